# Optimizing an MI355X kernel written in HIP

```python
import math
import jax, jax.numpy as jnp
from jax import lax
import numpy as np

D_MODEL = 1024
BATCH = 8
SEQ = 2048
DEPTH = 4
DEC_BATCH = 128
DEC_SEQ = 1
PAST_LEN = 16384
PAGE_SIZE = 128

MIX = D_MODEL
GROUP_W = MIX // 4
GM_HEADS = 4
GM_HEAD_DIM = GROUP_W // GM_HEADS
GM_CHUNK = 128
SSM_CH = 16
SSM_GROUPS = GROUP_W // SSM_CH
SSM_P = 64
CONV_W = 3
WKV_N = 64
WKV_HEADS = GROUP_W // WKV_N
LORA_W = 32
LORA_A = 32
LORA_G = 64
D_TM = 3 * GROUP_W + LORA_W + LORA_A + LORA_G
IN_COLS = 6 * GROUP_W + D_TM
IN_SPLITS = [GROUP_W * i for i in range(1, 7)]
TM_SPLITS = [GROUP_W, 2 * GROUP_W, 3 * GROUP_W, 3 * GROUP_W + LORA_W, 3 * GROUP_W + LORA_W + LORA_A]
D_FF = -(-(8 * D_MODEL) // (3 * 256)) * 256
NORM_EPS = 1e-6
GM_LN_EPS = 1e-5
WKV_LN_EPS = 64e-5

kernel_name = 'hybrid_gmlp_s5_conv_rwkv7_step'


def rmsnorm(x, g):
    xf = x.astype(jnp.float32)
    y = xf * lax.rsqrt(jnp.mean(xf * xf, axis=-1, keepdims=True) + NORM_EPS) * g.astype(jnp.float32)
    return y.astype(x.dtype)


def chunk_gmlp(zu, zv, ln_g, ln_b, ws, bs):
    bsz, t, _ = zu.shape
    u = jax.nn.gelu(zu)
    vf = jax.nn.gelu(zv.astype(jnp.float32))
    mu = jnp.mean(vf, axis=-1, keepdims=True)
    var = jnp.mean(jnp.square(vf - mu), axis=-1, keepdims=True)
    vn = ((vf - mu) * lax.rsqrt(var + GM_LN_EPS) * ln_g.astype(jnp.float32)
          + ln_b.astype(jnp.float32)).astype(zu.dtype)
    tc = min(t, GM_CHUNK)
    nc = t // tc
    wm = ws[:, :tc, :tc] * jnp.tril(jnp.ones((tc, tc), ws.dtype))
    vc = vn.reshape(bsz, nc, tc, GM_HEADS, GM_HEAD_DIM)
    s = jnp.einsum('hts,bcshd->bcthd', wm, vc) + jnp.transpose(bs[:, :tc])[None, None, :, :, None]
    return u * s.reshape(bsz, t, GROUP_W).astype(zu.dtype), vn


def s5_ssm(zu, s_re0, s_im0, a_re, a_im, log_dt, b_re, b_im, c_re, c_im, d, glu_w, glu_b):
    f32 = jnp.float32
    bsz, t, _ = zu.shape
    u = zu.astype(f32).reshape(bsz, t, SSM_GROUPS, SSM_CH)
    lam_re = jnp.minimum(a_re.astype(f32), -1e-4)
    lam_im = a_im.astype(f32)
    dt = jnp.exp(log_dt.astype(f32))
    mag = jnp.exp(lam_re * dt)
    lb_re = mag * jnp.cos(lam_im * dt)
    lb_im = mag * jnp.sin(lam_im * dt)
    den = lam_re * lam_re + lam_im * lam_im
    f_re = ((lb_re - 1.0) * lam_re + lb_im * lam_im) / den
    f_im = (lb_im * lam_re - (lb_re - 1.0) * lam_im) / den
    br, bi = b_re.astype(f32), b_im.astype(f32)
    bb_re = f_re[..., None] * br - f_im[..., None] * bi
    bb_im = f_re[..., None] * bi + f_im[..., None] * br
    bu_re = jnp.einsum('btgh,gph->tbgp', u, bb_re)
    bu_im = jnp.einsum('btgh,gph->tbgp', u, bb_im)
    a_r = jnp.broadcast_to(lb_re, (t, 1, SSM_GROUPS, SSM_P))
    a_i = jnp.broadcast_to(lb_im, (t, 1, SSM_GROUPS, SSM_P))

    def combine(e1, e2):
        a1r, a1i, b1r, b1i = e1
        a2r, a2i, b2r, b2i = e2
        return (a2r * a1r - a2i * a1i, a2r * a1i + a2i * a1r,
                a2r * b1r - a2i * b1i + b2r, a2r * b1i + a2i * b1r + b2i)

    pa_r, pa_i, sr, si = lax.associative_scan(combine, (a_r, a_i, bu_re, bu_im), axis=0)
    s0r = s_re0.astype(f32)[None]
    s0i = s_im0.astype(f32)[None]
    st_re = pa_r * s0r - pa_i * s0i + sr
    st_im = pa_r * s0i + pa_i * s0r + si
    y = (jnp.einsum('tbgp,ghp->btgh', st_re, c_re.astype(f32))
         - jnp.einsum('tbgp,ghp->btgh', st_im, c_im.astype(f32))
         + d.astype(f32) * u)
    y = jax.nn.gelu(y.reshape(bsz, t, GROUP_W))
    out = y * jax.nn.sigmoid(y @ glu_w.astype(f32) + glu_b.astype(f32))
    return out.astype(zu.dtype), st_re[-1], st_im[-1]


def short_conv(zx, zb, zc, buf, conv_w, conv_b):
    t = zx.shape[1]
    z = zc * zx
    zp = jnp.concatenate([buf.astype(z.dtype), z], axis=1)
    y = conv_b + sum(conv_w[j] * zp[:, j:j + t] for j in range(CONV_W))
    return zb * y, zp[:, t:]


def rwkv7(zd, prev, s0, mu, w0, w2, a0, a2, g2, k_k, k_a, r_k, ln_g, ln_b):
    f32 = jnp.float32
    bsz, t, _ = zd.shape
    zprev = jnp.concatenate([prev[:, None, :].astype(zd.dtype), zd[:, :-1]], axis=1)
    zs = zd + mu * (zprev - zd)
    r, k, v, xw, xa, xg = jnp.split(zs, TM_SPLITS, axis=-1)
    w = -jax.nn.softplus(-(w0 + jnp.tanh(xw) @ w2).astype(f32)) - 0.5
    decay = jnp.exp(-jnp.exp(w))
    a = jax.nn.sigmoid((a0 + xa @ a2).astype(f32))
    g = (jax.nn.sigmoid(xg) @ g2).astype(f32)
    hs = (bsz, t, WKV_HEADS, WKV_N)
    rf = r.astype(f32).reshape(hs)
    kf = k.astype(f32).reshape(hs)
    vf = v.astype(f32).reshape(hs)
    ah = a.reshape(hs)
    dh = decay.reshape(hs)
    kk = kf * k_k.astype(f32).reshape(WKV_HEADS, WKV_N)
    kk = kk / jnp.maximum(jnp.linalg.norm(kk, axis=-1, keepdims=True), 1e-12)
    kf = kf * (1.0 + (ah - 1.0) * k_a.astype(f32).reshape(WKV_HEADS, WKV_N))
    a_vec = -kk
    b_vec = kk * ah

    def step(S, inp):
        r_t, d_t, k_t, v_t, a_t, b_t = inp
        sa = jnp.einsum('bhvk,bhk->bhv', S, a_t)
        S = (S * d_t[:, :, None, :] + sa[..., None] * b_t[:, :, None, :]
             + v_t[..., None] * k_t[:, :, None, :])
        return S, jnp.einsum('bhvk,bhk->bhv', S, r_t)

    xs = tuple(jnp.moveaxis(q, 1, 0) for q in (rf, dh, kf, vf, a_vec, b_vec))
    S, o = lax.scan(step, s0.astype(f32), xs)
    o = jnp.moveaxis(o, 0, 1)
    m = jnp.mean(o, axis=-1, keepdims=True)
    var = jnp.mean(jnp.square(o - m), axis=-1, keepdims=True)
    on = ((o - m) * lax.rsqrt(var + WKV_LN_EPS) * ln_g.astype(f32).reshape(WKV_HEADS, WKV_N)
          + ln_b.astype(f32).reshape(WKV_HEADS, WKV_N))
    bonus = jnp.sum(rf * kf * r_k.astype(f32), axis=-1, keepdims=True) * vf
    out = (on + bonus).reshape(bsz, t, GROUP_W) * g
    return out.astype(zd.dtype), zd[:, -1], S


def setup_inputs(seed: int = 0) -> dict:
    key = jax.random.key(seed)
    ks = iter(jax.random.split(key, 64))
    f32 = jnp.float32

    def nrm(shape, scale):
        return jax.random.normal(next(ks), shape, f32) * scale

    def gain(shape):
        return 1.0 + nrm(shape, 0.02)

    def unif(shape, lo, hi):
        return jax.random.uniform(next(ks), shape, f32, lo, hi)

    L, G, P, H, N = DEPTH, SSM_GROUPS, SSM_P, WKV_HEADS, WKV_N
    return {
        'x_prompt': nrm((BATCH, SEQ, D_MODEL), 1.0),
        'x_sample': nrm((DEC_BATCH, DEC_SEQ, D_MODEL), 1.0),
        'state_wkv': nrm((L, DEC_BATCH, H, N, N), 0.3),
        'state_shift': nrm((L, DEC_BATCH, D_TM), 1.0),
        'state_ssm_re': nrm((L, DEC_BATCH, G, P), 0.3),
        'state_ssm_im': nrm((L, DEC_BATCH, G, P), 0.3),
        'state_conv': nrm((L, DEC_BATCH, CONV_W - 1, GROUP_W), 1.0),
        'norm1_g': gain((L, D_MODEL)),
        'w_in': nrm((L, D_MODEL, IN_COLS), D_MODEL ** -0.5),
        'gm_ln_g': gain((L, GROUP_W)),
        'gm_ln_b': nrm((L, GROUP_W), 0.02),
        'gm_ws': nrm((L, GM_HEADS, GM_CHUNK, GM_CHUNK), GM_CHUNK ** -0.5),
        'gm_bs': gain((L, GM_HEADS, GM_CHUNK)),
        'ssm_a_re': -0.5 + nrm((L, G, P), 0.01),
        'ssm_a_im': math.pi * jnp.arange(P, dtype=f32) + nrm((L, G, P), 0.01),
        'ssm_log_dt': unif((L, G, P), math.log(1e-3), math.log(1e-1)),
        'ssm_b_re': nrm((L, G, P, SSM_CH), (2 * SSM_CH) ** -0.5),
        'ssm_b_im': nrm((L, G, P, SSM_CH), (2 * SSM_CH) ** -0.5),
        'ssm_c_re': nrm((L, G, SSM_CH, P), P ** -0.5),
        'ssm_c_im': nrm((L, G, SSM_CH, P), P ** -0.5),
        'ssm_d': nrm((L, G, SSM_CH), 1.0),
        'ssm_glu_w': nrm((L, GROUP_W, GROUP_W), GROUP_W ** -0.5),
        'ssm_glu_b': nrm((L, GROUP_W), 0.02),
        'conv_w': nrm((L, CONV_W, GROUP_W), CONV_W ** -0.5),
        'conv_b': nrm((L, GROUP_W), 0.02),
        'tm_mu': unif((L, D_TM), 0.0, 1.0),
        'tm_w0': unif((L, GROUP_W), -6.0, -1.0),
        'tm_w2': nrm((L, LORA_W, GROUP_W), 0.1 * LORA_W ** -0.5),
        'tm_a0': nrm((L, GROUP_W), 0.1),
        'tm_a2': nrm((L, LORA_A, GROUP_W), 0.1 * LORA_A ** -0.5),
        'tm_g2': nrm((L, LORA_G, GROUP_W), LORA_G ** -0.5),
        'tm_k_k': 0.85 + nrm((L, GROUP_W), 0.02),
        'tm_k_a': gain((L, GROUP_W)),
        'tm_r_k': nrm((L, H, N), 0.1),
        'tm_ln_g': gain((L, GROUP_W)),
        'tm_ln_b': nrm((L, GROUP_W), 0.02),
        'w_out': nrm((L, MIX, D_MODEL), 0.5 * MIX ** -0.5),
        'norm2_g': gain((L, D_MODEL)),
        'ffn_w_gu': nrm((L, D_MODEL, 2 * D_FF), D_MODEL ** -0.5),
        'ffn_w_down': nrm((L, D_FF, D_MODEL), 0.5 * D_FF ** -0.5),
        'norm_f_g': gain((D_MODEL,)),
    }


def reference(x_prompt, x_sample, state_wkv, state_shift, state_ssm_re, state_ssm_im, state_conv,
              norm1_g, w_in, gm_ln_g, gm_ln_b, gm_ws, gm_bs,
              ssm_a_re, ssm_a_im, ssm_log_dt, ssm_b_re, ssm_b_im, ssm_c_re, ssm_c_im, ssm_d,
              ssm_glu_w, ssm_glu_b, conv_w, conv_b,
              tm_mu, tm_w0, tm_w2, tm_a0, tm_a2, tm_g2, tm_k_k, tm_k_a, tm_r_k, tm_ln_g, tm_ln_b,
              w_out, norm2_g, ffn_w_gu, ffn_w_down, norm_f_g):

    def run_layer(x, l, wkv0, shift0, sre0, sim0, conv0):
        h = rmsnorm(x, norm1_g[l])
        z = h @ w_in[l]
        zau, zav, zbu, zcx, zcb, zcc, zd = jnp.split(z, IN_SPLITS, axis=-1)
        ya, v_rows = chunk_gmlp(zau, zav, gm_ln_g[l], gm_ln_b[l], gm_ws[l], gm_bs[l])
        yb, s_re, s_im = s5_ssm(zbu, sre0, sim0, ssm_a_re[l], ssm_a_im[l], ssm_log_dt[l],
                                ssm_b_re[l], ssm_b_im[l], ssm_c_re[l], ssm_c_im[l], ssm_d[l],
                                ssm_glu_w[l], ssm_glu_b[l])
        yc, conv_new = short_conv(zcx, zcb, zcc, conv0, conv_w[l], conv_b[l])
        yd, shift_new, wkv_new = rwkv7(zd, shift0, wkv0, tm_mu[l], tm_w0[l], tm_w2[l], tm_a0[l],
                                       tm_a2[l], tm_g2[l], tm_k_k[l], tm_k_a[l], tm_r_k[l],
                                       tm_ln_g[l], tm_ln_b[l])
        x = x + jnp.concatenate([ya, yb, yc, yd], axis=-1) @ w_out[l]
        gate, up = jnp.split(rmsnorm(x, norm2_g[l]) @ ffn_w_gu[l], 2, axis=-1)
        x = x + (jax.nn.silu(gate) * up) @ ffn_w_down[l]
        return x, wkv_new, shift_new, s_re, s_im, conv_new, v_rows

    bp = x_prompt.shape[0]
    dtp = x_prompt.dtype
    xp, xs = x_prompt, x_sample
    wkv_p, wkv_s, sh_p, sh_s, re_p, re_s, im_p, im_s, cv_p, cv_s, chv_s = ([] for _ in range(11))
    for l in range(DEPTH):
        xp, a1, a2, a3, a4, a5, _ = run_layer(
            xp, l,
            jnp.zeros((bp, WKV_HEADS, WKV_N, WKV_N), dtp),
            jnp.zeros((bp, D_TM), dtp),
            jnp.zeros((bp, SSM_GROUPS, SSM_P), dtp),
            jnp.zeros((bp, SSM_GROUPS, SSM_P), dtp),
            jnp.zeros((bp, CONV_W - 1, GROUP_W), dtp))
        wkv_p.append(a1); sh_p.append(a2); re_p.append(a3); im_p.append(a4); cv_p.append(a5)
        xs, b1, b2, b3, b4, b5, b6 = run_layer(
            xs, l, state_wkv[l], state_shift[l], state_ssm_re[l], state_ssm_im[l], state_conv[l])
        wkv_s.append(b1); sh_s.append(b2); re_s.append(b3); im_s.append(b4); cv_s.append(b5)
        chv_s.append(b6)
    y_prompt = rmsnorm(xp, norm_f_g)
    y_sample = rmsnorm(xs, norm_f_g)
    return (y_prompt, y_sample,
            jnp.stack(wkv_p), jnp.stack(wkv_s),
            jnp.stack(sh_p), jnp.stack(sh_s),
            jnp.stack(re_p), jnp.stack(re_s),
            jnp.stack(im_p), jnp.stack(im_s),
            jnp.stack(cv_p), jnp.stack(cv_s),
            jnp.stack(chv_s))
```

```cpp
#include <hip/hip_runtime.h>
#include <hip/hip_cooperative_groups.h>
#include <cstdio>
namespace cg = cooperative_groups;

#define LAS __attribute__((address_space(3)))
typedef unsigned short bf16_t;
typedef short bf16x8 __attribute__((ext_vector_type(8)));
typedef float f32x4 __attribute__((ext_vector_type(4)));
typedef float f32x2 __attribute__((ext_vector_type(2)));
typedef unsigned u32x4 __attribute__((ext_vector_type(4)));
typedef unsigned u32x2 __attribute__((ext_vector_type(2)));

constexpr int DM = 1024, NPROMPT = 16384, NSAMP = 128, NR = NPROMPT + NSAMP, SEQ = 2048, NB = 8, NL = 4;
constexpr int ZLD = 2560, INC = 2432, DFF = 2816, DTM = 896;
constexpr int MIXOFF = 256;
constexpr size_t O_Y = 0;
constexpr size_t O_WKVP = (size_t)NR * DM;
constexpr size_t O_WKVS = O_WKVP + (size_t)NL * NB * 4 * 64 * 64;
constexpr size_t O_SHP = O_WKVS + (size_t)NL * NSAMP * 4 * 64 * 64;
constexpr size_t O_SHS = O_SHP + (size_t)NL * NB * DTM;
constexpr size_t O_REP = O_SHS + (size_t)NL * NSAMP * DTM;
constexpr size_t O_RES = O_REP + (size_t)NL * NB * 1024;
constexpr size_t O_IMP = O_RES + (size_t)NL * NSAMP * 1024;
constexpr size_t O_IMS = O_IMP + (size_t)NL * NB * 1024;
constexpr size_t O_CVP = O_IMS + (size_t)NL * NSAMP * 1024;
constexpr size_t O_CVS = O_CVP + (size_t)NL * NB * 512;
constexpr size_t O_CHV = O_CVS + (size_t)NL * NSAMP * 512;
constexpr size_t O_END = O_CHV + (size_t)NL * NSAMP * 256;
static_assert(O_END == 27832320, "output size");
constexpr size_t W_XB = 0;
constexpr int CHS = 31232;
constexpr size_t W_ZA = W_XB + (size_t)NR * DM * 2;
constexpr size_t W_WB = W_ZA + (size_t)NR * DFF * 2;
constexpr size_t WB_WIN = 0, WB_WOUT = WB_WIN + (size_t)ZLD * 1024 * 2, WB_WGU = WB_WOUT + (size_t)1024 * 1024 * 2, WB_WDN = WB_WGU + (size_t)5632 * 1024 * 2,
                 WB_GLU = WB_WDN + (size_t)1024 * DFF * 2, WB_LORA = WB_GLU + 256 * 256 * 2, WB_WSB = WB_LORA + 256 * 128 * 2, WB_SIZE = WB_WSB + 4 * 128 * 128 * 2;
constexpr size_t W_TOK = W_WB + 2 * WB_SIZE;
constexpr size_t W_GG = W_TOK + (size_t)NR * 1536 * 2;
constexpr size_t W_OO = W_GG + (size_t)NR * 256 * 2;
constexpr size_t W_BON = W_OO + (size_t)NR * 256 * 4;
constexpr size_t W_SSQ = W_BON + (size_t)NR * 4 * 4;
constexpr size_t W_EE = W_SSQ + (size_t)9 * NR * 8;
constexpr size_t W_LBC = W_EE + (size_t)NB * 32 * 16 * 64 * 2 * 4;
constexpr size_t W_BBAR = W_LBC + (size_t)NL * 1024 * 8;
constexpr size_t W_BAR = W_BBAR + (size_t)NL * 16 * 128 * 16 * 2;
constexpr size_t W_END = W_BAR + 16384;
static_assert(W_END <= 268435456, "workspace");
static_assert((size_t)NB * 4 * 64 * CHS <= (size_t)NR * DM * 4, "chunk data lives in the y region of d_out until the final norm overwrites it");
static_assert(W_ZA % 256 == 0 && W_WB % 256 == 0 && W_TOK % 256 == 0 && W_GG % 256 == 0 && W_OO % 256 == 0 && W_BON % 256 == 0 && W_SSQ % 256 == 0 && W_EE % 256 == 0 && WB_SIZE % 256 == 0, "align");
constexpr int LDS_BYTES = 139264;

struct Params { const float* in[41]; float* out; unsigned char* ws; };

struct Ctx {
    const float* const* in; float* out; unsigned char* ws;
    LAS unsigned char* lds; int tid, lane, w, gw, nw;
    __device__ __forceinline__ float* X() const { return out; }
    __device__ __forceinline__ bf16_t* XB() const { return (bf16_t*)(ws + W_XB); }
    __device__ __forceinline__ bf16_t* Z() const { return (bf16_t*)(ws + W_ZA); }
    __device__ __forceinline__ bf16_t* ACT() const { return (bf16_t*)(ws + W_ZA); }
    __device__ __forceinline__ unsigned char* WB() const { return ws + W_WB; }
    __device__ __forceinline__ bf16_t* TOK() const { return (bf16_t*)(ws + W_TOK); }
    __device__ __forceinline__ bf16_t* GG() const { return (bf16_t*)(ws + W_GG); }
    __device__ __forceinline__ float* OO() const { return (float*)(ws + W_OO); }
    __device__ __forceinline__ float* BON() const { return (float*)(ws + W_BON); }
    __device__ __forceinline__ unsigned long long* SSQ() const { return (unsigned long long*)(ws + W_SSQ); }
    __device__ __forceinline__ float* EE() const { return (float*)(ws + W_EE); }
    __device__ __forceinline__ unsigned char* CH() const { return (unsigned char*)out; }
    __device__ __forceinline__ float* LBC() const { return (float*)(ws + W_LBC); }
    __device__ __forceinline__ bf16_t* BBAR() const { return (bf16_t*)(ws + W_BBAR); }
};

__device__ __forceinline__ float bf2f(bf16_t b) { return __uint_as_float(((unsigned)b) << 16); }
__device__ __forceinline__ float bflo(unsigned u) { return __uint_as_float(u << 16); }
__device__ __forceinline__ float bfhi(unsigned u) { return __uint_as_float(u & 0xffff0000u); }
typedef __bf16 bf16v2 __attribute__((ext_vector_type(2)));
__device__ __forceinline__ unsigned pk2(float lo, float hi) { const f32x2 v = {lo, hi}; const bf16v2 b = __builtin_convertvector(v, bf16v2); return __builtin_bit_cast(unsigned, b); }
__device__ __forceinline__ bf16_t f2bf(float f) { return (bf16_t)(pk2(f, 0.f) & 0xffffu); }
constexpr float SSQ_SCALE = 16777216.0f;
__device__ __forceinline__ float ssq_rs(const unsigned long long* p, int row) { return rsqrtf((float)p[row] * (1.0f / (SSQ_SCALE * 1024.0f)) + 1e-6f); }
__device__ __forceinline__ void ssq_add(unsigned long long* p, int row, float s) { atomicAdd(p + row, (unsigned long long)(s * SSQ_SCALE + 0.5f)); }
__device__ __forceinline__ float sigmoidf_(float x) { return 1.0f / (1.0f + __expf(-x)); }
__device__ __forceinline__ float gelu_t(float x) { const float y = 0.7978845608028654f * (x + 0.044715f * x * x * x); return x * sigmoidf_(2.0f * y); }
__device__ __forceinline__ float tanh_(float x) { return 1.0f - 2.0f / (__expf(2.0f * x) + 1.0f); }
template <int CTRL> __device__ __forceinline__ float dpp_mov(float v) { return __builtin_bit_cast(float, __builtin_amdgcn_update_dpp(0, __builtin_bit_cast(int, v), CTRL, 0xf, 0xf, true)); }
__device__ __forceinline__ float row16_sum(float v) { v += dpp_mov<0xB1>(v); v += dpp_mov<0x4E>(v); v += dpp_mov<0x141>(v); v += dpp_mov<0x140>(v); return v; }
__device__ __forceinline__ float wave_sum(float v) {
    v = row16_sum(v); const int b = __builtin_bit_cast(int, v);
    const float a0 = __builtin_bit_cast(float, __builtin_amdgcn_readlane(b, 0)), a1 = __builtin_bit_cast(float, __builtin_amdgcn_readlane(b, 16));
    const float a2 = __builtin_bit_cast(float, __builtin_amdgcn_readlane(b, 32)), a3 = __builtin_bit_cast(float, __builtin_amdgcn_readlane(b, 48));
    return (a0 + a1) + (a2 + a3);
}
__device__ __forceinline__ f32x4 zero4() { float z = 0.f; asm volatile("" : "+v"(z)); return (f32x4){z, z, z, z}; }
__device__ __forceinline__ f32x4 mfma16(bf16x8 a, bf16x8 b, f32x4 c) { return __builtin_amdgcn_mfma_f32_16x16x32_bf16(a, b, c, 0, 0, 0); }
__device__ __forceinline__ bf16x8 pack8(const float* z) { u32x4 u; u.x = pk2(z[0], z[1]); u.y = pk2(z[2], z[3]); u.z = pk2(z[4], z[5]); u.w = pk2(z[6], z[7]); return __builtin_bit_cast(bf16x8, u); }
__device__ __forceinline__ bf16x8 lds_ld16(const LAS bf16_t* p) { const u32x2 a = *(const LAS u32x2*)p, b = *(const LAS u32x2*)(p + 4); u32x4 r; r.x = a.x; r.y = a.y; r.z = b.x; r.w = b.y; return __builtin_bit_cast(bf16x8, r); }
constexpr int VLD = 132;
__device__ __forceinline__ void unpack4(u32x2 u, float* z) { z[0] = bflo(u.x); z[1] = bfhi(u.x); z[2] = bflo(u.y); z[3] = bfhi(u.y); }
__device__ __forceinline__ void unpack8(u32x4 u, float* z) { z[0] = bflo(u.x); z[1] = bfhi(u.x); z[2] = bflo(u.y); z[3] = bfhi(u.y); z[4] = bflo(u.z); z[5] = bfhi(u.z); z[6] = bflo(u.w); z[7] = bfhi(u.w); }

namespace pg8 {
constexpr int BM = 256, BK = 64, HALF = 128, HTB = HALF * BK * 2, STAGE_BYTES = 8 * HTB, NXCD = 8, WGM = 8;
__device__ __forceinline__ int lds_byte(int r, int c) { const int st = (r >> 4) * 2 + (c >> 5), rr = r & 15, cc = c & 31, ob = rr * 64 + cc * 2; return st * 1024 + (ob ^ (((ob >> 9) & 1) << 5)); }
__device__ __forceinline__ void stage_rc(int b, int& R, int& C) { const int st = b / 1024, sb = b % 1024, swz = sb ^ (((sb >> 9) & 1) << 5); R = (st >> 1) * 16 + swz / 64; C = (st & 1) * 32 + (swz % 64) / 2; }
__device__ __forceinline__ int perm32(int rho) { const int n = rho >> 4, i = rho & 15; return 8 * (i >> 2) + 4 * n + (i & 3); }
struct Unit { int pm, pn; };
struct Gemm { const bf16_t* A; const bf16_t* Bt; int M, N, K, lda; };
struct StaticOrder {
    int nM, nN, nwg, G, c;
    __device__ void init(int M, int N, int G_, int c_) { nM = M / BM; nN = N / BM; nwg = nM * nN; G = G_; c = c_; }
    __device__ bool next(int i, Unit& u) const {
        const long L = (long)i * G + c; if (L >= nwg) return false;
        int wgid = (int)L; { const int q = nwg / NXCD, r = nwg % NXCD, xcd = wgid % NXCD, off = wgid / NXCD; wgid = (xcd < r ? xcd * (q + 1) : r * (q + 1) + (xcd - r) * q) + off; }
        const int nig = WGM * nN, gid = wgid / nig, fm = gid * WGM, gsz = (nM - fm) < WGM ? (nM - fm) : WGM;
        u.pm = fm + ((wgid % nig) % gsz); u.pn = (wgid % nig) / gsz; return true;
    }
};

template <class Epi>
__device__ __forceinline__ void gemm_phase(LAS unsigned char* lds, const Gemm g, const StaticOrder& S, const Epi& E, const int tid) {
    const int wid = __builtin_amdgcn_readfirstlane(tid >> 6), lane = tid & 63, wr = wid >> 2, wc = wid & 3, fr = lane & 15, fq = lane >> 4;
    const int K = g.K, nt = K / BK;
    unsigned voffA[2], voffB[2];
#pragma unroll
    for (int i = 0; i < 2; ++i) { int R, C; stage_rc(tid * 16 + i * 8192, R, C); const int Rb = Epi::PERM ? ((R & ~31) + perm32(R & 31)) : R;
        voffA[i] = (unsigned)(R * g.lda + C) * 2u; voffB[i] = (unsigned)(Rb * K + C) * 2u; }
    const size_t kstep = (size_t)(BK * 2);
    const size_t hstepA = (size_t)HALF * g.lda * 2, hstepB = (size_t)HALF * K * 2;
    const size_t tstepA = 2 * hstepA, tstepB = 2 * hstepB;
    const unsigned ldsw = (unsigned)wid * 1024u;
    const int aoff = lds_byte(wr * 64 + fr, fq * 8), boff = lds_byte(wc * 32 + fr, fq * 8);
#define PG8_SA(b, h) (((b) * 2 + (h)) * HTB)
#define PG8_SB(b, h) ((4 + (b) * 2 + (h)) * HTB)
#define PG8_STAGE(bufoff, gbase, voff) do { _Pragma("unroll") for (int _i = 0; _i < 2; ++_i) \
        __builtin_amdgcn_global_load_lds((const unsigned*)((const char*)(gbase) + (voff)[_i]), (LAS unsigned*)(lds + (bufoff) + ldsw + _i * 8192), 16, 0, 0); } while (0)
#define PG8_LDA(dst, b, h) do { _Pragma("unroll") for (int m = 0; m < 4; ++m) _Pragma("unroll") for (int k = 0; k < 2; ++k) dst[m][k] = *(const LAS bf16x8*)(lds + PG8_SA(b, h) + aoff + m * 2048 + k * 1024); } while (0)
#define PG8_LDB(dst, b, h) do { _Pragma("unroll") for (int n = 0; n < 2; ++n) _Pragma("unroll") for (int k = 0; k < 2; ++k) dst[n][k] = *(const LAS bf16x8*)(lds + PG8_SB(b, h) + boff + n * 2048 + k * 1024); } while (0)
#define PG8_MMA(ai, bj, At, Bt) do { __builtin_amdgcn_s_setprio(1); _Pragma("unroll") for (int m = 0; m < 4; ++m) _Pragma("unroll") for (int n = 0; n < 2; ++n) _Pragma("unroll") for (int k = 0; k < 2; ++k) \
        acc[ai][bj][m][n] = __builtin_amdgcn_mfma_f32_16x16x32_bf16(Bt[n][k], At[m][k], acc[ai][bj][m][n], 0, 0, 0); __builtin_amdgcn_s_setprio(0); } while (0)
#define PG8_WAIT_V(n) asm volatile("s_waitcnt vmcnt(" #n ")" ::: "memory")
#define PG8_WAIT_L(n) asm volatile("s_waitcnt lgkmcnt(" #n ")" ::: "memory")
#define PG8_BAR __builtin_amdgcn_s_barrier()
#define PG8_SCHED __builtin_amdgcn_sched_barrier(0)
    Unit cur, nxt; int ui = 0;
    if (!S.next(0, cur)) return;
    f32x4 acc[2][2][4][2];
#pragma unroll
    for (int a = 0; a < 2; ++a)
#pragma unroll
        for (int b = 0; b < 2; ++b)
#pragma unroll
            for (int m = 0; m < 4; ++m)
#pragma unroll
                for (int n = 0; n < 2; ++n) acc[a][b][m][n] = zero4();
    bf16x8 At[4][2], B0[2][2], B1[2][2];
    const char* cA = (const char*)g.A + (size_t)cur.pm * tstepA; const char* cB = (const char*)g.Bt + (size_t)cur.pn * tstepB;
    PG8_STAGE(PG8_SB(0, 0), cB, voffB); PG8_STAGE(PG8_SA(0, 0), cA, voffA); PG8_STAGE(PG8_SB(0, 1), cB + hstepB, voffB); PG8_STAGE(PG8_SA(0, 1), cA + hstepA, voffA);
    if (wr == 1) PG8_BAR;
    PG8_WAIT_V(4); PG8_BAR;
    PG8_STAGE(PG8_SB(1, 0), cB + kstep, voffB); PG8_STAGE(PG8_SA(1, 0), cA + kstep, voffA); PG8_STAGE(PG8_SB(1, 1), cB + hstepB + kstep, voffB);
    PG8_WAIT_V(6); PG8_BAR;
    for (;;) {
        const bool has_next = S.next(ui + 1, nxt);
        const char* nA = has_next ? (const char*)g.A + (size_t)nxt.pm * tstepA : cA; const char* nB = has_next ? (const char*)g.Bt + (size_t)nxt.pn * tstepB : cB;
        for (int t = 0; t < nt; t += 2) {
            const bool last = (t == nt - 2);
            const char* a1 = cA + (size_t)(t + 1) * kstep;
            const char* a2 = last ? nA : cA + (size_t)(t + 2) * kstep; const char* b2 = last ? nB : cB + (size_t)(t + 2) * kstep;
            const char* a3 = a2 + kstep; const char* b3 = b2 + kstep;
            PG8_LDB(B0, 0, 0); PG8_SCHED; PG8_LDA(At, 0, 0); PG8_STAGE(PG8_SA(1, 1), a1 + hstepA, voffA);
            PG8_WAIT_L(8); PG8_BAR; PG8_WAIT_L(0); PG8_MMA(0, 0, At, B0); PG8_BAR; PG8_SCHED;
            PG8_LDB(B1, 0, 1); PG8_STAGE(PG8_SB(0, 0), b2, voffB);
            PG8_BAR; PG8_WAIT_L(0); PG8_MMA(0, 1, At, B1); PG8_BAR;
            PG8_LDA(At, 0, 1); PG8_STAGE(PG8_SA(0, 0), a2, voffA);
            PG8_BAR; PG8_WAIT_L(0); PG8_MMA(1, 0, At, B0); PG8_BAR; PG8_SCHED;
            PG8_STAGE(PG8_SB(0, 1), b2 + hstepB, voffB);
            PG8_WAIT_V(6); PG8_BAR; PG8_MMA(1, 1, At, B1); PG8_BAR;
            PG8_LDB(B0, 1, 0); PG8_SCHED; PG8_LDA(At, 1, 0); PG8_STAGE(PG8_SA(0, 1), a2 + hstepA, voffA);
            PG8_WAIT_L(8); PG8_BAR; PG8_WAIT_L(0); PG8_MMA(0, 0, At, B0); PG8_BAR; PG8_SCHED;
            PG8_LDB(B1, 1, 1); PG8_STAGE(PG8_SB(1, 0), b3, voffB);
            PG8_BAR; PG8_WAIT_L(0); PG8_MMA(0, 1, At, B1); PG8_BAR;
            PG8_LDA(At, 1, 1); PG8_STAGE(PG8_SA(1, 0), a3, voffA);
            PG8_BAR; PG8_WAIT_L(0); PG8_MMA(1, 0, At, B0); PG8_BAR; PG8_SCHED;
            PG8_STAGE(PG8_SB(1, 1), b3 + hstepB, voffB);
            PG8_WAIT_V(6); PG8_BAR; PG8_MMA(1, 1, At, B1); PG8_BAR;
        }
        E(acc, cur, wr, wc, fr, fq);
        if (!has_next) break;
#pragma unroll
        for (int a = 0; a < 2; ++a)
#pragma unroll
            for (int b = 0; b < 2; ++b)
#pragma unroll
                for (int m = 0; m < 4; ++m)
#pragma unroll
                    for (int n = 0; n < 2; ++n) acc[a][b][m][n] = zero4();
        cur = nxt; cA = nA; cB = nB; ++ui;
    }
    PG8_WAIT_V(0);
    if (wr == 0) PG8_BAR;
    PG8_BAR;
#undef PG8_SA
#undef PG8_SB
#undef PG8_STAGE
#undef PG8_LDA
#undef PG8_LDB
#undef PG8_MMA
#undef PG8_WAIT_V
#undef PG8_WAIT_L
#undef PG8_BAR
#undef PG8_SCHED
}
}

struct EpiZ {
    static constexpr bool PERM = true;
    bf16_t* Z; const unsigned long long* ssq;
    __device__ __forceinline__ void operator()(const f32x4 (&acc)[2][2][4][2], const pg8::Unit& u, int wr, int wc, int fr, int fq) const {
        const int row0 = u.pm * 256 + wr * 64 + fr, col0 = u.pn * 256 + wc * 32 + 8 * fq;
        unsigned long long sq[8];
#pragma unroll
        for (int i = 0; i < 8; ++i) sq[i] = ssq[row0 + (i >> 2) * 128 + (i & 3) * 16];
#pragma unroll
        for (int ai = 0; ai < 2; ++ai)
#pragma unroll
            for (int m = 0; m < 4; ++m) { const int row = row0 + ai * 128 + m * 16; const float rs = rsqrtf((float)sq[ai * 4 + m] * (1.0f / (SSQ_SCALE * 1024.0f)) + 1e-6f);
                bf16_t* rowp = Z + (size_t)row * ZLD + col0;
#pragma unroll
                for (int bj = 0; bj < 2; ++bj) { const f32x4 v0 = acc[ai][bj][m][0] * rs, v1 = acc[ai][bj][m][1] * rs;
                    u32x4 w; w.x = pk2(v0[0], v0[1]); w.y = pk2(v0[2], v0[3]); w.z = pk2(v1[0], v1[1]); w.w = pk2(v1[2], v1[3]);
                    *(u32x4*)(rowp + bj * 128) = w; } }
    }
};
struct EpiRes {
    static constexpr bool PERM = true;
    bf16_t* XB; unsigned long long* ssq;
    __device__ __forceinline__ void operator()(const f32x4 (&acc)[2][2][4][2], const pg8::Unit& u, int wr, int wc, int fr, int fq) const {
        const int row0 = u.pm * 256 + wr * 64 + fr, col0 = u.pn * 256 + wc * 32 + 8 * fq;
        u32x4 xin[2][4][2];
#pragma unroll
        for (int ai = 0; ai < 2; ++ai)
#pragma unroll
            for (int m = 0; m < 4; ++m) { const bf16_t* bp = XB + (size_t)(row0 + ai * 128 + m * 16) * DM + col0;
#pragma unroll
                for (int bj = 0; bj < 2; ++bj) xin[ai][m][bj] = *(const u32x4*)(bp + bj * 128); }
#pragma unroll
        for (int ai = 0; ai < 2; ++ai)
#pragma unroll
            for (int m = 0; m < 4; ++m) { const int row = row0 + ai * 128 + m * 16; bf16_t* bp = XB + (size_t)row * DM + col0; float s = 0.f;
#pragma unroll
                for (int bj = 0; bj < 2; ++bj) { float xo[8]; unpack8(xin[ai][m][bj], xo); const f32x4 a0 = acc[ai][bj][m][0], a1 = acc[ai][bj][m][1];
                    u32x4 w; w.x = pk2(xo[0] + a0[0], xo[1] + a0[1]); w.y = pk2(xo[2] + a0[2], xo[3] + a0[3]); w.z = pk2(xo[4] + a1[0], xo[5] + a1[1]); w.w = pk2(xo[6] + a1[2], xo[7] + a1[3]);
                    *(u32x4*)(bp + bj * 128) = w; float o[8]; unpack8(w, o);
#pragma unroll
                    for (int e = 0; e < 8; ++e) s += o[e] * o[e]; }
                s += __shfl_xor(s, 16); s += __shfl_xor(s, 32);
                if (fq == 0) ssq_add(ssq, row, s); }
    }
};
struct EpiAct {
    static constexpr bool PERM = true;
    bf16_t* ACT; const unsigned long long* ssq;
    __device__ __forceinline__ void operator()(const f32x4 (&acc)[2][2][4][2], const pg8::Unit& u, int wr, int wc, int fr, int fq) const {
        const int row0 = u.pm * 256 + wr * 64 + fr, col0 = u.pn * 128 + wc * 32 + 8 * fq;
        unsigned long long sq[8];
#pragma unroll
        for (int i = 0; i < 8; ++i) sq[i] = ssq[row0 + (i >> 2) * 128 + (i & 3) * 16];
#pragma unroll
        for (int ai = 0; ai < 2; ++ai)
#pragma unroll
            for (int m = 0; m < 4; ++m) { const int row = row0 + ai * 128 + m * 16; const float rs = rsqrtf((float)sq[ai * 4 + m] * (1.0f / (SSQ_SCALE * 1024.0f)) + 1e-6f);
                float o[8];
#pragma unroll
                for (int n = 0; n < 2; ++n)
#pragma unroll
                    for (int j = 0; j < 4; ++j) { const float g = acc[ai][0][m][n][j] * rs, up = acc[ai][1][m][n][j] * rs; o[n * 4 + j] = g * sigmoidf_(g) * up; }
                u32x4 w; w.x = pk2(o[0], o[1]); w.y = pk2(o[2], o[3]); w.z = pk2(o[4], o[5]); w.w = pk2(o[6], o[7]);
                *(u32x4*)(ACT + (size_t)row * DFF + col0) = w; }
    }
};

template <class F>
__device__ __forceinline__ void thin_gemm(const bf16_t* A, int lda, const bf16_t* Bt, int K, int npairs, const F& f, int w, int lane, int wgi = -1, int G = 0) {
    if (wgi < 0) { wgi = blockIdx.x; G = gridDim.x; }
    const int fr = lane & 15, fq = lane >> 4, ntask = npairs * 8;
    for (int task = w * G + wgi; task < ntask; task += 8 * G) {
        const int rt = task & 7, pr = task >> 3;
        const bf16_t* ap = A + (size_t)(rt * 16 + fr) * lda + 8 * fq;
        const bf16_t* bp0 = Bt + (size_t)(f.b0(pr) + fr) * K + 8 * fq;
        const bf16_t* bp1 = Bt + (size_t)(f.b1(pr) + fr) * K + 8 * fq;
        f32x4 c0 = {0.f, 0.f, 0.f, 0.f}, c1 = {0.f, 0.f, 0.f, 0.f};
        for (int k0 = 0; k0 < K; k0 += 256) {
            bf16x8 a[8], x[8], y[8];
#pragma unroll
            for (int i = 0; i < 8; ++i) { a[i] = *(const bf16x8*)(ap + k0 + i * 32); x[i] = *(const bf16x8*)(bp0 + k0 + i * 32); y[i] = *(const bf16x8*)(bp1 + k0 + i * 32); }
#pragma unroll
            for (int i = 0; i < 8; ++i) { c0 = mfma16(x[i], a[i], c0); c1 = mfma16(y[i], a[i], c1); }
        }
        f.epi(rt * 16 + fr, pr, fq, c0, c1);
    }
}
template <int KS, class F>
__device__ __forceinline__ void thin_gemm_sk(LAS unsigned char* lds, const bf16_t* A, int lda, const bf16_t* Bt, int K, int npairs, const F& f, int w, int lane) {
    const int fr = lane & 15, fq = lane >> 4, ntask = npairs * 8;
    LAS float* P = (LAS float*)lds;
    for (int task = blockIdx.x; task < ntask; task += gridDim.x) {
        const int rt = task & 7, pr = task >> 3, k0 = w * KS * 32;
        const bf16_t* ap = A + (size_t)(rt * 16 + fr) * lda + 8 * fq + k0;
        const bf16_t* bp0 = Bt + (size_t)(f.b0(pr) + fr) * K + 8 * fq + k0;
        const bf16_t* bp1 = Bt + (size_t)(f.b1(pr) + fr) * K + 8 * fq + k0;
        f32x4 c0 = {0.f, 0.f, 0.f, 0.f}, c1 = {0.f, 0.f, 0.f, 0.f};
        bf16x8 a[KS], x[KS], y[KS];
#pragma unroll
        for (int i = 0; i < KS; ++i) { a[i] = *(const bf16x8*)(ap + i * 32); x[i] = *(const bf16x8*)(bp0 + i * 32); y[i] = *(const bf16x8*)(bp1 + i * 32); }
#pragma unroll
        for (int i = 0; i < KS; ++i) { c0 = mfma16(x[i], a[i], c0); c1 = mfma16(y[i], a[i], c1); }
        *(LAS f32x4*)(P + (w * 64 + lane) * 8) = c0; *(LAS f32x4*)(P + (w * 64 + lane) * 8 + 4) = c1;
        __syncthreads();
        if (w == 0) {
            f32x4 s0 = {0.f, 0.f, 0.f, 0.f}, s1 = {0.f, 0.f, 0.f, 0.f};
#pragma unroll
            for (int q = 0; q < 8; ++q) { s0 += *(const LAS f32x4*)(P + (q * 64 + lane) * 8); s1 += *(const LAS f32x4*)(P + (q * 64 + lane) * 8 + 4); }
            f.epi(rt * 16 + fr, pr, fq, s0, s1);
        }
        __syncthreads();
    }
}
struct ThinZ { bf16_t* Z; const unsigned long long* ssq;
    __device__ __forceinline__ int b0(int pr) const { return pr * 32; }
    __device__ __forceinline__ int b1(int pr) const { return pr * 32 + 16; }
    __device__ __forceinline__ void epi(int r, int pr, int fq, f32x4 c0, f32x4 c1) const {
        const int row = NPROMPT + r; const float rs = ssq_rs(ssq, row); c0 = c0 * rs; c1 = c1 * rs;
        bf16_t* zp = Z + (size_t)row * ZLD + pr * 32 + 4 * fq; u32x2 a, b; a.x = pk2(c0[0], c0[1]); a.y = pk2(c0[2], c0[3]); b.x = pk2(c1[0], c1[1]); b.y = pk2(c1[2], c1[3]);
        *(u32x2*)zp = a; *(u32x2*)(zp + 16) = b; }
};
struct ThinRes { bf16_t* XB; unsigned long long* ssq;
    __device__ __forceinline__ int b0(int pr) const { return pr * 32; }
    __device__ __forceinline__ int b1(int pr) const { return pr * 32 + 16; }
    __device__ __forceinline__ void epi(int r, int pr, int fq, f32x4 c0, f32x4 c1) const {
        const int row = NPROMPT + r; bf16_t* bp = XB + (size_t)row * DM + pr * 32 + 4 * fq;
        float x0[4], x1[4]; unpack4(*(const u32x2*)bp, x0); unpack4(*(const u32x2*)(bp + 16), x1);
        u32x2 a, b; a.x = pk2(x0[0] + c0[0], x0[1] + c0[1]); a.y = pk2(x0[2] + c0[2], x0[3] + c0[3]); b.x = pk2(x1[0] + c1[0], x1[1] + c1[1]); b.y = pk2(x1[2] + c1[2], x1[3] + c1[3]);
        *(u32x2*)bp = a; *(u32x2*)(bp + 16) = b; float o0[4], o1[4]; unpack4(a, o0); unpack4(b, o1);
        float s = (o0[0] * o0[0] + o0[1] * o0[1]) + (o0[2] * o0[2] + o0[3] * o0[3]) + (o1[0] * o1[0] + o1[1] * o1[1]) + (o1[2] * o1[2] + o1[3] * o1[3]);
        s += __shfl_xor(s, 16); s += __shfl_xor(s, 32);
        if (fq == 0) ssq_add(ssq, row, s); }
};
struct ThinAct { bf16_t* ACT; const unsigned long long* ssq;
    __device__ __forceinline__ int b0(int pr) const { const int c = pr * 16; return (c >> 7) * 256 + (c & 127); }
    __device__ __forceinline__ int b1(int pr) const { const int c = pr * 16; return (c >> 7) * 256 + 128 + (c & 127); }
    __device__ __forceinline__ void epi(int r, int pr, int fq, f32x4 c0, f32x4 c1) const {
        const int row = NPROMPT + r; const float rs = ssq_rs(ssq, row); float o[4];
#pragma unroll
        for (int j = 0; j < 4; ++j) { const float g = c0[j] * rs, up = c1[j] * rs; o[j] = g * sigmoidf_(g) * up; }
        u32x2 a; a.x = pk2(o[0], o[1]); a.y = pk2(o[2], o[3]); *(u32x2*)(ACT + (size_t)row * DFF + pr * 16 + 4 * fq) = a; }
};

struct TileDesc { const float* src; const float* gain; bf16_t* dst; int lds_src, ld_dst; };
__device__ __forceinline__ TileDesc tile_desc(const Ctx& c, int l, unsigned char* wb, int t) {
    bf16_t* WinT = (bf16_t*)(wb + WB_WIN); bf16_t* WoutT = (bf16_t*)(wb + WB_WOUT); bf16_t* WguT = (bf16_t*)(wb + WB_WGU); bf16_t* WdnT = (bf16_t*)(wb + WB_WDN); bf16_t* GLUT = (bf16_t*)(wb + WB_GLU);
    const int NT_IN = 16 * 38, NT_OUT = 256, NT_GU = 16 * 88, NT_DN = 44 * 16;
    TileDesc d; int q = t;
    if (q < NT_IN) { const int kt = q & 15, nt = q >> 4; d.src = c.in[8] + (size_t)l * 1024 * INC + (size_t)kt * 64 * INC + nt * 64; d.lds_src = INC; d.gain = c.in[7] + l * 1024 + kt * 64; d.dst = WinT + (size_t)nt * 64 * 1024 + kt * 64; d.ld_dst = 1024; return d; }
    q -= NT_IN;
    if (q < NT_OUT) { const int kt = q & 15, nt = q >> 4; const int bm = (kt >> 2) == 0 ? 3 : ((kt >> 2) == 1 ? 1 : ((kt >> 2) == 2 ? 0 : 2)); const int ks = bm * 256 + (kt & 3) * 64;
        d.src = c.in[36] + (size_t)l * 1024 * 1024 + (size_t)ks * 1024 + nt * 64; d.lds_src = 1024; d.gain = nullptr; d.dst = WoutT + (size_t)nt * 64 * 1024 + kt * 64; d.ld_dst = 1024; return d; }
    q -= NT_OUT;
    if (q < NT_GU) { const int kt = q & 15, nt = q >> 4; const int n0 = nt * 64; int dr; if (n0 < DFF) dr = (n0 >> 7) * 256 + (n0 & 127); else { const int n1 = n0 - DFF; dr = (n1 >> 7) * 256 + 128 + (n1 & 127); }
        d.src = c.in[38] + (size_t)l * 1024 * 5632 + (size_t)kt * 64 * 5632 + n0; d.lds_src = 5632; d.gain = c.in[37] + l * 1024 + kt * 64; d.dst = WguT + (size_t)dr * 1024 + kt * 64; d.ld_dst = 1024; return d; }
    q -= NT_GU;
    if (q < NT_DN) { const int nt = q & 15, kt = q >> 4; d.src = c.in[39] + (size_t)l * DFF * 1024 + (size_t)kt * 64 * 1024 + nt * 64; d.lds_src = 1024; d.gain = nullptr; d.dst = WdnT + (size_t)nt * 64 * DFF + kt * 64; d.ld_dst = DFF; return d; }
    q -= NT_DN;
    { const int kt = q & 3, nt = q >> 2; d.src = c.in[21] + (size_t)l * 65536 + (size_t)kt * 64 * 256 + nt * 64; d.lds_src = 256; d.gain = nullptr; d.dst = GLUT + (size_t)nt * 64 * 256 + kt * 64; d.ld_dst = 256; return d; }
}
struct TileRegs { f32x4 v[2]; float g[2]; };
__device__ __forceinline__ void tile_load(TileRegs& r, const TileDesc& d, int tid) {
    const int i = tid >> 4, j4 = (tid & 15) * 4;
#pragma unroll
    for (int p = 0; p < 2; ++p) { const int k = i + p * 32; r.v[p] = __builtin_nontemporal_load((const f32x4*)(d.src + (size_t)k * d.lds_src + j4)); r.g[p] = d.gain ? d.gain[k] : 1.0f; }
}
__device__ void convert_weights(const Ctx& c, int l, int buf, int part = -1, int wgi = -1, int nwg = 0) {
    if (wgi < 0) { wgi = blockIdx.x; nwg = gridDim.x; }
    asm volatile("" : "+s"(nwg), "+s"(wgi));
    unsigned char* wb = c.WB() + (size_t)buf * WB_SIZE;
    bf16_t* WinT = (bf16_t*)(wb + WB_WIN); bf16_t* LORAT = (bf16_t*)(wb + WB_LORA); bf16_t* WSB = (bf16_t*)(wb + WB_WSB);
    const int total = 16 * 38 + 256 + 16 * 88 + 44 * 16 + 16;
    const int t_lo = (part == 1) ? total / 2 : 0, t_hi = (part == 0) ? total / 2 : total;
    LAS float* T = (LAS float*)c.lds; const int tid = c.tid;
    int t = t_lo + wgi;
    if (t < t_hi) {
        TileDesc d = tile_desc(c, l, wb, t); TileRegs r; tile_load(r, d, tid);
        for (;;) {
            { const int i = tid >> 4, j4 = (tid & 15) * 4;
#pragma unroll
              for (int p = 0; p < 2; ++p) { const int k = i + p * 32; T[k * 65 + j4 + 0] = r.v[p][0] * r.g[p]; T[k * 65 + j4 + 1] = r.v[p][1] * r.g[p]; T[k * 65 + j4 + 2] = r.v[p][2] * r.g[p]; T[k * 65 + j4 + 3] = r.v[p][3] * r.g[p]; } }
            __syncthreads();
            const int tn = t + nwg; const bool more = tn < t_hi; const TileDesc dcur = d;
            if (more) { d = tile_desc(c, l, wb, tn); tile_load(r, d, tid); }
            { const int jn = tid >> 3, kq = (tid & 7) * 8; float z[8];
#pragma unroll
              for (int e = 0; e < 8; ++e) z[e] = T[(kq + e) * 65 + jn];
              *(bf16x8*)(dcur.dst + (size_t)jn * dcur.ld_dst + kq) = pack8(z); }
            __syncthreads();
            if (!more) break;
            t = tn;
        }
    }
    if (part == 1) return;
    const int gt = wgi * 512 + c.tid, gn = nwg * 512;
    for (int i = gt; i < 128 * 1024; i += gn) WinT[(size_t)INC * 1024 + i] = 0;
    for (int i = gt; i < 256 * 128; i += gn) { const int n = i >> 7, k = i & 127; float v;
        if (k < 32) v = c.in[27][(size_t)l * 32 * 256 + k * 256 + n]; else if (k < 64) v = c.in[29][(size_t)l * 32 * 256 + (k - 32) * 256 + n]; else v = c.in[30][(size_t)l * 64 * 256 + (k - 64) * 256 + n];
        LORAT[i] = f2bf(v); }
    for (int i = gt; i < 4 * 128 * 128; i += gn) { const int s = i & 127, t = (i >> 7) & 127; WSB[i] = (s <= t) ? f2bf(c.in[11][(size_t)l * 65536 + i]) : (bf16_t)0; }
}

__device__ void phase0(const Ctx& c) {
    for (int row0 = c.gw; row0 < NR; row0 += 5 * c.nw) {
        f32x4 v[5][4];
#pragma unroll
        for (int u = 0; u < 5; ++u) { const int row = (row0 + u * c.nw < NR) ? row0 + u * c.nw : row0; const float* src = row < NPROMPT ? c.in[0] + (size_t)row * DM : c.in[1] + (size_t)(row - NPROMPT) * DM;
#pragma unroll
            for (int j = 0; j < 4; ++j) v[u][j] = __builtin_nontemporal_load((const f32x4*)(src + j * 256 + c.lane * 4)); }
#pragma unroll
        for (int u = 0; u < 5; ++u) { const int row = row0 + u * c.nw; if (row < NR) { float s = 0.f;
#pragma unroll
            for (int j = 0; j < 4; ++j) { const int col = j * 256 + c.lane * 4; u32x2 w; w.x = pk2(v[u][j][0], v[u][j][1]); w.y = pk2(v[u][j][2], v[u][j][3]); *(u32x2*)(c.XB() + (size_t)row * DM + col) = w; float o[4]; unpack4(w, o); s += (o[0] * o[0] + o[1] * o[1]) + (o[2] * o[2] + o[3] * o[3]); }
            s = wave_sum(s); if (c.lane == 0) c.SSQ()[row] = (unsigned long long)(s * SSQ_SCALE + 0.5f); } }
    }
    for (int i = blockIdx.x * 512 + c.tid; i < 8 * NR; i += gridDim.x * 512) c.SSQ()[NR + i] = 0ull;
    for (int i = blockIdx.x * 512 + c.tid; i < NL * 1024; i += gridDim.x * 512) {
        const float lam_re = fminf(c.in[13][i], -1e-4f), lam_im = c.in[14][i], dt = expf(c.in[15][i]);
        const float mag = expf(lam_re * dt); float sn, cs; sincosf(lam_im * dt, &sn, &cs);
        const float lbr = mag * cs, lbi = mag * sn, den = lam_re * lam_re + lam_im * lam_im;
        const float f_re = ((lbr - 1.0f) * lam_re + lbi * lam_im) / den, f_im = (lbi * lam_re - (lbr - 1.0f) * lam_im) / den;
        c.LBC()[2 * i] = lbr; c.LBC()[2 * i + 1] = lbi;
        const int lg = i >> 6, pp = i & 63; bf16_t* bo = c.BBAR() + ((size_t)lg * 128 + 2 * pp) * 16;
#pragma unroll
        for (int q = 0; q < 4; ++q) { const f32x4 br = *(const f32x4*)(c.in[16] + (size_t)i * 16 + q * 4), bi = *(const f32x4*)(c.in[17] + (size_t)i * 16 + q * 4); float re[4], im[4];
#pragma unroll
            for (int e = 0; e < 4; ++e) { re[e] = f_re * br[e] - f_im * bi[e]; im[e] = f_re * bi[e] + f_im * br[e]; }
            u32x2 a; a.x = pk2(re[0], re[1]); a.y = pk2(re[2], re[3]); *(u32x2*)(bo + q * 4) = a; a.x = pk2(im[0], im[1]); a.y = pk2(im[2], im[3]); *(u32x2*)(bo + 16 + q * 4) = a; }
    }
    convert_weights(c, 0, 0);
}

template <int N> struct ZsVec { typedef u32x4 T; };
template <> struct ZsVec<4> { typedef u32x2 T; };
template <int N, bool SAMP> struct ZsIn {
    typename ZsVec<N>::T cur, prb; f32x4 prf[N / 4]; f32x4 mu[N / 4]; float pm;
    __device__ __forceinline__ void load(const Ctx& c, int l, int row, int col) {
        typedef typename ZsVec<N>::T V;
        const bf16_t* zp = c.Z() + (size_t)row * ZLD + 1536 + col;
        cur = *(const V*)zp;
        pm = 1.0f;
        if (!SAMP) { const bool first = (row & (SEQ - 1)) == 0; pm = first ? 0.f : 1.f; const bf16_t* pp = first ? zp : zp - ZLD; prb = *(const V*)pp; }
        else { const float* sp = c.in[3] + ((size_t)l * NSAMP + (row - NPROMPT)) * DTM + col;
#pragma unroll
            for (int e = 0; e < N / 4; ++e) prf[e] = *(const f32x4*)(sp + 4 * e); }
        const float* m = c.in[25] + l * DTM + col;
#pragma unroll
        for (int e = 0; e < N / 4; ++e) mu[e] = *(const f32x4*)(m + 4 * e);
    }
    __device__ __forceinline__ void eval(float* out) const {
        float cu[N], pv[N];
        if constexpr (N == 8) unpack8(cur, cu); else unpack4(cur, cu);
        if (!SAMP) { if constexpr (N == 8) unpack8(prb, pv); else unpack4(prb, pv); }
        else {
#pragma unroll
            for (int e = 0; e < N; ++e) pv[e] = prf[e >> 2][e & 3]; }
#pragma unroll
        for (int e = 0; e < N; ++e) out[e] = cu[e] + mu[e >> 2][e & 3] * (pm * pv[e] - cu[e]);
    }
};

__device__ void d1_chunk(const Ctx& c, int blk, int h);
template <bool SAMP> __device__ __forceinline__ void rwkv_tok_task(const Ctx& c, int l, const bf16_t* LORAT, int blk, int h, int mt_lo, int mt_hi) {
    const int lane = c.lane, fr = lane & 15, fq = lane >> 4;
    for (int mt = mt_lo; mt < mt_hi; ++mt) {
        const int row = blk * 32 + mt * 16 + fr;
        bf16_t* tok = c.TOK() + (size_t)row * 1536;
        ZsIn<8, SAMP> za[4]; bf16x8 lf[4][4];
#pragma unroll
        for (int ks = 0; ks < 4; ++ks) za[ks].load(c, l, row, 768 + ks * 32 + 8 * fq);
#pragma unroll
        for (int nt = 0; nt < 4; ++nt)
#pragma unroll
            for (int ks = 0; ks < 4; ++ks) lf[nt][ks] = *(const bf16x8*)(LORAT + (size_t)(h * 64 + 32 * (nt >> 1) + 8 * (fr >> 2) + 4 * (nt & 1) + (fr & 3)) * 128 + ks * 32 + 8 * fq);
        bf16x8 af[4];
#pragma unroll
        for (int ks = 0; ks < 4; ++ks) { float z[8]; za[ks].eval(z);
#pragma unroll
            for (int e = 0; e < 8; ++e) z[e] = (ks == 0) ? tanh_(z[e]) : ((ks == 1) ? z[e] : sigmoidf_(z[e]));
            af[ks] = pack8(z); }
        f32x4 aw[4], aa[4], ag[4];
#pragma unroll
        for (int nt = 0; nt < 4; ++nt) { const f32x4 zero = {0.f, 0.f, 0.f, 0.f};
            aw[nt] = mfma16(lf[nt][0], af[0], zero); aa[nt] = mfma16(lf[nt][1], af[1], zero); ag[nt] = mfma16(lf[nt][2], af[2], zero); ag[nt] = mfma16(lf[nt][3], af[3], ag[nt]); }
        float n2 = 0.f, bon = 0.f; float kkr[16], av[16];
#pragma unroll
        for (int np = 0; np < 2; ++np) {
            asm volatile("" ::: "memory");
            const int cb = h * 64 + 32 * np + 8 * fq;
            ZsIn<8, SAMP> zr, zk, zv; f32x4 w0[2], a0[2], kk_[2], ka[2], rk[2];
            zr.load(c, l, row, cb); zk.load(c, l, row, 256 + cb); zv.load(c, l, row, 512 + cb);
#pragma unroll
            for (int q = 0; q < 2; ++q) { const int ch = cb + 4 * q;
                w0[q] = *(const f32x4*)(c.in[26] + l * 256 + ch); a0[q] = *(const f32x4*)(c.in[28] + l * 256 + ch); kk_[q] = *(const f32x4*)(c.in[31] + l * 256 + ch);
                ka[q] = *(const f32x4*)(c.in[32] + l * 256 + ch); rk[q] = *(const f32x4*)(c.in[33] + l * 256 + ch); }
            float rz[8], kz[8], vz[8]; zr.eval(rz); zk.eval(kz); zv.eval(vz);
            float km[8], ld[8], gg[8];
#pragma unroll
            for (int q = 0; q < 2; ++q) { const int nt = 2 * np + q;
#pragma unroll
                for (int e = 0; e < 4; ++e) { const int i8 = 4 * q + e;
                    const float x = -(w0[q][e] + aw[nt][e]); const float sp = fmaxf(x, 0.f) + __logf(1.0f + __expf(-fabsf(x))); const float wv = -sp - 0.5f; ld[i8] = -__expf(wv);
                    const float a = sigmoidf_(a0[q][e] + aa[nt][e]); gg[i8] = ag[nt][e];
                    const float kr = kz[i8] * kk_[q][e]; n2 += kr * kr; km[i8] = kz[i8] * (1.0f + (a - 1.0f) * ka[q][e]); bon += rz[i8] * km[i8] * rk[q][e];
                    kkr[nt * 4 + e] = kr; av[nt * 4 + e] = a; } }
            *(bf16x8*)(tok + cb) = pack8(rz); *(bf16x8*)(tok + 256 + cb) = pack8(km); *(bf16x8*)(tok + 512 + cb) = pack8(vz); *(bf16x8*)(tok + 1280 + cb) = pack8(ld);
            *(bf16x8*)(c.GG() + (size_t)row * 256 + cb) = pack8(gg);
        }
        n2 += __shfl_xor(n2, 16); n2 += __shfl_xor(n2, 32); bon += __shfl_xor(bon, 16); bon += __shfl_xor(bon, 32);
        const float inv = 1.0f / fmaxf(sqrtf(n2), 1e-12f);
#pragma unroll
        for (int np = 0; np < 2; ++np) { const int cb = h * 64 + 32 * np + 8 * fq; float kk[8], bv[8];
#pragma unroll
            for (int i8 = 0; i8 < 8; ++i8) { const int idx = (2 * np + (i8 >> 2)) * 4 + (i8 & 3); kk[i8] = kkr[idx] * inv; bv[i8] = kk[i8] * av[idx]; }
            *(bf16x8*)(tok + 768 + cb) = pack8(kk); *(bf16x8*)(tok + 1024 + cb) = pack8(bv); }
        if (fq == 0) c.BON()[(size_t)row * 4 + h] = bon;
        asm volatile("" ::: "memory");
    }
}
__device__ void rwkv_tok(const Ctx& c, int l, int buf) {
    const bf16_t* LORAT = (const bf16_t*)(c.WB() + (size_t)buf * WB_SIZE + WB_LORA);
    for (int task = c.gw; task < (NPROMPT / 32) * 4; task += c.nw) rwkv_tok_task<false>(c, l, LORAT, task >> 2, task & 3, 0, 2);
    for (int ht = c.w * (int)gridDim.x + (int)blockIdx.x; ht < (NSAMP / 16) * 4; ht += 8 * (int)gridDim.x) { const int b16 = ht >> 2; rwkv_tok_task<true>(c, l, LORAT, NPROMPT / 32 + (b16 >> 1), ht & 3, b16 & 1, (b16 & 1) + 1); }
}

__device__ void conv_phase(const Ctx& c, int l) {
    const float* cw = c.in[23] + l * 768; const float* cb = c.in[24] + l * 256;
    for (int task = blockIdx.x * 512 + c.tid; task < (NPROMPT / 8) * 64; task += gridDim.x * 512) {
        const int cq = (task & 63) * 4, r0 = (task >> 6) * 8;
        const f32x4 w0 = *(const f32x4*)(cw + cq), w1 = *(const f32x4*)(cw + 256 + cq), w2 = *(const f32x4*)(cw + 512 + cq), bb = *(const f32x4*)(cb + cq);
        const int t0 = r0 & (SEQ - 1); const float pm = t0 ? 1.f : 0.f; const int rp = t0 ? r0 - 2 : r0;
        u32x2 zx[10], zc[10], zb[8];
#pragma unroll
        for (int i = 0; i < 10; ++i) { const int row = (i < 2) ? rp + i : r0 + i - 2; const bf16_t* zr = c.Z() + (size_t)row * ZLD; zx[i] = *(const u32x2*)(zr + 768 + cq); zc[i] = *(const u32x2*)(zr + 1280 + cq); if (i >= 2) zb[i - 2] = *(const u32x2*)(zr + 1024 + cq); }
        float zm2[4], zm1[4];
        { float a[4], b[4]; unpack4(zx[0], a); unpack4(zc[0], b);
#pragma unroll
          for (int e = 0; e < 4; ++e) zm2[e] = pm * a[e] * b[e];
          unpack4(zx[1], a); unpack4(zc[1], b);
#pragma unroll
          for (int e = 0; e < 4; ++e) zm1[e] = pm * a[e] * b[e]; }
#pragma unroll
        for (int i = 0; i < 8; ++i) { const int row = r0 + i; bf16_t* zr = c.Z() + (size_t)row * ZLD; float a[4], b[4], g[4], z0[4], y[4];
            unpack4(zx[i + 2], a); unpack4(zc[i + 2], b); unpack4(zb[i], g);
#pragma unroll
            for (int e = 0; e < 4; ++e) { z0[e] = a[e] * b[e]; y[e] = g[e] * (bb[e] + w0[e] * zm2[e] + w1[e] * zm1[e] + w2[e] * z0[e]); zm2[e] = zm1[e]; zm1[e] = z0[e]; }
            u32x2 p; p.x = pk2(y[0], y[1]); p.y = pk2(y[2], y[3]); *(u32x2*)(zr + 1024 + cq) = p;
            const int t = row & (SEQ - 1);
            if (t >= SEQ - 2) { float* o = c.out + O_CVP + (((size_t)l * NB + (row >> 11)) * 2 + (t - (SEQ - 2))) * 256 + cq; *(f32x4*)o = (f32x4){z0[0], z0[1], z0[2], z0[3]}; } }
    }
    for (int task = blockIdx.x * 512 + c.tid; task < NSAMP * 64; task += gridDim.x * 512) {
        const int cq = (task & 63) * 4, i = task >> 6, row = NPROMPT + i; bf16_t* zr = c.Z() + (size_t)row * ZLD;
        const f32x4 w0 = *(const f32x4*)(cw + cq), w1 = *(const f32x4*)(cw + 256 + cq), w2 = *(const f32x4*)(cw + 512 + cq), bb = *(const f32x4*)(cb + cq);
        const float* sc = c.in[6] + ((size_t)l * NSAMP + i) * 512; const f32x4 b0 = *(const f32x4*)(sc + cq), b1 = *(const f32x4*)(sc + 256 + cq);
        float a[4], b[4], g[4], y[4]; f32x4 z0;
        unpack4(*(const u32x2*)(zr + 768 + cq), a); unpack4(*(const u32x2*)(zr + 1280 + cq), b); unpack4(*(const u32x2*)(zr + 1024 + cq), g);
#pragma unroll
        for (int e = 0; e < 4; ++e) { z0[e] = a[e] * b[e]; y[e] = g[e] * (bb[e] + w0[e] * b0[e] + w1[e] * b1[e] + w2[e] * z0[e]); }
        u32x2 p; p.x = pk2(y[0], y[1]); p.y = pk2(y[2], y[3]); *(u32x2*)(zr + 1024 + cq) = p;
        float* o = c.out + O_CVS + ((size_t)l * NSAMP + i) * 512; *(f32x4*)(o + cq) = b1; *(f32x4*)(o + 256 + cq) = z0;
    }
}

__device__ void shift_out(const Ctx& c, int l, int first, int stride) {
    for (int i = first; i < (NB + NSAMP) * DTM; i += stride) {
        const int s = i / DTM, col = i - s * DTM;
        if (s < NB) c.out[O_SHP + ((size_t)l * NB + s) * DTM + col] = bf2f(c.Z()[(size_t)(s * SEQ + SEQ - 1) * ZLD + 1536 + col]);
        else c.out[O_SHS + ((size_t)l * NSAMP + (s - NB)) * DTM + col] = bf2f(c.Z()[(size_t)(NPROMPT + s - NB) * ZLD + 1536 + col]);
    }
}

constexpr int LDS_U = 0, LDS_S = 32768, LDS_YG = 102400, SLD = 136, YLD = 264;
template <bool FULL> __device__ void ssm_tile(const Ctx& c, int l, int tile, int h_lo = 0, int h_hi = 2) {
    const int lane = c.lane, w = c.w, fr = lane & 15, fq = lane >> 4;
    const bool samp = tile >= 256;
    const int row0 = samp ? NPROMPT + (tile - 256) * 64 : tile * 64, b = tile >> 5, ch = tile & 31;
    LAS bf16_t* S = (LAS bf16_t*)(c.lds + LDS_S + w * (32 * SLD * 2));
    LAS unsigned* S32 = (LAS unsigned*)S;
    LAS bf16_t* YG = (LAS bf16_t*)(c.lds + LDS_YG);
    float z0_ = 0.f; asm volatile("" : "+v"(z0_)); const f32x4 zero = {z0_, z0_, z0_, z0_};
    for (int gi = 0; gi < 2; ++gi) {
        const int g = 2 * w + gi, idx = (l * 16 + g) * 64 + lane;
        const f32x2 lb = *(const f32x2*)(c.LBC() + 2 * idx); const float lbr = lb.x, lbi = lb.y;
        bf16x8 bbf[8];
#pragma unroll
        for (int it = 0; it < 8; ++it) { u32x4 v = *(const u32x4*)(c.BBAR() + ((size_t)(l * 16 + g) * 128 + it * 16 + fr) * 16 + 8 * (fq & 1)); if (fq >= 2) v = (u32x4){0u, 0u, 0u, 0u}; bbf[it] = __builtin_bit_cast(bf16x8, v); }
        float sr = 0.f, si = 0.f;
        bf16x8 cm[4];
        const f32x4 dd = *(const f32x4*)(c.in[20] + (size_t)(l * 16 + g) * 16 + 4 * fq);
        if (FULL) {
            if (!samp) {
                float pr = lbr, pi = lbi;
#pragma unroll
                for (int q = 0; q < 6; ++q) { const float nr = pr * pr - pi * pi, ni = 2.0f * pr * pi; pr = nr; pi = ni; }
                for (int cc0 = 0; cc0 < ch; cc0 += 8) { f32x2 e[8];
#pragma unroll
                    for (int u = 0; u < 8; ++u) { const int cc = (cc0 + u < ch) ? cc0 + u : cc0; e[u] = *(const f32x2*)(c.EE() + ((size_t)((b * 32 + cc) * 16 + g) * 64 + lane) * 2); }
#pragma unroll
                    for (int u = 0; u < 8; ++u) if (cc0 + u < ch) { const float nr = pr * sr - pi * si + e[u].x, ni = pr * si + pi * sr + e[u].y; sr = nr; si = ni; } }
            }
#pragma unroll
            for (int ks = 0; ks < 4; ++ks) { const size_t co = ((size_t)(l * 16 + g) * 16 + fr) * 64 + ks * 16 + 4 * fq; const f32x4 vr = *(const f32x4*)(c.in[18] + co), vi = *(const f32x4*)(c.in[19] + co);
                float z[8] = {vr[0], -vi[0], vr[1], -vi[1], vr[2], -vi[2], vr[3], -vi[3]}; cm[ks] = pack8(z); }
        }
        for (int half = h_lo; half < h_hi; ++half) {
            asm volatile("s_waitcnt lgkmcnt(0)" ::: "memory");
            u32x4 uvv[2]; u32x2 uue[2];
#pragma unroll
            for (int jt = 0; jt < 2; ++jt) { const bf16_t* up = c.Z() + (size_t)(row0 + half * 32 + jt * 16 + fr) * ZLD + 512 + g * 16; uvv[jt] = *(const u32x4*)(up + 8 * (fq & 1)); uue[jt] = *(const u32x2*)(up + 4 * fq); }
#pragma unroll
            for (int jt = 0; jt < 2; ++jt) { u32x4 uv = uvv[jt]; if (fq >= 2) uv = (u32x4){0u, 0u, 0u, 0u};
                const bf16x8 uf = __builtin_bit_cast(bf16x8, uv);
#pragma unroll
                for (int it = 0; it < 8; ++it) { const f32x4 d = mfma16(bbf[it], uf, zero); u32x2 pq; pq.x = pk2(d[0], d[1]); pq.y = pk2(d[2], d[3]); *(LAS u32x2*)(S + (jt * 16 + fr) * SLD + it * 16 + 4 * fq) = pq; } }
            asm volatile("s_waitcnt lgkmcnt(0)" ::: "memory");
            if (FULL && samp) {
#pragma unroll 1
                for (int t0 = 0; t0 < 32; t0 += 16) { float pr[16], pi[16]; const size_t sbase = ((size_t)(l * NSAMP + (row0 - NPROMPT) + half * 32 + t0) * 16 + g) * 64 + lane;
#pragma unroll
                    for (int u = 0; u < 16; ++u) { pr[u] = c.in[4][sbase + (size_t)u * 1024]; pi[u] = c.in[5][sbase + (size_t)u * 1024]; }
#pragma unroll
                    for (int u = 0; u < 16; ++u) { const unsigned wv = S32[(t0 + u) * (SLD / 2) + lane];
                        const float nr = lbr * pr[u] - lbi * pi[u] + bflo(wv), ni = lbr * pi[u] + lbi * pr[u] + bfhi(wv);
                        S32[(t0 + u) * (SLD / 2) + lane] = pk2(nr, ni); c.out[O_RES + sbase + (size_t)u * 1024] = nr; c.out[O_IMS + sbase + (size_t)u * 1024] = ni; }
                    asm volatile("" ::: "memory"); }
            } else {
#pragma unroll 1
            for (int tt0 = 0; tt0 < 32; tt0 += 8) { unsigned wv[8];
#pragma unroll
                for (int u = 0; u < 8; ++u) wv[u] = S32[(tt0 + u) * (SLD / 2) + lane];
#pragma unroll
                for (int u = 0; u < 8; ++u) { const float nr = lbr * sr - lbi * si + bflo(wv[u]), ni = lbr * si + lbi * sr + bfhi(wv[u]); sr = nr; si = ni;
                    if (FULL) S32[(tt0 + u) * (SLD / 2) + lane] = pk2(sr, si); }
            }
            }
            if (FULL) {
                asm volatile("s_waitcnt lgkmcnt(0)" ::: "memory");
#pragma unroll
                for (int mt = 0; mt < 2; ++mt) { f32x4 acc = zero;
#pragma unroll
                    for (int ks = 0; ks < 4; ++ks) { const bf16x8 sf = *(const LAS bf16x8*)(S + (mt * 16 + fr) * SLD + ks * 32 + 8 * fq); acc = mfma16(cm[ks], sf, acc); }
                    const int t = half * 32 + mt * 16 + fr; float uu[4]; unpack4(uue[mt], uu);
                    float y[4];
#pragma unroll
                    for (int e = 0; e < 4; ++e) y[e] = gelu_t(acc[e] + dd[e] * uu[e]);
                    u32x2 p; p.x = pk2(y[0], y[1]); p.y = pk2(y[2], y[3]); *(LAS u32x2*)(YG + t * YLD + g * 16 + 4 * fq) = p; }
            }
        }
        if (!FULL) { *(f32x2*)(c.EE() + ((size_t)((b * 32 + ch) * 16 + g) * 64 + lane) * 2) = (f32x2){sr, si}; }
        else if (!samp && ch == 31) { const size_t so = ((size_t)(l * NB + b) * 16 + g) * 64 + lane; c.out[O_REP + so] = sr; c.out[O_IMP + so] = si; }
    }
}
__device__ void ssm_glu(const Ctx& c, int l, int buf, int tile, int mt_lo = 0, int mt_hi = 4) {
    const bf16_t* GLUT = (const bf16_t*)(c.WB() + (size_t)buf * WB_SIZE + WB_GLU);
    const int lane = c.lane, w = c.w, fr = lane & 15, fq = lane >> 4;
    const int row0 = tile >= 256 ? NPROMPT + (tile - 256) * 64 : tile * 64;
    LAS bf16_t* YG = (LAS bf16_t*)(c.lds + LDS_YG);
    f32x4 acc[4][2];
#pragma unroll
    for (int mt = 0; mt < 4; ++mt) { acc[mt][0] = zero4(); acc[mt][1] = zero4(); }
#pragma unroll
    for (int ks = 0; ks < 8; ++ks) { bf16x8 bf[2];
#pragma unroll
        for (int nn = 0; nn < 2; ++nn) bf[nn] = *(const bf16x8*)(GLUT + (size_t)((2 * w + nn) * 16 + fr) * 256 + ks * 32 + 8 * fq);
#pragma unroll
        for (int mt = 0; mt < 4; ++mt) { const bf16x8 af = *(const LAS bf16x8*)(YG + (mt * 16 + fr) * YLD + ks * 32 + 8 * fq); acc[mt][0] = mfma16(bf[0], af, acc[mt][0]); acc[mt][1] = mfma16(bf[1], af, acc[mt][1]); } }
    f32x4 gbv[2];
#pragma unroll
    for (int nn = 0; nn < 2; ++nn) gbv[nn] = *(const f32x4*)(c.in[22] + l * 256 + (2 * w + nn) * 16 + 4 * fq);
#pragma unroll
    for (int mt = 0; mt < 4; ++mt)
#pragma unroll
        for (int nn = 0; nn < 2; ++nn) if (mt >= mt_lo && mt < mt_hi) { const int t = mt * 16 + fr, j = (2 * w + nn) * 16 + 4 * fq; float yg[4]; unpack4(*(const LAS u32x2*)(YG + t * YLD + j), yg);
            const f32x4 gb = gbv[nn]; float o[4];
#pragma unroll
            for (int e = 0; e < 4; ++e) o[e] = yg[e] * sigmoidf_(acc[mt][nn][e] + gb[e]);
            u32x2 p; p.x = pk2(o[0], o[1]); p.y = pk2(o[2], o[3]); *(u32x2*)(c.Z() + (size_t)(row0 + t) * ZLD + 512 + j) = p; }
}

template <bool WHOLE> __device__ void gmlp_tile(const Ctx& c, int l, int buf, int tile) {
    const bf16_t* WSB = (const bf16_t*)(c.WB() + (size_t)buf * WB_SIZE + WB_WSB);
    const int lane = c.lane, w = c.w, fr = lane & 15, fq = lane >> 4;
    const int b = WHOLE ? tile >> 4 : tile >> 5, cc = WHOLE ? (tile & 15) : ((tile & 31) >> 1), h_lo = WHOLE ? 0 : (tile & 1), h_hi = WHOLE ? 2 : (tile & 1) + 1, nKall = 64 * h_hi, rowc0 = b * SEQ + cc * 128;
    LAS bf16_t* VNt = (LAS bf16_t*)c.lds;
    const float* lg = c.in[9] + l * 256; const float* lb = c.in[10] + l * 256;
    u32x2 zuA[2][2][4]; float bsA[2][2];
    if constexpr (WHOLE) {
#pragma unroll
        for (int hh = 0; hh < 2; ++hh)
#pragma unroll
            for (int mi = 0; mi < 2; ++mi) { const int tt = hh * 64 + ((w & 1) * 2 + mi) * 16 + fr; bsA[hh][mi] = c.in[12][(size_t)l * 512 + (w >> 1) * 128 + tt]; const bf16_t* zr = c.Z() + (size_t)(rowc0 + tt) * ZLD;
#pragma unroll
                for (int nt = 0; nt < 4; ++nt) zuA[hh][mi][nt] = *(const u32x2*)(zr + (w >> 1) * 64 + nt * 16 + 4 * fq); }
    }
    constexpr int LNB = WHOLE ? 16 : 8;
    for (int s0 = w; s0 < nKall; s0 += 8 * LNB) { unsigned raw[LNB][4];
#pragma unroll
        for (int u = 0; u < LNB; ++u) { const bf16_t* zp = c.Z() + (size_t)(rowc0 + s0 + 8 * u) * ZLD + 256;
#pragma unroll
            for (int j = 0; j < 4; ++j) raw[u][j] = zp[lane + 64 * j]; }
#pragma unroll
        for (int u = 0; u < LNB; ++u) { const int s = s0 + 8 * u; float v[4]; float sum = 0.f;
            float q = 0.f;
#pragma unroll
            for (int j = 0; j < 4; ++j) { v[j] = gelu_t(__uint_as_float(raw[u][j] << 16)); sum += v[j]; q += v[j] * v[j]; }
            const float mean = wave_sum(sum) * (1.0f / 256.0f);
            const float rstd = rsqrtf(fmaxf(wave_sum(q) * (1.0f / 256.0f) - mean * mean, 0.f) + 1e-5f);
#pragma unroll
            for (int j = 0; j < 4; ++j) { const int chn = lane + 64 * j; VNt[chn * VLD + s] = f2bf((v[j] - mean) * rstd * lg[chn] + lb[chn]); } } }
    __syncthreads();
    const int h = w >> 1, mts = (w & 1) * 2;
#pragma unroll
    for (int half = 0; half < 2; ++half) { if (!WHOLE && (half < h_lo || half >= h_hi)) continue;
    const int nK = 64 * (half + 1);
    f32x4 acc[2][4];
#pragma unroll
    for (int mi = 0; mi < 2; ++mi)
#pragma unroll
        for (int nt = 0; nt < 4; ++nt) acc[mi][nt] = zero4();
    bf16x8 wf[4][2];
#pragma unroll
    for (int ks = 0; ks < 4; ++ks)
#pragma unroll
        for (int mi = 0; mi < 2; ++mi) { const int tt = half * 64 + (mts + mi) * 16 + fr; const int kse = (ks < nK / 32) ? ks : 0; wf[ks][mi] = *(const bf16x8*)(WSB + (size_t)(h * 128 + tt) * 128 + kse * 32 + 8 * fq); }
#pragma unroll
    for (int ks = 0; ks < 4; ++ks) if (ks < nK / 32) { bf16x8 bf[4];
#pragma unroll
        for (int nt = 0; nt < 4; ++nt) bf[nt] = lds_ld16(VNt + (h * 64 + nt * 16 + fr) * VLD + ks * 32 + 8 * fq);
#pragma unroll
        for (int mi = 0; mi < 2; ++mi)
#pragma unroll
            for (int nt = 0; nt < 4; ++nt) acc[mi][nt] = mfma16(bf[nt], wf[ks][mi], acc[mi][nt]); }
    { u32x2 zu[2][4]; float bsv[2];
#pragma unroll
      for (int mi = 0; mi < 2; ++mi) { const int tt = half * 64 + (mts + mi) * 16 + fr; bsv[mi] = c.in[12][(size_t)l * 512 + h * 128 + tt]; const bf16_t* zr = c.Z() + (size_t)(rowc0 + tt) * ZLD;
#pragma unroll
          for (int nt = 0; nt < 4; ++nt) { if constexpr (WHOLE) zu[mi][nt] = zuA[half][mi][nt]; else zu[mi][nt] = *(const u32x2*)(zr + h * 64 + nt * 16 + 4 * fq); }
          if constexpr (WHOLE) bsv[mi] = bsA[half][mi]; }
#pragma unroll
      for (int mi = 0; mi < 2; ++mi) { const int tt = half * 64 + (mts + mi) * 16 + fr; bf16_t* zr = c.Z() + (size_t)(rowc0 + tt) * ZLD;
#pragma unroll
          for (int nt = 0; nt < 4; ++nt) { const int chn = h * 64 + nt * 16 + 4 * fq; float u[4]; unpack4(zu[mi][nt], u); float o[4];
#pragma unroll
              for (int e = 0; e < 4; ++e) o[e] = gelu_t(u[e]) * (acc[mi][nt][e] + bsv[mi]);
              u32x2 p; p.x = pk2(o[0], o[1]); p.y = pk2(o[2], o[3]); *(u32x2*)(zr + 768 + chn) = p; } } }
    }
    __syncthreads();
}
__device__ void gmlp_sample(const Ctx& c, int l, int first, int stride) {
    const int lane = c.lane, h = lane >> 4;
    for (int i = first; i < NSAMP; i += stride) { const int row = NPROMPT + i; bf16_t* zr = c.Z() + (size_t)row * ZLD; float v[4], u[4]; unpack4(*(const u32x2*)(zr + 256 + 4 * lane), v); unpack4(*(const u32x2*)(zr + 4 * lane), u);
        float sum = 0.f;
#pragma unroll
        for (int e = 0; e < 4; ++e) { v[e] = gelu_t(v[e]); sum += v[e]; }
        const float mean = wave_sum(sum) * (1.0f / 256.0f); float q = 0.f;
#pragma unroll
        for (int e = 0; e < 4; ++e) { const float d = v[e] - mean; q += d * d; }
        const float rstd = rsqrtf(wave_sum(q) * (1.0f / 256.0f) + 1e-5f);
        const f32x4 lg = *(const f32x4*)(c.in[9] + l * 256 + 4 * lane), lb = *(const f32x4*)(c.in[10] + l * 256 + 4 * lane);
        const float ws0 = c.in[11][(size_t)l * 65536 + h * 16384], bs0 = c.in[12][(size_t)l * 512 + h * 128]; f32x4 vn; float o[4];
#pragma unroll
        for (int e = 0; e < 4; ++e) { vn[e] = (v[e] - mean) * rstd * lg[e] + lb[e]; o[e] = gelu_t(u[e]) * (ws0 * vn[e] + bs0); }
        *(f32x4*)(c.out + O_CHV + ((size_t)l * NSAMP + i) * 256 + 4 * lane) = vn;
        u32x2 p; p.x = pk2(o[0], o[1]); p.y = pk2(o[2], o[3]); *(u32x2*)(zr + 768 + 4 * lane) = p; }
}


constexpr int CH_W = 0, CH_R = 4096, CH_ARB = 8192, CH_BT = 10240, CH_Y = 14336, CH_P1 = 18432, CH_P2 = 22528, CH_DG = 30720;
__device__ __forceinline__ u32x2 pk4(f32x4 v) { u32x2 p; p.x = pk2(v[0], v[1]); p.y = pk2(v[2], v[3]); return p; }
__device__ __forceinline__ bf16x8 pk8(f32x4 a, f32x4 b) { const u32x2 x = pk4(a), y = pk4(b); u32x4 r; r.x = x.x; r.y = x.y; r.z = y.x; r.w = y.y; return __builtin_bit_cast(bf16x8, r); }
#define LDSW() asm volatile("s_waitcnt lgkmcnt(0)" ::: "memory")
typedef short s16x4 __attribute__((ext_vector_type(4)));
__device__ __forceinline__ bf16x8 tr_frag(const LAS bf16_t* buf, int rb0, int rb1, int c, int lane) {
    const int q = (lane & 15) >> 2, p = lane & 3;
    const s16x4 lo = __builtin_amdgcn_ds_read_tr16_b64_v4i16((LAS s16x4*)(buf + (rb0 + q) * 68 + 16 * c + 4 * p));
    const s16x4 hi = __builtin_amdgcn_ds_read_tr16_b64_v4i16((LAS s16x4*)(buf + (rb1 + q) * 68 + 16 * c + 4 * p));
    return __builtin_shufflevector(lo, hi, 0, 1, 2, 3, 4, 5, 6, 7);
}
__device__ void d1_chunk(const Ctx& c, int blk, int h) {
    const int lane = c.lane, fr = lane & 15, fq = lane >> 4;
    const int b = blk >> 6, ck = blk & 63, row0 = blk * 32;
    unsigned char* chp = c.CH() + (size_t)((b * 4 + h) * 64 + ck) * CHS;
    LAS unsigned char* lw = c.lds + c.w * 17408;
    LAS bf16_t* AT = (LAS bf16_t*)lw; LAS bf16_t* BT_ = AT + 32 * 68; LAS bf16_t* KT_ = BT_ + 32 * 68; LAS bf16_t* RT_ = KT_ + 32 * 68;
    const bf16_t* tok = c.TOK() + (size_t)row0 * 1536 + h * 64 + lane;
    float z0_ = 0.f; asm volatile("" : "+v"(z0_)); const f32x4 zero = {z0_, z0_, z0_, z0_};
    float GT;
    LDSW();
    { float G = 0.f;
#pragma unroll 1
      for (int t0 = 0; t0 < 32; t0 += 16) { unsigned raw[16][5];
#pragma unroll
          for (int u = 0; u < 16; ++u) { const bf16_t* q = tok + (size_t)(t0 + u) * 1536; raw[u][0] = q[0]; raw[u][1] = q[256]; raw[u][2] = q[768]; raw[u][3] = q[1024]; raw[u][4] = q[1280]; }
#pragma unroll
          for (int u = 0; u < 16; ++u) { const int t = t0 + u; const float ld = __uint_as_float(raw[u][4] << 16); const float Gm = G; G += ld;
              const float r = __uint_as_float(raw[u][0] << 16), km = __uint_as_float(raw[u][1] << 16), a = -__uint_as_float(raw[u][2] << 16), bv = __uint_as_float(raw[u][3] << 16); const float eG = __expf(G), ie = __expf(-G), eGm = __expf(Gm);
              AT[t * 68 + lane] = f2bf(a * eGm); BT_[t * 68 + lane] = f2bf(bv * ie); KT_[t * 68 + lane] = f2bf(km * ie); RT_[t * 68 + lane] = f2bf(r * eG); }
          asm volatile("" ::: "memory"); }
      GT = G; }
    LDSW();
    f32x4 acc[2][2][2][2];
#pragma unroll
    for (int i = 0; i < 16; ++i) acc[i >> 3][(i >> 2) & 1][(i >> 1) & 1][i & 1] = zero;
#pragma unroll
    for (int ks = 0; ks < 2; ++ks) { bf16x8 af[2][2], bf[2][2];
#pragma unroll
        for (int m = 0; m < 2; ++m) { const int o = (m * 16 + fr) * 68 + ks * 32 + fq * 8; af[0][m] = lds_ld16(BT_ + o); af[1][m] = lds_ld16(KT_ + o); bf[0][m] = lds_ld16(AT + o); bf[1][m] = lds_ld16(RT_ + o); }
#pragma unroll
        for (int i = 0; i < 16; ++i) { const int as = i >> 3, bs = (i >> 2) & 1, mt = (i >> 1) & 1, nt = i & 1; acc[as][bs][mt][nt] = mfma16(af[as][mt], bf[bs][nt], acc[as][bs][mt][nt]); } }
#pragma unroll
    for (int nt = 0; nt < 2; ++nt)
#pragma unroll
        for (int ks = 0; ks < 2; ++ks) { const int t = 16 * nt + fr; const u32x2 lo = *(const LAS u32x2*)(RT_ + t * 68 + 32 * ks + 4 * fq), hi = *(const LAS u32x2*)(RT_ + t * 68 + 32 * ks + 16 + 4 * fq);
            u32x4 v; v.x = lo.x; v.y = lo.y; v.z = hi.x; v.w = hi.y; *(u32x4*)((bf16_t*)(chp + CH_R) + t * 64 + (((ks * 4 + fq) ^ (fr & 7)) * 8)) = v; }
    LDSW();
    bf16x8 aT[4], kT[4], bTp[4];
#pragma unroll
    for (int mt = 0; mt < 4; ++mt) { aT[mt] = tr_frag(AT, 8 * fq, 8 * fq + 4, mt, lane); kT[mt] = tr_frag(KT_, 8 * fq, 8 * fq + 4, mt, lane); bTp[mt] = tr_frag(BT_, 4 * fq, 16 + 4 * fq, mt, lane); }
    LDSW();
    LAS float* L = (LAS float*)lw; LAS bf16_t* AAK = (LAS bf16_t*)(lw + 4608); LAS bf16_t* ARK = (LAS bf16_t*)(lw + 7168); LAS bf16_t* TINV = (LAS bf16_t*)(lw + 9728);
    LAS float* DGL = (LAS float*)(lw + 12288); LAS bf16_t* VR = RT_;
    DGL[lane] = __expf(GT);
    {
#pragma unroll 1
      for (int t0 = 0; t0 < 32; t0 += 16) { unsigned rv[16];
#pragma unroll
          for (int u = 0; u < 16; ++u) rv[u] = tok[(size_t)(t0 + u) * 1536 + 512];
#pragma unroll
          for (int u = 0; u < 16; ++u) VR[(t0 + u) * 68 + lane] = (bf16_t)rv[u];
          asm volatile("" ::: "memory"); } }
#pragma unroll
    for (int nt = 0; nt < 2; ++nt) { const int t = 16 * nt + fr;
#pragma unroll
        for (int mt = 0; mt < 2; ++mt) { const int s0 = 16 * mt + 4 * fq; f32x4 v = acc[0][0][mt][nt], k = acc[1][0][mt][nt], q = acc[1][1][mt][nt];
#pragma unroll
            for (int e = 0; e < 4; ++e) { if (!(s0 + e < t)) { v[e] = z0_; k[e] = z0_; } if (!(s0 + e <= t)) q[e] = z0_; }
            *(LAS f32x4*)(L + t * 36 + s0) = v; *(LAS u32x2*)(AAK + t * 40 + s0) = pk4(k); *(LAS u32x2*)(ARK + t * 40 + s0) = pk4(q); }
        f32x4 v0 = acc[0][1][0][nt], v1 = acc[0][1][1][nt];
#pragma unroll
        for (int e = 0; e < 4; ++e) { if (!(4 * fq + e <= t)) v0[e] = z0_; if (!(16 + 4 * fq + e <= t)) v1[e] = z0_; }
        const u32x2 a = pk4(v0), bb = pk4(v1); u32x4 w; w.x = a.x; w.y = a.y; w.z = bb.x; w.w = bb.y; *(u32x4*)((bf16_t*)(chp + CH_ARB) + t * 32 + ((fq ^ ((fr >> 2) & 3)) * 8)) = w; }
    LDSW();
    bf16x8 vT[4];
#pragma unroll
    for (int nt = 0; nt < 4; ++nt) vT[nt] = tr_frag(VR, 8 * fq, 8 * fq + 4, nt, lane);
#pragma unroll
    for (int mt = 0; mt < 4; ++mt) { const f32x4 dg4 = *(const LAS f32x4*)(DGL + 16 * mt + 4 * fq);
#pragma unroll
        for (int nt = 0; nt < 4; ++nt) { const f32x4 p = mfma16(kT[mt], vT[nt], zero) * dg4; *(u32x2*)(chp + CH_P2 + ((nt * 4 + mt) * 64 + lane) * 8) = pk4(p); }
        const int chn = 16 * mt + fr; const float dgs = DGL[chn]; float z[8]; unpack8(__builtin_bit_cast(u32x4, bTp[mt]), z);
#pragma unroll
        for (int e = 0; e < 8; ++e) z[e] *= dgs;
        *(bf16x8*)((bf16_t*)(chp + CH_BT) + chn * 32 + ((fq ^ ((fr >> 2) & 3)) * 8)) = pack8(z); }
#pragma unroll
    for (int nt = 0; nt < 4; ++nt)
#pragma unroll
        for (int mt = 0; mt < 2; ++mt) { const f32x4 p = mfma16(*(const LAS bf16x8*)(ARK + (mt * 16 + fr) * 40 + fq * 8), vT[nt], zero); *(u32x2*)(chp + CH_P1 + ((nt * 2 + mt) * 64 + lane) * 8) = pk4(p); }
    LDSW();
    { float x[32]; const int j = lane & 31;
#pragma unroll
      for (int t = 0; t < 32; ++t) x[t] = 0.f;
#pragma unroll
      for (int t = 0; t < 32; ++t) { int jj = j; asm volatile("" : "+v"(jj)); float a = (t == jj) ? 1.f : 0.f;
#pragma unroll
          for (int s4 = 0; s4 < (t + 3) / 4; ++s4) { const f32x4 Lr = *(const LAS f32x4*)(L + t * 36 + 4 * s4); a += Lr[0] * x[4 * s4] + Lr[1] * x[4 * s4 + 1] + Lr[2] * x[4 * s4 + 2] + Lr[3] * x[4 * s4 + 3]; }
          asm volatile("" : "+v"(a) :: "memory"); x[t] = a; }
#pragma unroll
      for (int t = 0; t < 32; ++t) TINV[t * 40 + j] = f2bf(x[t]); }
    { f32x4 w[4][2];
#pragma unroll
      for (int mt = 0; mt < 4; ++mt)
#pragma unroll
          for (int nt = 0; nt < 2; ++nt) w[mt][nt] = mfma16(aT[mt], *(const LAS bf16x8*)(TINV + (nt * 16 + fr) * 40 + fq * 8), zero);
#pragma unroll
      for (int nt = 0; nt < 2; ++nt)
#pragma unroll
          for (int ks = 0; ks < 2; ++ks) { const u32x2 a = pk4(w[2 * ks][nt]), bb = pk4(w[2 * ks + 1][nt]); u32x4 v; v.x = a.x; v.y = a.y; v.z = bb.x; v.w = bb.y;
              *(u32x4*)((bf16_t*)(chp + CH_W) + (16 * nt + fr) * 64 + (((ks * 4 + fq) ^ (fr & 7)) * 8)) = v; } }
    { bf16x8 tp[2];
#pragma unroll
      for (int mt = 0; mt < 2; ++mt) { const u32x2 lo = *(const LAS u32x2*)(TINV + (mt * 16 + fr) * 40 + 4 * fq), hi = *(const LAS u32x2*)(TINV + (mt * 16 + fr) * 40 + 16 + 4 * fq); u32x4 v; v.x = lo.x; v.y = lo.y; v.z = hi.x; v.w = hi.y; tp[mt] = __builtin_bit_cast(bf16x8, v); }
#pragma unroll
      for (int nt = 0; nt < 4; ++nt) { f32x4 x[2];
#pragma unroll
          for (int mt = 0; mt < 2; ++mt) x[mt] = mfma16(*(const LAS bf16x8*)(AAK + (mt * 16 + fr) * 40 + fq * 8), vT[nt], zero);
          const bf16x8 xb = pk8(x[0], x[1]);
#pragma unroll
          for (int mt = 0; mt < 2; ++mt) { const f32x4 y = mfma16(tp[mt], xb, zero); *(u32x2*)(chp + CH_Y + ((nt * 2 + mt) * 64 + lane) * 8) = pk4(y);
 } } }
    ((bf16_t*)(chp + CH_DG))[lane] = f2bf(__expf(GT));
    LDSW();
}

__device__ void rwkv_d1(const Ctx& c) {
    asm volatile("s_waitcnt vmcnt(0)" ::: "memory");
    for (int task = c.gw; task < (NPROMPT / 32) * 4; task += c.nw) d1_chunk(c, task >> 2, task & 3);
}

struct D2F { bf16x8 w[2][2], rr[2][2], arb[2], bt[4]; u32x2 y[2], p1[2], p2[4], dg[4]; };
constexpr int D2_SLOT = 19456, D2_NSLOT = 7;
__device__ __forceinline__ void d2_dma(LAS unsigned char* slot, const unsigned char* chp, int slab, int lane) {
    const unsigned char* g = chp + lane * 16;
#pragma unroll
    for (int i = 0; i < 14; ++i) __builtin_amdgcn_global_load_lds((const unsigned*)(g + i * 1024), (LAS unsigned*)(slot + i * 1024), 16, 0, 0);
    __builtin_amdgcn_global_load_lds((const unsigned*)(g + CH_Y + slab * 1024), (LAS unsigned*)(slot + 14336), 16, 0, 0);
    __builtin_amdgcn_global_load_lds((const unsigned*)(g + CH_P1 + slab * 1024), (LAS unsigned*)(slot + 15360), 16, 0, 0);
    __builtin_amdgcn_global_load_lds((const unsigned*)(g + CH_P2 + slab * 2048), (LAS unsigned*)(slot + 16384), 16, 0, 0);
    __builtin_amdgcn_global_load_lds((const unsigned*)(g + CH_P2 + slab * 2048 + 1024), (LAS unsigned*)(slot + 17408), 16, 0, 0);
    __builtin_amdgcn_global_load_lds((const unsigned*)(g + CH_DG), (LAS unsigned*)(slot + 18432), 16, 0, 0);
}
__device__ __forceinline__ void d2_load(D2F& f, const LAS unsigned char* slot, int fr, int fq, int lane) {
    const int x8 = fr & 7, x4 = (fr >> 2) & 3;
#pragma unroll
    for (int mt = 0; mt < 2; ++mt) {
#pragma unroll
        for (int ks = 0; ks < 2; ++ks) { const int o = (16 * mt + fr) * 128 + (((ks * 4 + fq) ^ x8) * 16); f.w[mt][ks] = *(const LAS bf16x8*)(slot + CH_W + o); f.rr[mt][ks] = *(const LAS bf16x8*)(slot + CH_R + o); }
        f.arb[mt] = *(const LAS bf16x8*)(slot + CH_ARB + (16 * mt + fr) * 64 + ((fq ^ x4) * 16));
        f.y[mt] = *(const LAS u32x2*)(slot + 14336 + mt * 512 + lane * 8); f.p1[mt] = *(const LAS u32x2*)(slot + 15360 + mt * 512 + lane * 8); }
#pragma unroll
    for (int mt = 0; mt < 4; ++mt) { f.bt[mt] = *(const LAS bf16x8*)(slot + CH_BT + (16 * mt + fr) * 64 + ((fq ^ x4) * 16));
        f.p2[mt] = *(const LAS u32x2*)(slot + 16384 + mt * 512 + lane * 8); f.dg[mt] = *(const LAS u32x2*)(slot + 18432 + mt * 32 + fq * 8); }
}
__device__ __forceinline__ f32x4 up4(u32x2 u) { return (f32x4){bflo(u.x), bfhi(u.x), bflo(u.y), bfhi(u.y)}; }
__device__ __forceinline__ void d2_step(const D2F& f, f32x4 (&H)[4], float* op, int fq) {
    const bf16x8 hb0 = pk8(H[0], H[1]), hb1 = pk8(H[2], H[3]);
    f32x4 U[2], O[2];
#pragma unroll
    for (int mt = 0; mt < 2; ++mt) { U[mt] = up4(f.y[mt]); U[mt] = mfma16(f.w[mt][0], hb0, U[mt]); U[mt] = mfma16(f.w[mt][1], hb1, U[mt]);
        O[mt] = up4(f.p1[mt]); O[mt] = mfma16(f.rr[mt][0], hb0, O[mt]); O[mt] = mfma16(f.rr[mt][1], hb1, O[mt]); }
    const bf16x8 ub = pk8(U[0], U[1]);
#pragma unroll
    for (int mt = 0; mt < 2; ++mt) { O[mt] = mfma16(f.arb[mt], ub, O[mt]);
#pragma unroll
        for (int r = 0; r < 4; ++r) op[(size_t)(16 * mt + 4 * fq + r) * 256] = O[mt][r]; }
#pragma unroll
    for (int mt = 0; mt < 4; ++mt) { u32x2 p2 = f.p2[mt], dg = f.dg[mt]; asm volatile("" : "+v"(p2.x), "+v"(p2.y), "+v"(dg.x), "+v"(dg.y)); const f32x4 hn = up4(p2) + up4(dg) * H[mt]; H[mt] = mfma16(f.bt[mt], ub, hn); }
}
__device__ void rwkv_d2(const Ctx& c, int l) {
    const int lane = c.lane, fr = lane & 15, fq = lane >> 4, G = gridDim.x;
    if (c.w != 0) return;
    for (int task = blockIdx.x; task < NB * 4 * 4; task += G) {
        const int slab = task & 3, h = (task >> 2) & 3, b = task >> 4;
        const unsigned char* chb = c.CH() + (size_t)((b * 4 + h) * 64) * CHS;
        f32x4 H[4];
#pragma unroll
        for (int mt = 0; mt < 4; ++mt) H[mt] = zero4();
        float* op = c.OO() + (size_t)(b * SEQ) * 256 + h * 64 + slab * 16 + fr;
        asm volatile("s_waitcnt vmcnt(0) lgkmcnt(0)" ::: "memory");
        d2_dma(c.lds, chb, slab, lane); d2_dma(c.lds + D2_SLOT, chb + CHS, slab, lane);
        for (int ck = 0; ck < 64; ++ck) {
            if (ck + 2 < 64) d2_dma(c.lds + ((ck + 2) % D2_NSLOT) * D2_SLOT, chb + (size_t)(ck + 2) * CHS, slab, lane);
            if (ck == 0) asm volatile("s_waitcnt vmcnt(38)" ::: "memory");
            else if (ck == 1) asm volatile("s_waitcnt vmcnt(46)" ::: "memory");
            else if (ck < 62) asm volatile("s_waitcnt vmcnt(54)" ::: "memory");
            else asm volatile("s_waitcnt vmcnt(0)" ::: "memory");
            D2F f; d2_load(f, c.lds + (ck % D2_NSLOT) * D2_SLOT, fr, fq, lane);
            d2_step(f, H, op + (size_t)(ck * 32) * 256, fq);
        }
        float* so = c.out + O_WKVP + (((size_t)(l * NB + b) * 4 + h) * 64 + slab * 16 + fr) * 64;
#pragma unroll
        for (int mt = 0; mt < 4; ++mt) *(f32x4*)(so + 16 * mt + 4 * fq) = H[mt];
    }
}

__device__ void rwkv_scan(const Ctx& c, int l, int first, int stride) {
    const int lane = c.lane;
    for (int task = first; task < NSAMP * 16; task += stride) {
        const int i = task >> 4, h = (task >> 2) & 3, q4 = task & 3, row = NPROMPT + i;
        const bf16_t* tk = c.TOK() + (size_t)row * 1536 + h * 64;
        const float r = bf2f(tk[lane]), km = bf2f(tk[256 + lane]), kk = bf2f(tk[768 + lane]), bv = bf2f(tk[1024 + lane]), d = __expf(bf2f(tk[1280 + lane]));
        const size_t sb = (((size_t)(l * NSAMP + i) * 4 + h) * 64) * 64;
        float S0[16]; unsigned vraw[16];
#pragma unroll
        for (int j = 0; j < 16; ++j) { const int vr = q4 * 16 + j; S0[j] = c.in[2][sb + (size_t)vr * 64 + lane]; vraw[j] = tk[512 + vr]; }
#pragma unroll
        for (int j = 0; j < 16; ++j) { const int vr = q4 * 16 + j; float S = S0[j]; const float vv = __uint_as_float(vraw[j] << 16);
            const float sa = -wave_sum(S * kk); S = S * d + sa * bv + vv * km; const float o = wave_sum(S * r);
            c.out[O_WKVS + sb + (size_t)vr * 64 + lane] = S; if (lane == 0) c.OO()[(size_t)row * 256 + h * 64 + vr] = o; }
    }
}

__device__ void rwkv_final(const Ctx& c, int l) {
    const int lane = c.lane, h = lane >> 4;
    const f32x4 lg = *(const f32x4*)(c.in[34] + l * 256 + 4 * lane), lb = *(const f32x4*)(c.in[35] + l * 256 + 4 * lane);
    for (int row0 = c.gw; row0 < NR; row0 += 9 * c.nw) {
        f32x4 o[9]; u32x2 vv[9], gq[9]; float bon[9];
#pragma unroll
        for (int u = 0; u < 9; ++u) { const int row = (row0 + u * c.nw < NR) ? row0 + u * c.nw : row0; o[u] = *(const f32x4*)(c.OO() + (size_t)row * 256 + 4 * lane);
            vv[u] = *(const u32x2*)(c.TOK() + (size_t)row * 1536 + 512 + 4 * lane); gq[u] = *(const u32x2*)(c.GG() + (size_t)row * 256 + 4 * lane); bon[u] = c.BON()[(size_t)row * 4 + h]; }
#pragma unroll
        for (int u = 0; u < 9; ++u) { const int row = row0 + u * c.nw; if (row < NR) {
            const float m = row16_sum((o[u][0] + o[u][1]) + (o[u][2] + o[u][3])) * (1.0f / 64.0f);
            const f32x4 d = o[u] - m; const float var = row16_sum((d[0] * d[0] + d[1] * d[1]) + (d[2] * d[2] + d[3] * d[3])) * (1.0f / 64.0f);
            const float rstd = rsqrtf(var + 64e-5f);
            float v[4], g[4]; unpack4(vv[u], v); unpack4(gq[u], g);
            float y[4];
#pragma unroll
            for (int e = 0; e < 4; ++e) y[e] = (d[e] * rstd * lg[e] + lb[e] + bon[u] * v[e]) * g[e];
            u32x2 p; p.x = pk2(y[0], y[1]); p.y = pk2(y[2], y[3]); *(u32x2*)(c.Z() + (size_t)row * ZLD + 256 + 4 * lane) = p; } }
    }
}

#define XB_XCNT(j)  (256  + 64 * (j))
#define XB_XSUB(j)  (1280 + 64 * (j))
#define XB_XGEN(j)  (2304 + 64 * (j))
#define XB_TOP      3328
#define XB_TOPGEN   3392
__device__ __forceinline__ unsigned xb_ld(unsigned* p) { return __hip_atomic_load(p, __ATOMIC_RELAXED, __HIP_MEMORY_SCOPE_AGENT); }
__device__ __forceinline__ unsigned xb_add(unsigned* p, unsigned v) { return __hip_atomic_fetch_add(p, v, __ATOMIC_RELAXED, __HIP_MEMORY_SCOPE_AGENT); }
#define XB_SPIN(cond) do { unsigned _sp = 0; while (cond) { __builtin_amdgcn_s_sleep(1); if (++_sp > (1u << 24)) break; } } while (0)
__device__ __forceinline__ void gbar(unsigned* bar, unsigned x, unsigned nloc, unsigned nx, unsigned gen) {
    asm volatile("s_waitcnt vmcnt(0) lgkmcnt(0)" ::: "memory");
    __syncthreads();
    if (threadIdx.x == 0) {
        const unsigned old = xb_add(&bar[XB_XSUB(x)], 1u);
        if (old + 1u == (gen + 1u) * nloc) {
            __builtin_amdgcn_fence(__ATOMIC_RELEASE, "agent");
            asm volatile("s_waitcnt vmcnt(0)" ::: "memory");
            const unsigned og = xb_add(&bar[XB_TOP], 1u);
            const unsigned tg = gen;
            if (og + 1u == (tg + 1u) * nx) xb_add(&bar[XB_TOPGEN], 1u);
            else XB_SPIN(xb_ld(&bar[XB_TOPGEN]) == tg);
            __builtin_amdgcn_fence(__ATOMIC_ACQUIRE, "agent");
            xb_add(&bar[XB_XGEN(x)], 1u);
            asm volatile("s_waitcnt vmcnt(0)" ::: "memory");
        } else {
            XB_SPIN(xb_ld(&bar[XB_XGEN(x)]) == gen);
            __builtin_amdgcn_fence(__ATOMIC_ACQUIRE, "agent");
            asm volatile("s_waitcnt vmcnt(0)" ::: "memory");
        }
    }
    __syncthreads();
}

__global__ void __launch_bounds__(512) hybrid_fwd(Params P) {
    extern __shared__ __attribute__((aligned(16))) unsigned char lds_raw[];
    cg::grid_group grid = cg::this_grid();
    Ctx c;
    c.in = P.in; c.out = P.out; c.ws = P.ws;
    c.lds = (LAS unsigned char*)lds_raw; c.tid = threadIdx.x; c.lane = threadIdx.x & 63; c.w = __builtin_amdgcn_readfirstlane(threadIdx.x >> 6);
    c.gw = blockIdx.x * 8 + c.w; c.nw = gridDim.x * 8;
    const int G = gridDim.x;
    const int wave_id = __builtin_amdgcn_readfirstlane(threadIdx.x >> 6);
#define REFRESH() do { int w_ = wave_id; asm volatile("" : "+s"(w_)); int ln_; asm volatile("v_mbcnt_lo_u32_b32 %0, -1, 0\n\tv_mbcnt_hi_u32_b32 %0, -1, %0" : "=v"(ln_)); int t_ = w_ * 64 + ln_; { unsigned char* w2_ = P.ws; asm volatile("" : "+s"(w2_)); c.ws = w2_; } c.tid = t_; c.lane = t_ & 63; c.w = w_; c.gw = blockIdx.x * 8 + c.w; } while (0)

    unsigned* bar = (unsigned*)(P.ws + W_BAR);
    const unsigned xcc = (unsigned)__builtin_amdgcn_s_getreg((3 << 11) | 20) & 0xFu;
    if (threadIdx.x == 0) xb_add(&bar[XB_XCNT(xcc)], 1u);
    phase0(c);
    grid.sync();
    unsigned nloc = 0, nx = 0;
#pragma unroll
    for (unsigned j = 0; j < 16; ++j) { const unsigned cnt = xb_ld(&bar[XB_XCNT(j)]); nx += cnt > 0u ? 1u : 0u; nloc = (j == xcc) ? cnt : nloc; }
    nloc = __builtin_amdgcn_readfirstlane(nloc); nx = __builtin_amdgcn_readfirstlane(nx);
    if (nloc == 0u) nloc = 1u; if (nx == 0u) nx = 1u;
    unsigned bar_gen = 0;
#define GBAR() do { gbar(bar, xcc, nloc, nx, bar_gen); ++bar_gen; } while (0)
    for (int l = 0; l < NL; ++l) {
        const int buf = l & 1;
        unsigned char* wb = c.WB() + (size_t)buf * WB_SIZE;
        const bf16_t* WinT = (const bf16_t*)(wb + WB_WIN); const bf16_t* WoutT = (const bf16_t*)(wb + WB_WOUT); const bf16_t* WguT = (const bf16_t*)(wb + WB_WGU); const bf16_t* WdnT = (const bf16_t*)(wb + WB_WDN);
        REFRESH();
        { pg8::Gemm g{c.XB(), WinT, NPROMPT, ZLD, 1024, 1024}; pg8::StaticOrder S; S.init(NPROMPT, ZLD, G, blockIdx.x); EpiZ E{c.Z(), c.SSQ() + (size_t)(2 * l) * NR};
          pg8::gemm_phase<EpiZ>(c.lds, g, S, E, c.tid);
          REFRESH(); ThinZ T{c.Z(), c.SSQ() + (size_t)(2 * l) * NR};
          const bool split = (G == 256);
          if (!split) thin_gemm(c.XB() + (size_t)NPROMPT * DM, DM, WinT, 1024, INC / 32, T, c.w, c.lane);
          else if (blockIdx.x >= 128) thin_gemm(c.XB() + (size_t)NPROMPT * DM, DM, WinT, 1024, INC / 32, T, c.w, c.lane, (int)blockIdx.x - 128, 128);
          if (l + 1 < NL) { REFRESH(); if (!split) convert_weights(c, l + 1, buf ^ 1, 0); else if (blockIdx.x >= 128) convert_weights(c, l + 1, buf ^ 1, 0, (int)blockIdx.x - 128, 128); } }
        GBAR();
        REFRESH();
        conv_phase(c, l);
        REFRESH();
        for (int tile = blockIdx.x; tile < 256; tile += G) ssm_tile<false>(c, l, tile);
        REFRESH();
        rwkv_tok(c, l, buf);
        REFRESH();
        __syncthreads();
        rwkv_d1(c);
        if (G != 256) { REFRESH(); shift_out(c, l, (int)blockIdx.x * 512 + c.tid, G * 512); }
        GBAR();
        REFRESH();
        for (int tile = blockIdx.x; tile < 256; tile += G) { ssm_tile<true>(c, l, tile); __syncthreads(); ssm_glu(c, l, buf, tile); __syncthreads(); }
        { const int sb = (G >= 160) ? 128 : 0;
          for (int q = (int)blockIdx.x - sb; q >= 0 && q < 4; q += G) { const int tile = 256 + (q >> 1), hf = q & 1; ssm_tile<true>(c, l, tile, hf, hf + 1); __syncthreads(); ssm_glu(c, l, buf, tile, 2 * hf, 2 * hf + 2); __syncthreads(); } }
        if (G == 256) {
            if (blockIdx.x >= 128) { REFRESH(); gmlp_tile<true>(c, l, buf, (int)blockIdx.x - 128); }
            else { REFRESH();
                if (c.w == 0) rwkv_d2(c, l);
                else { if (c.w == 1) gmlp_sample(c, l, (int)blockIdx.x, 128); rwkv_scan(c, l, (int)blockIdx.x * 7 + c.w - 1, 128 * 7); shift_out(c, l, (int)blockIdx.x * 448 + c.tid - 64, 128 * 448); } }
        } else {
            REFRESH();
            for (int tile = blockIdx.x; tile < 256; tile += G) gmlp_tile<false>(c, l, buf, tile);
            REFRESH();
            gmlp_sample(c, l, c.gw, c.nw);
            REFRESH();
            rwkv_scan(c, l, c.gw, c.nw);
            REFRESH();
            rwkv_d2(c, l);
        }
        GBAR();
        REFRESH();
        rwkv_final(c, l);
        GBAR();
        REFRESH();
        { pg8::Gemm g{c.Z() + MIXOFF, WoutT, NPROMPT, 1024, 1024, ZLD}; pg8::StaticOrder S; S.init(NPROMPT, 1024, G, blockIdx.x); EpiRes E{c.XB(), c.SSQ() + (size_t)(2 * l + 1) * NR};
          pg8::gemm_phase<EpiRes>(c.lds, g, S, E, c.tid);
          REFRESH(); ThinRes T{c.XB(), c.SSQ() + (size_t)(2 * l + 1) * NR}; thin_gemm_sk<4>(c.lds, c.Z() + MIXOFF + (size_t)NPROMPT * ZLD, ZLD, WoutT, 1024, 32, T, c.w, c.lane); }
        GBAR();
        REFRESH();
        { pg8::Gemm g{c.XB(), WguT, NPROMPT, 5632, 1024, 1024}; pg8::StaticOrder S; S.init(NPROMPT, 5632, G, blockIdx.x); EpiAct E{c.ACT(), c.SSQ() + (size_t)(2 * l + 1) * NR};
          pg8::gemm_phase<EpiAct>(c.lds, g, S, E, c.tid);
          REFRESH(); ThinAct T{c.ACT(), c.SSQ() + (size_t)(2 * l + 1) * NR}; if (G != 256) thin_gemm(c.XB() + (size_t)NPROMPT * DM, DM, WguT, 1024, DFF / 16, T, c.w, c.lane); else if (blockIdx.x >= 128) thin_gemm(c.XB() + (size_t)NPROMPT * DM, DM, WguT, 1024, DFF / 16, T, c.w, c.lane, (int)blockIdx.x - 128, 128);
          if (l + 1 < NL) { REFRESH(); if (G != 256) convert_weights(c, l + 1, buf ^ 1, 1); else if (blockIdx.x >= 128) convert_weights(c, l + 1, buf ^ 1, 1, (int)blockIdx.x - 128, 128); } }
        GBAR();
        REFRESH();
        { pg8::Gemm g{c.ACT(), WdnT, NPROMPT, 1024, DFF, DFF}; pg8::StaticOrder S; S.init(NPROMPT, 1024, G, blockIdx.x); EpiRes E{c.XB(), c.SSQ() + (size_t)(2 * l + 2) * NR};
          pg8::gemm_phase<EpiRes>(c.lds, g, S, E, c.tid);
          REFRESH(); ThinRes T{c.XB(), c.SSQ() + (size_t)(2 * l + 2) * NR}; thin_gemm_sk<11>(c.lds, c.ACT() + (size_t)NPROMPT * DFF, DFF, WdnT, DFF, 32, T, c.w, c.lane); }
        GBAR();
    }
    REFRESH();
    { f32x4 gn[4];
#pragma unroll
      for (int j = 0; j < 4; ++j) gn[j] = *(const f32x4*)(c.in[40] + j * 256 + c.lane * 4);
      for (int row0 = c.gw; row0 < NR; row0 += 5 * c.nw) { u32x2 xv[5][4]; unsigned long long sq[5];
#pragma unroll
          for (int u = 0; u < 5; ++u) { const int row = (row0 + u * c.nw < NR) ? row0 + u * c.nw : row0; sq[u] = c.SSQ()[(size_t)8 * NR + row];
#pragma unroll
              for (int j = 0; j < 4; ++j) xv[u][j] = *(const u32x2*)(c.XB() + (size_t)row * DM + j * 256 + c.lane * 4); }
#pragma unroll
          for (int u = 0; u < 5; ++u) { const int row = row0 + u * c.nw; if (row < NR) { const float rs = rsqrtf((float)sq[u] * (1.0f / (SSQ_SCALE * 1024.0f)) + 1e-6f);
#pragma unroll
              for (int j = 0; j < 4; ++j) { float v[4]; unpack4(xv[u][j], v); *(f32x4*)(c.out + (size_t)row * DM + j * 256 + c.lane * 4) = (f32x4){v[0] * rs * gn[j][0], v[1] * rs * gn[j][1], v[2] * rs * gn[j][2], v[3] * rs * gn[j][3]}; } } } } }
}

extern "C" void kernel_launch(void* const* d_in, const int* in_sizes, int n_in, void* d_out, int out_size, void* d_ws, size_t ws_size, hipStream_t stream) {
    static int grid_blocks = 0;
    if (!grid_blocks) {
        int dev = 0, cus = 0, per_cu = 0;
        hipGetDevice(&dev);
        hipDeviceGetAttribute(&cus, hipDeviceAttributeMultiprocessorCount, dev);
        hipFuncSetAttribute((const void*)hybrid_fwd, hipFuncAttributeMaxDynamicSharedMemorySize, LDS_BYTES);
        hipOccupancyMaxActiveBlocksPerMultiprocessor(&per_cu, (const void*)hybrid_fwd, 512, LDS_BYTES);
        if (per_cu < 1) per_cu = 1;
        grid_blocks = cus * per_cu;
        if (n_in != 41 || (size_t)out_size != O_END || ws_size < W_END) fprintf(stderr, "kernel_launch: unexpected sizes n_in %d out %d ws %zu\n", n_in, out_size, ws_size);
    }
    hipMemsetAsync((char*)d_ws + W_BAR, 0, 16384, stream);
    Params p{};
    for (int i = 0; i < 41; ++i) p.in[i] = (const float*)d_in[i];
    p.out = (float*)d_out; p.ws = (unsigned char*)d_ws;
    void* args[] = {&p};
    hipError_t e = hipLaunchCooperativeKernel((const void*)hybrid_fwd, dim3(grid_blocks), dim3(512), args, LDS_BYTES, stream);
    if (e != hipSuccess) fprintf(stderr, "cooperative launch failed: %s (grid %d)\n", hipGetErrorString(e), grid_blocks);
}
```

```cpp
#include <hip/hip_runtime.h>
#include <hip/hip_cooperative_groups.h>
#include <cstdio>
namespace cg = cooperative_groups;

#define LAS __attribute__((address_space(3)))
typedef unsigned short bf16_t;
typedef short bf16x8 __attribute__((ext_vector_type(8)));
typedef float f32x4 __attribute__((ext_vector_type(4)));
typedef float f32x2 __attribute__((ext_vector_type(2)));
typedef unsigned u32x4 __attribute__((ext_vector_type(4)));
typedef unsigned u32x2 __attribute__((ext_vector_type(2)));

constexpr int DM = 1024, NPROMPT = 16384, NSAMP = 128, NR = NPROMPT + NSAMP, SEQ = 2048, NB = 8, NL = 4;
constexpr int ZLD = 2560, INC = 2432, DFF = 2816, DTM = 896;
constexpr int MIXOFF = 256;
constexpr size_t O_Y = 0;
constexpr size_t O_WKVP = (size_t)NR * DM;
constexpr size_t O_WKVS = O_WKVP + (size_t)NL * NB * 4 * 64 * 64;
constexpr size_t O_SHP = O_WKVS + (size_t)NL * NSAMP * 4 * 64 * 64;
constexpr size_t O_SHS = O_SHP + (size_t)NL * NB * DTM;
constexpr size_t O_REP = O_SHS + (size_t)NL * NSAMP * DTM;
constexpr size_t O_RES = O_REP + (size_t)NL * NB * 1024;
constexpr size_t O_IMP = O_RES + (size_t)NL * NSAMP * 1024;
constexpr size_t O_IMS = O_IMP + (size_t)NL * NB * 1024;
constexpr size_t O_CVP = O_IMS + (size_t)NL * NSAMP * 1024;
constexpr size_t O_CVS = O_CVP + (size_t)NL * NB * 512;
constexpr size_t O_CHV = O_CVS + (size_t)NL * NSAMP * 512;
constexpr size_t O_END = O_CHV + (size_t)NL * NSAMP * 256;
static_assert(O_END == 27832320, "output size");
constexpr size_t W_XB = 0;
constexpr int CHS = 31232;
constexpr size_t W_ZA = W_XB + (size_t)NR * DM * 2;
constexpr size_t W_WB = W_ZA + (size_t)NR * DFF * 2;
constexpr size_t WB_WIN = 0, WB_WOUT = WB_WIN + (size_t)ZLD * 1024 * 2, WB_WGU = WB_WOUT + (size_t)1024 * 1024 * 2, WB_WDN = WB_WGU + (size_t)5632 * 1024 * 2,
                 WB_GLU = WB_WDN + (size_t)1024 * DFF * 2, WB_LORA = WB_GLU + 256 * 256 * 2, WB_WSB = WB_LORA + 256 * 128 * 2, WB_SIZE = WB_WSB + 4 * 128 * 128 * 2;
constexpr size_t W_TOK = W_WB + 2 * WB_SIZE;
constexpr size_t W_GG = W_TOK + (size_t)NR * 1536 * 2;
constexpr size_t W_OO = W_GG + (size_t)NR * 256 * 2;
constexpr size_t W_BON = W_OO + (size_t)NR * 256 * 4;
constexpr size_t W_SSQ = W_BON + (size_t)NR * 4 * 4;
constexpr size_t W_EE = W_SSQ + (size_t)9 * NR * 8;
constexpr size_t W_LBC = W_EE + (size_t)NB * 32 * 16 * 64 * 2 * 4;
constexpr size_t W_BBAR = W_LBC + (size_t)NL * 1024 * 8;
constexpr size_t W_BAR = W_BBAR + (size_t)NL * 16 * 128 * 16 * 2;
constexpr size_t W_END = W_BAR + 16384;
static_assert(W_END <= 268435456, "workspace");
static_assert((size_t)NB * 4 * 64 * CHS <= (size_t)NR * DM * 4, "chunk data lives in the y region of d_out until the final norm overwrites it");
static_assert(W_ZA % 256 == 0 && W_WB % 256 == 0 && W_TOK % 256 == 0 && W_GG % 256 == 0 && W_OO % 256 == 0 && W_BON % 256 == 0 && W_SSQ % 256 == 0 && W_EE % 256 == 0 && WB_SIZE % 256 == 0, "align");
constexpr int LDS_BYTES = 139264;

struct Params { const float* in[41]; float* out; unsigned char* ws; };

struct Ctx {
    const float* const* in; float* out; unsigned char* ws;
    LAS unsigned char* lds; int tid, lane, w, gw, nw;
    __device__ __forceinline__ float* X() const { return out; }
    __device__ __forceinline__ bf16_t* XB() const { return (bf16_t*)(ws + W_XB); }
    __device__ __forceinline__ bf16_t* Z() const { return (bf16_t*)(ws + W_ZA); }
    __device__ __forceinline__ bf16_t* ACT() const { return (bf16_t*)(ws + W_ZA); }
    __device__ __forceinline__ unsigned char* WB() const { return ws + W_WB; }
    __device__ __forceinline__ bf16_t* TOK() const { return (bf16_t*)(ws + W_TOK); }
    __device__ __forceinline__ bf16_t* GG() const { return (bf16_t*)(ws + W_GG); }
    __device__ __forceinline__ float* OO() const { return (float*)(ws + W_OO); }
    __device__ __forceinline__ float* BON() const { return (float*)(ws + W_BON); }
    __device__ __forceinline__ unsigned long long* SSQ() const { return (unsigned long long*)(ws + W_SSQ); }
    __device__ __forceinline__ float* EE() const { return (float*)(ws + W_EE); }
    __device__ __forceinline__ unsigned char* CH() const { return (unsigned char*)out; }
    __device__ __forceinline__ float* LBC() const { return (float*)(ws + W_LBC); }
    __device__ __forceinline__ bf16_t* BBAR() const { return (bf16_t*)(ws + W_BBAR); }
};

__device__ __forceinline__ float bf2f(bf16_t b) { return __uint_as_float(((unsigned)b) << 16); }
__device__ __forceinline__ float bflo(unsigned u) { return __uint_as_float(u << 16); }
__device__ __forceinline__ float bfhi(unsigned u) { return __uint_as_float(u & 0xffff0000u); }
typedef __bf16 bf16v2 __attribute__((ext_vector_type(2)));
__device__ __forceinline__ unsigned pk2(float lo, float hi) { const f32x2 v = {lo, hi}; const bf16v2 b = __builtin_convertvector(v, bf16v2); return __builtin_bit_cast(unsigned, b); }
__device__ __forceinline__ bf16_t f2bf(float f) { return (bf16_t)(pk2(f, 0.f) & 0xffffu); }
constexpr float SSQ_SCALE = 16777216.0f;
__device__ __forceinline__ float ssq_rs(const unsigned long long* p, int row) { return rsqrtf((float)p[row] * (1.0f / (SSQ_SCALE * 1024.0f)) + 1e-6f); }
__device__ __forceinline__ void ssq_add(unsigned long long* p, int row, float s) { atomicAdd(p + row, (unsigned long long)(s * SSQ_SCALE + 0.5f)); }
__device__ __forceinline__ float sigmoidf_(float x) { return 1.0f / (1.0f + __expf(-x)); }
__device__ __forceinline__ float gelu_t(float x) { const float y = 0.7978845608028654f * (x + 0.044715f * x * x * x); return x * sigmoidf_(2.0f * y); }
__device__ __forceinline__ float tanh_(float x) { return 1.0f - 2.0f / (__expf(2.0f * x) + 1.0f); }
template <int CTRL> __device__ __forceinline__ float dpp_mov(float v) { return __builtin_bit_cast(float, __builtin_amdgcn_update_dpp(0, __builtin_bit_cast(int, v), CTRL, 0xf, 0xf, true)); }
__device__ __forceinline__ float row16_sum(float v) { v += dpp_mov<0xB1>(v); v += dpp_mov<0x4E>(v); v += dpp_mov<0x141>(v); v += dpp_mov<0x140>(v); return v; }
__device__ __forceinline__ float wave_sum(float v) {
    v = row16_sum(v); const int b = __builtin_bit_cast(int, v);
    const float a0 = __builtin_bit_cast(float, __builtin_amdgcn_readlane(b, 0)), a1 = __builtin_bit_cast(float, __builtin_amdgcn_readlane(b, 16));
    const float a2 = __builtin_bit_cast(float, __builtin_amdgcn_readlane(b, 32)), a3 = __builtin_bit_cast(float, __builtin_amdgcn_readlane(b, 48));
    return (a0 + a1) + (a2 + a3);
}
__device__ __forceinline__ f32x4 zero4() { float z = 0.f; asm volatile("" : "+v"(z)); return (f32x4){z, z, z, z}; }
__device__ __forceinline__ f32x4 mfma16(bf16x8 a, bf16x8 b, f32x4 c) { return __builtin_amdgcn_mfma_f32_16x16x32_bf16(a, b, c, 0, 0, 0); }
__device__ __forceinline__ bf16x8 pack8(const float* z) { u32x4 u; u.x = pk2(z[0], z[1]); u.y = pk2(z[2], z[3]); u.z = pk2(z[4], z[5]); u.w = pk2(z[6], z[7]); return __builtin_bit_cast(bf16x8, u); }
__device__ __forceinline__ void unpack4(u32x2 u, float* z) { z[0] = bflo(u.x); z[1] = bfhi(u.x); z[2] = bflo(u.y); z[3] = bfhi(u.y); }
__device__ __forceinline__ void unpack8(u32x4 u, float* z) { z[0] = bflo(u.x); z[1] = bfhi(u.x); z[2] = bflo(u.y); z[3] = bfhi(u.y); z[4] = bflo(u.z); z[5] = bfhi(u.z); z[6] = bflo(u.w); z[7] = bfhi(u.w); }

namespace pg8 {
constexpr int BM = 256, BK = 64, HALF = 128, HTB = HALF * BK * 2, STAGE_BYTES = 8 * HTB, NXCD = 8, WGM = 8;
__device__ __forceinline__ int lds_byte(int r, int c) { const int st = (r >> 4) * 2 + (c >> 5), rr = r & 15, cc = c & 31, ob = rr * 64 + cc * 2; return st * 1024 + (ob ^ (((ob >> 9) & 1) << 5)); }
__device__ __forceinline__ void stage_rc(int b, int& R, int& C) { const int st = b / 1024, sb = b % 1024, swz = sb ^ (((sb >> 9) & 1) << 5); R = (st >> 1) * 16 + swz / 64; C = (st & 1) * 32 + (swz % 64) / 2; }
__device__ __forceinline__ int perm32(int rho) { const int n = rho >> 4, i = rho & 15; return 8 * (i >> 2) + 4 * n + (i & 3); }
struct Unit { int pm, pn; };
struct Gemm { const bf16_t* A; const bf16_t* Bt; int M, N, K, lda; };
struct StaticOrder {
    int nM, nN, nwg, G, c;
    __device__ void init(int M, int N, int G_, int c_) { nM = M / BM; nN = N / BM; nwg = nM * nN; G = G_; c = c_; }
    __device__ bool next(int i, Unit& u) const {
        const long L = (long)i * G + c; if (L >= nwg) return false;
        int wgid = (int)L; { const int q = nwg / NXCD, r = nwg % NXCD, xcd = wgid % NXCD, off = wgid / NXCD; wgid = (xcd < r ? xcd * (q + 1) : r * (q + 1) + (xcd - r) * q) + off; }
        const int nig = WGM * nN, gid = wgid / nig, fm = gid * WGM, gsz = (nM - fm) < WGM ? (nM - fm) : WGM;
        u.pm = fm + ((wgid % nig) % gsz); u.pn = (wgid % nig) / gsz; return true;
    }
};

template <class Epi>
__device__ __forceinline__ void gemm_phase(LAS unsigned char* lds, const Gemm g, const StaticOrder& S, const Epi& E, const int tid) {
    const int wid = __builtin_amdgcn_readfirstlane(tid >> 6), lane = tid & 63, wr = wid >> 2, wc = wid & 3, fr = lane & 15, fq = lane >> 4;
    const int K = g.K, nt = K / BK;
    unsigned voffA[2], voffB[2];
#pragma unroll
    for (int i = 0; i < 2; ++i) { int R, C; stage_rc(tid * 16 + i * 8192, R, C); const int Rb = Epi::PERM ? ((R & ~31) + perm32(R & 31)) : R;
        voffA[i] = (unsigned)(R * g.lda + C) * 2u; voffB[i] = (unsigned)(Rb * K + C) * 2u; }
    const size_t kstep = (size_t)(BK * 2);
    const size_t hstepA = (size_t)HALF * g.lda * 2, hstepB = (size_t)HALF * K * 2;
    const size_t tstepA = 2 * hstepA, tstepB = 2 * hstepB;
    const unsigned ldsw = (unsigned)wid * 1024u;
    const int aoff = lds_byte(wr * 64 + fr, fq * 8), boff = lds_byte(wc * 32 + fr, fq * 8);
#define PG8_SA(b, h) (((b) * 2 + (h)) * HTB)
#define PG8_SB(b, h) ((4 + (b) * 2 + (h)) * HTB)
#define PG8_STAGE(bufoff, gbase, voff) do { _Pragma("unroll") for (int _i = 0; _i < 2; ++_i) \
        __builtin_amdgcn_global_load_lds((const unsigned*)((const char*)(gbase) + (voff)[_i]), (LAS unsigned*)(lds + (bufoff) + ldsw + _i * 8192), 16, 0, 0); } while (0)
#define PG8_LDA(dst, b, h) do { _Pragma("unroll") for (int m = 0; m < 4; ++m) _Pragma("unroll") for (int k = 0; k < 2; ++k) dst[m][k] = *(const LAS bf16x8*)(lds + PG8_SA(b, h) + aoff + m * 2048 + k * 1024); } while (0)
#define PG8_LDB(dst, b, h) do { _Pragma("unroll") for (int n = 0; n < 2; ++n) _Pragma("unroll") for (int k = 0; k < 2; ++k) dst[n][k] = *(const LAS bf16x8*)(lds + PG8_SB(b, h) + boff + n * 2048 + k * 1024); } while (0)
#define PG8_MMA(ai, bj, At, Bt) do { __builtin_amdgcn_s_setprio(1); _Pragma("unroll") for (int m = 0; m < 4; ++m) _Pragma("unroll") for (int n = 0; n < 2; ++n) _Pragma("unroll") for (int k = 0; k < 2; ++k) \
        acc[ai][bj][m][n] = __builtin_amdgcn_mfma_f32_16x16x32_bf16(Bt[n][k], At[m][k], acc[ai][bj][m][n], 0, 0, 0); __builtin_amdgcn_s_setprio(0); } while (0)
#define PG8_WAIT_V(n) asm volatile("s_waitcnt vmcnt(" #n ")" ::: "memory")
#define PG8_WAIT_L(n) asm volatile("s_waitcnt lgkmcnt(" #n ")" ::: "memory")
#define PG8_BAR __builtin_amdgcn_s_barrier()
#define PG8_SCHED __builtin_amdgcn_sched_barrier(0)
    Unit cur, nxt; int ui = 0;
    if (!S.next(0, cur)) return;
    f32x4 acc[2][2][4][2];
#pragma unroll
    for (int a = 0; a < 2; ++a)
#pragma unroll
        for (int b = 0; b < 2; ++b)
#pragma unroll
            for (int m = 0; m < 4; ++m)
#pragma unroll
                for (int n = 0; n < 2; ++n) acc[a][b][m][n] = zero4();
    bf16x8 At[4][2], B0[2][2], B1[2][2];
    const char* cA = (const char*)g.A + (size_t)cur.pm * tstepA; const char* cB = (const char*)g.Bt + (size_t)cur.pn * tstepB;
    PG8_STAGE(PG8_SB(0, 0), cB, voffB); PG8_STAGE(PG8_SA(0, 0), cA, voffA); PG8_STAGE(PG8_SB(0, 1), cB + hstepB, voffB); PG8_STAGE(PG8_SA(0, 1), cA + hstepA, voffA);
    if (wr == 1) PG8_BAR;
    PG8_WAIT_V(4); PG8_BAR;
    PG8_STAGE(PG8_SB(1, 0), cB + kstep, voffB); PG8_STAGE(PG8_SA(1, 0), cA + kstep, voffA); PG8_STAGE(PG8_SB(1, 1), cB + hstepB + kstep, voffB);
    PG8_WAIT_V(6); PG8_BAR;
    for (;;) {
        const bool has_next = S.next(ui + 1, nxt);
        const char* nA = has_next ? (const char*)g.A + (size_t)nxt.pm * tstepA : cA; const char* nB = has_next ? (const char*)g.Bt + (size_t)nxt.pn * tstepB : cB;
        for (int t = 0; t < nt; t += 2) {
            const bool last = (t == nt - 2);
            const char* a1 = cA + (size_t)(t + 1) * kstep;
            const char* a2 = last ? nA : cA + (size_t)(t + 2) * kstep; const char* b2 = last ? nB : cB + (size_t)(t + 2) * kstep;
            const char* a3 = a2 + kstep; const char* b3 = b2 + kstep;
            PG8_LDB(B0, 0, 0); PG8_SCHED; PG8_LDA(At, 0, 0); PG8_STAGE(PG8_SA(1, 1), a1 + hstepA, voffA);
            PG8_WAIT_L(8); PG8_BAR; PG8_WAIT_L(0); PG8_MMA(0, 0, At, B0); PG8_BAR; PG8_SCHED;
            PG8_LDB(B1, 0, 1); PG8_STAGE(PG8_SB(0, 0), b2, voffB);
            PG8_BAR; PG8_WAIT_L(0); PG8_MMA(0, 1, At, B1); PG8_BAR;
            PG8_LDA(At, 0, 1); PG8_STAGE(PG8_SA(0, 0), a2, voffA);
            PG8_BAR; PG8_WAIT_L(0); PG8_MMA(1, 0, At, B0); PG8_BAR; PG8_SCHED;
            PG8_STAGE(PG8_SB(0, 1), b2 + hstepB, voffB);
            PG8_WAIT_V(6); PG8_BAR; PG8_MMA(1, 1, At, B1); PG8_BAR;
            PG8_LDB(B0, 1, 0); PG8_SCHED; PG8_LDA(At, 1, 0); PG8_STAGE(PG8_SA(0, 1), a2 + hstepA, voffA);
            PG8_WAIT_L(8); PG8_BAR; PG8_WAIT_L(0); PG8_MMA(0, 0, At, B0); PG8_BAR; PG8_SCHED;
            PG8_LDB(B1, 1, 1); PG8_STAGE(PG8_SB(1, 0), b3, voffB);
            PG8_BAR; PG8_WAIT_L(0); PG8_MMA(0, 1, At, B1); PG8_BAR;
            PG8_LDA(At, 1, 1); PG8_STAGE(PG8_SA(1, 0), a3, voffA);
            PG8_BAR; PG8_WAIT_L(0); PG8_MMA(1, 0, At, B0); PG8_BAR; PG8_SCHED;
            PG8_STAGE(PG8_SB(1, 1), b3 + hstepB, voffB);
            PG8_WAIT_V(6); PG8_BAR; PG8_MMA(1, 1, At, B1); PG8_BAR;
        }
        E(acc, cur, wr, wc, fr, fq);
        if (!has_next) break;
#pragma unroll
        for (int a = 0; a < 2; ++a)
#pragma unroll
            for (int b = 0; b < 2; ++b)
#pragma unroll
                for (int m = 0; m < 4; ++m)
#pragma unroll
                    for (int n = 0; n < 2; ++n) acc[a][b][m][n] = zero4();
        cur = nxt; cA = nA; cB = nB; ++ui;
    }
    PG8_WAIT_V(0);
    if (wr == 0) PG8_BAR;
    PG8_BAR;
#undef PG8_SA
#undef PG8_SB
#undef PG8_STAGE
#undef PG8_LDA
#undef PG8_LDB
#undef PG8_MMA
#undef PG8_WAIT_V
#undef PG8_WAIT_L
#undef PG8_BAR
#undef PG8_SCHED
}
}

struct EpiZ {
    static constexpr bool PERM = true;
    bf16_t* Z; const unsigned long long* ssq;
    __device__ __forceinline__ void operator()(const f32x4 (&acc)[2][2][4][2], const pg8::Unit& u, int wr, int wc, int fr, int fq) const {
        const int row0 = u.pm * 256 + wr * 64 + fr, col0 = u.pn * 256 + wc * 32 + 8 * fq;
        unsigned long long sq[8];
#pragma unroll
        for (int i = 0; i < 8; ++i) sq[i] = ssq[row0 + (i >> 2) * 128 + (i & 3) * 16];
#pragma unroll
        for (int ai = 0; ai < 2; ++ai)
#pragma unroll
            for (int m = 0; m < 4; ++m) { const int row = row0 + ai * 128 + m * 16; const float rs = rsqrtf((float)sq[ai * 4 + m] * (1.0f / (SSQ_SCALE * 1024.0f)) + 1e-6f);
                bf16_t* rowp = Z + (size_t)row * ZLD + col0;
#pragma unroll
                for (int bj = 0; bj < 2; ++bj) { const f32x4 v0 = acc[ai][bj][m][0] * rs, v1 = acc[ai][bj][m][1] * rs;
                    u32x4 w; w.x = pk2(v0[0], v0[1]); w.y = pk2(v0[2], v0[3]); w.z = pk2(v1[0], v1[1]); w.w = pk2(v1[2], v1[3]);
                    *(u32x4*)(rowp + bj * 128) = w; } }
    }
};
struct EpiRes {
    static constexpr bool PERM = true;
    bf16_t* XB; unsigned long long* ssq;
    __device__ __forceinline__ void operator()(const f32x4 (&acc)[2][2][4][2], const pg8::Unit& u, int wr, int wc, int fr, int fq) const {
        const int row0 = u.pm * 256 + wr * 64 + fr, col0 = u.pn * 256 + wc * 32 + 8 * fq;
        u32x4 xin[2][4][2];
#pragma unroll
        for (int ai = 0; ai < 2; ++ai)
#pragma unroll
            for (int m = 0; m < 4; ++m) { const bf16_t* bp = XB + (size_t)(row0 + ai * 128 + m * 16) * DM + col0;
#pragma unroll
                for (int bj = 0; bj < 2; ++bj) xin[ai][m][bj] = *(const u32x4*)(bp + bj * 128); }
#pragma unroll
        for (int ai = 0; ai < 2; ++ai)
#pragma unroll
            for (int m = 0; m < 4; ++m) { const int row = row0 + ai * 128 + m * 16; bf16_t* bp = XB + (size_t)row * DM + col0; float s = 0.f;
#pragma unroll
                for (int bj = 0; bj < 2; ++bj) { float xo[8]; unpack8(xin[ai][m][bj], xo); const f32x4 a0 = acc[ai][bj][m][0], a1 = acc[ai][bj][m][1];
                    u32x4 w; w.x = pk2(xo[0] + a0[0], xo[1] + a0[1]); w.y = pk2(xo[2] + a0[2], xo[3] + a0[3]); w.z = pk2(xo[4] + a1[0], xo[5] + a1[1]); w.w = pk2(xo[6] + a1[2], xo[7] + a1[3]);
                    *(u32x4*)(bp + bj * 128) = w; float o[8]; unpack8(w, o);
#pragma unroll
                    for (int e = 0; e < 8; ++e) s += o[e] * o[e]; }
                s += __shfl_xor(s, 16); s += __shfl_xor(s, 32);
                if (fq == 0) ssq_add(ssq, row, s); }
    }
};
struct EpiAct {
    static constexpr bool PERM = true;
    bf16_t* ACT; const unsigned long long* ssq;
    __device__ __forceinline__ void operator()(const f32x4 (&acc)[2][2][4][2], const pg8::Unit& u, int wr, int wc, int fr, int fq) const {
        const int row0 = u.pm * 256 + wr * 64 + fr, col0 = u.pn * 128 + wc * 32 + 8 * fq;
        unsigned long long sq[8];
#pragma unroll
        for (int i = 0; i < 8; ++i) sq[i] = ssq[row0 + (i >> 2) * 128 + (i & 3) * 16];
#pragma unroll
        for (int ai = 0; ai < 2; ++ai)
#pragma unroll
            for (int m = 0; m < 4; ++m) { const int row = row0 + ai * 128 + m * 16; const float rs = rsqrtf((float)sq[ai * 4 + m] * (1.0f / (SSQ_SCALE * 1024.0f)) + 1e-6f);
                float o[8];
#pragma unroll
                for (int n = 0; n < 2; ++n)
#pragma unroll
                    for (int j = 0; j < 4; ++j) { const float g = acc[ai][0][m][n][j] * rs, up = acc[ai][1][m][n][j] * rs; o[n * 4 + j] = g * sigmoidf_(g) * up; }
                u32x4 w; w.x = pk2(o[0], o[1]); w.y = pk2(o[2], o[3]); w.z = pk2(o[4], o[5]); w.w = pk2(o[6], o[7]);
                *(u32x4*)(ACT + (size_t)row * DFF + col0) = w; }
    }
};

template <class F>
__device__ __forceinline__ void thin_gemm(const bf16_t* A, int lda, const bf16_t* Bt, int K, int npairs, const F& f, int w, int lane, int wgi = -1, int G = 0) {
    if (wgi < 0) { wgi = blockIdx.x; G = gridDim.x; }
    const int fr = lane & 15, fq = lane >> 4, ntask = npairs * 8;
    for (int task = w * G + wgi; task < ntask; task += 8 * G) {
        const int rt = task & 7, pr = task >> 3;
        const bf16_t* ap = A + (size_t)(rt * 16 + fr) * lda + 8 * fq;
        const bf16_t* bp0 = Bt + (size_t)(f.b0(pr) + fr) * K + 8 * fq;
        const bf16_t* bp1 = Bt + (size_t)(f.b1(pr) + fr) * K + 8 * fq;
        f32x4 c0 = {0.f, 0.f, 0.f, 0.f}, c1 = {0.f, 0.f, 0.f, 0.f};
        for (int k0 = 0; k0 < K; k0 += 256) {
            bf16x8 a[8], x[8], y[8];
#pragma unroll
            for (int i = 0; i < 8; ++i) { a[i] = *(const bf16x8*)(ap + k0 + i * 32); x[i] = *(const bf16x8*)(bp0 + k0 + i * 32); y[i] = *(const bf16x8*)(bp1 + k0 + i * 32); }
#pragma unroll
            for (int i = 0; i < 8; ++i) { c0 = mfma16(x[i], a[i], c0); c1 = mfma16(y[i], a[i], c1); }
        }
        f.epi(rt * 16 + fr, pr, fq, c0, c1);
    }
}
template <int KS, class F>
__device__ __forceinline__ void thin_gemm_sk(LAS unsigned char* lds, const bf16_t* A, int lda, const bf16_t* Bt, int K, int npairs, const F& f, int w, int lane) {
    const int fr = lane & 15, fq = lane >> 4, ntask = npairs * 8;
    LAS float* P = (LAS float*)lds;
    for (int task = blockIdx.x; task < ntask; task += gridDim.x) {
        const int rt = task & 7, pr = task >> 3, k0 = w * KS * 32;
        const bf16_t* ap = A + (size_t)(rt * 16 + fr) * lda + 8 * fq + k0;
        const bf16_t* bp0 = Bt + (size_t)(f.b0(pr) + fr) * K + 8 * fq + k0;
        const bf16_t* bp1 = Bt + (size_t)(f.b1(pr) + fr) * K + 8 * fq + k0;
        f32x4 c0 = {0.f, 0.f, 0.f, 0.f}, c1 = {0.f, 0.f, 0.f, 0.f};
        bf16x8 a[KS], x[KS], y[KS];
#pragma unroll
        for (int i = 0; i < KS; ++i) { a[i] = *(const bf16x8*)(ap + i * 32); x[i] = *(const bf16x8*)(bp0 + i * 32); y[i] = *(const bf16x8*)(bp1 + i * 32); }
#pragma unroll
        for (int i = 0; i < KS; ++i) { c0 = mfma16(x[i], a[i], c0); c1 = mfma16(y[i], a[i], c1); }
        *(LAS f32x4*)(P + (w * 64 + lane) * 8) = c0; *(LAS f32x4*)(P + (w * 64 + lane) * 8 + 4) = c1;
        __syncthreads();
        if (w == 0) {
            f32x4 s0 = {0.f, 0.f, 0.f, 0.f}, s1 = {0.f, 0.f, 0.f, 0.f};
#pragma unroll
            for (int q = 0; q < 8; ++q) { s0 += *(const LAS f32x4*)(P + (q * 64 + lane) * 8); s1 += *(const LAS f32x4*)(P + (q * 64 + lane) * 8 + 4); }
            f.epi(rt * 16 + fr, pr, fq, s0, s1);
        }
        __syncthreads();
    }
}
struct ThinZ { bf16_t* Z; const unsigned long long* ssq;
    __device__ __forceinline__ int b0(int pr) const { return pr * 32; }
    __device__ __forceinline__ int b1(int pr) const { return pr * 32 + 16; }
    __device__ __forceinline__ void epi(int r, int pr, int fq, f32x4 c0, f32x4 c1) const {
        const int row = NPROMPT + r; const float rs = ssq_rs(ssq, row); c0 = c0 * rs; c1 = c1 * rs;
        bf16_t* zp = Z + (size_t)row * ZLD + pr * 32 + 4 * fq; u32x2 a, b; a.x = pk2(c0[0], c0[1]); a.y = pk2(c0[2], c0[3]); b.x = pk2(c1[0], c1[1]); b.y = pk2(c1[2], c1[3]);
        *(u32x2*)zp = a; *(u32x2*)(zp + 16) = b; }
};
struct ThinRes { bf16_t* XB; unsigned long long* ssq;
    __device__ __forceinline__ int b0(int pr) const { return pr * 32; }
    __device__ __forceinline__ int b1(int pr) const { return pr * 32 + 16; }
    __device__ __forceinline__ void epi(int r, int pr, int fq, f32x4 c0, f32x4 c1) const {
        const int row = NPROMPT + r; bf16_t* bp = XB + (size_t)row * DM + pr * 32 + 4 * fq;
        float x0[4], x1[4]; unpack4(*(const u32x2*)bp, x0); unpack4(*(const u32x2*)(bp + 16), x1);
        u32x2 a, b; a.x = pk2(x0[0] + c0[0], x0[1] + c0[1]); a.y = pk2(x0[2] + c0[2], x0[3] + c0[3]); b.x = pk2(x1[0] + c1[0], x1[1] + c1[1]); b.y = pk2(x1[2] + c1[2], x1[3] + c1[3]);
        *(u32x2*)bp = a; *(u32x2*)(bp + 16) = b; float o0[4], o1[4]; unpack4(a, o0); unpack4(b, o1);
        float s = (o0[0] * o0[0] + o0[1] * o0[1]) + (o0[2] * o0[2] + o0[3] * o0[3]) + (o1[0] * o1[0] + o1[1] * o1[1]) + (o1[2] * o1[2] + o1[3] * o1[3]);
        s += __shfl_xor(s, 16); s += __shfl_xor(s, 32);
        if (fq == 0) ssq_add(ssq, row, s); }
};
struct ThinAct { bf16_t* ACT; const unsigned long long* ssq;
    __device__ __forceinline__ int b0(int pr) const { const int c = pr * 16; return (c >> 7) * 256 + (c & 127); }
    __device__ __forceinline__ int b1(int pr) const { const int c = pr * 16; return (c >> 7) * 256 + 128 + (c & 127); }
    __device__ __forceinline__ void epi(int r, int pr, int fq, f32x4 c0, f32x4 c1) const {
        const int row = NPROMPT + r; const float rs = ssq_rs(ssq, row); float o[4];
#pragma unroll
        for (int j = 0; j < 4; ++j) { const float g = c0[j] * rs, up = c1[j] * rs; o[j] = g * sigmoidf_(g) * up; }
        u32x2 a; a.x = pk2(o[0], o[1]); a.y = pk2(o[2], o[3]); *(u32x2*)(ACT + (size_t)row * DFF + pr * 16 + 4 * fq) = a; }
};

struct TileDesc { const float* src; const float* gain; bf16_t* dst; int lds_src, ld_dst; };
__device__ __forceinline__ TileDesc tile_desc(const Ctx& c, int l, unsigned char* wb, int t) {
    bf16_t* WinT = (bf16_t*)(wb + WB_WIN); bf16_t* WoutT = (bf16_t*)(wb + WB_WOUT); bf16_t* WguT = (bf16_t*)(wb + WB_WGU); bf16_t* WdnT = (bf16_t*)(wb + WB_WDN); bf16_t* GLUT = (bf16_t*)(wb + WB_GLU);
    const int NT_IN = 16 * 38, NT_OUT = 256, NT_GU = 16 * 88, NT_DN = 44 * 16;
    TileDesc d; int q = t;
    if (q < NT_IN) { const int kt = q & 15, nt = q >> 4; d.src = c.in[8] + (size_t)l * 1024 * INC + (size_t)kt * 64 * INC + nt * 64; d.lds_src = INC; d.gain = c.in[7] + l * 1024 + kt * 64; d.dst = WinT + (size_t)nt * 64 * 1024 + kt * 64; d.ld_dst = 1024; return d; }
    q -= NT_IN;
    if (q < NT_OUT) { const int kt = q & 15, nt = q >> 4; const int bm = (kt >> 2) == 0 ? 3 : ((kt >> 2) == 1 ? 1 : ((kt >> 2) == 2 ? 0 : 2)); const int ks = bm * 256 + (kt & 3) * 64;
        d.src = c.in[36] + (size_t)l * 1024 * 1024 + (size_t)ks * 1024 + nt * 64; d.lds_src = 1024; d.gain = nullptr; d.dst = WoutT + (size_t)nt * 64 * 1024 + kt * 64; d.ld_dst = 1024; return d; }
    q -= NT_OUT;
    if (q < NT_GU) { const int kt = q & 15, nt = q >> 4; const int n0 = nt * 64; int dr; if (n0 < DFF) dr = (n0 >> 7) * 256 + (n0 & 127); else { const int n1 = n0 - DFF; dr = (n1 >> 7) * 256 + 128 + (n1 & 127); }
        d.src = c.in[38] + (size_t)l * 1024 * 5632 + (size_t)kt * 64 * 5632 + n0; d.lds_src = 5632; d.gain = c.in[37] + l * 1024 + kt * 64; d.dst = WguT + (size_t)dr * 1024 + kt * 64; d.ld_dst = 1024; return d; }
    q -= NT_GU;
    if (q < NT_DN) { const int nt = q & 15, kt = q >> 4; d.src = c.in[39] + (size_t)l * DFF * 1024 + (size_t)kt * 64 * 1024 + nt * 64; d.lds_src = 1024; d.gain = nullptr; d.dst = WdnT + (size_t)nt * 64 * DFF + kt * 64; d.ld_dst = DFF; return d; }
    q -= NT_DN;
    { const int kt = q & 3, nt = q >> 2; d.src = c.in[21] + (size_t)l * 65536 + (size_t)kt * 64 * 256 + nt * 64; d.lds_src = 256; d.gain = nullptr; d.dst = GLUT + (size_t)nt * 64 * 256 + kt * 64; d.ld_dst = 256; return d; }
}
struct TileRegs { f32x4 v[2]; float g[2]; };
__device__ __forceinline__ void tile_load(TileRegs& r, const TileDesc& d, int tid) {
    const int i = tid >> 4, j4 = (tid & 15) * 4;
#pragma unroll
    for (int p = 0; p < 2; ++p) { const int k = i + p * 32; r.v[p] = __builtin_nontemporal_load((const f32x4*)(d.src + (size_t)k * d.lds_src + j4)); r.g[p] = d.gain ? d.gain[k] : 1.0f; }
}
__device__ void convert_weights(const Ctx& c, int l, int buf, int part = -1, int wgi = -1, int nwg = 0) {
    if (wgi < 0) { wgi = blockIdx.x; nwg = gridDim.x; }
    asm volatile("" : "+s"(nwg), "+s"(wgi));
    unsigned char* wb = c.WB() + (size_t)buf * WB_SIZE;
    bf16_t* WinT = (bf16_t*)(wb + WB_WIN); bf16_t* LORAT = (bf16_t*)(wb + WB_LORA); bf16_t* WSB = (bf16_t*)(wb + WB_WSB);
    const int total = 16 * 38 + 256 + 16 * 88 + 44 * 16 + 16;
    const int t_lo = (part == 1) ? total / 2 : 0, t_hi = (part == 0) ? total / 2 : total;
    LAS float* T = (LAS float*)c.lds; const int tid = c.tid;
    int t = t_lo + wgi;
    if (t < t_hi) {
        TileDesc d = tile_desc(c, l, wb, t); TileRegs r; tile_load(r, d, tid);
        for (;;) {
            { const int i = tid >> 4, j4 = (tid & 15) * 4;
#pragma unroll
              for (int p = 0; p < 2; ++p) { const int k = i + p * 32; T[k * 65 + j4 + 0] = r.v[p][0] * r.g[p]; T[k * 65 + j4 + 1] = r.v[p][1] * r.g[p]; T[k * 65 + j4 + 2] = r.v[p][2] * r.g[p]; T[k * 65 + j4 + 3] = r.v[p][3] * r.g[p]; } }
            __syncthreads();
            const int tn = t + nwg; const bool more = tn < t_hi; const TileDesc dcur = d;
            if (more) { d = tile_desc(c, l, wb, tn); tile_load(r, d, tid); }
            { const int jn = tid >> 3, kq = (tid & 7) * 8; float z[8];
#pragma unroll
              for (int e = 0; e < 8; ++e) z[e] = T[(kq + e) * 65 + jn];
              *(bf16x8*)(dcur.dst + (size_t)jn * dcur.ld_dst + kq) = pack8(z); }
            __syncthreads();
            if (!more) break;
            t = tn;
        }
    }
    if (part == 1) return;
    const int gt = wgi * 512 + c.tid, gn = nwg * 512;
    for (int i = gt; i < 128 * 1024; i += gn) WinT[(size_t)INC * 1024 + i] = 0;
    for (int i = gt; i < 256 * 128; i += gn) { const int n = i >> 7, k = i & 127; float v;
        if (k < 32) v = c.in[27][(size_t)l * 32 * 256 + k * 256 + n]; else if (k < 64) v = c.in[29][(size_t)l * 32 * 256 + (k - 32) * 256 + n]; else v = c.in[30][(size_t)l * 64 * 256 + (k - 64) * 256 + n];
        LORAT[i] = f2bf(v); }
    for (int i = gt; i < 4 * 128 * 128; i += gn) { const int s = i & 127, t = (i >> 7) & 127; WSB[i] = (s <= t) ? f2bf(c.in[11][(size_t)l * 65536 + i]) : (bf16_t)0; }
}

__device__ void phase0(const Ctx& c) {
    for (int row0 = c.gw; row0 < NR; row0 += 5 * c.nw) {
        f32x4 v[5][4];
#pragma unroll
        for (int u = 0; u < 5; ++u) { const int row = (row0 + u * c.nw < NR) ? row0 + u * c.nw : row0; const float* src = row < NPROMPT ? c.in[0] + (size_t)row * DM : c.in[1] + (size_t)(row - NPROMPT) * DM;
#pragma unroll
            for (int j = 0; j < 4; ++j) v[u][j] = __builtin_nontemporal_load((const f32x4*)(src + j * 256 + c.lane * 4)); }
#pragma unroll
        for (int u = 0; u < 5; ++u) { const int row = row0 + u * c.nw; if (row < NR) { float s = 0.f;
#pragma unroll
            for (int j = 0; j < 4; ++j) { const int col = j * 256 + c.lane * 4; u32x2 w; w.x = pk2(v[u][j][0], v[u][j][1]); w.y = pk2(v[u][j][2], v[u][j][3]); *(u32x2*)(c.XB() + (size_t)row * DM + col) = w; float o[4]; unpack4(w, o); s += (o[0] * o[0] + o[1] * o[1]) + (o[2] * o[2] + o[3] * o[3]); }
            s = wave_sum(s); if (c.lane == 0) c.SSQ()[row] = (unsigned long long)(s * SSQ_SCALE + 0.5f); } }
    }
    for (int i = blockIdx.x * 512 + c.tid; i < 8 * NR; i += gridDim.x * 512) c.SSQ()[NR + i] = 0ull;
    for (int i = blockIdx.x * 512 + c.tid; i < NL * 1024; i += gridDim.x * 512) {
        const float lam_re = fminf(c.in[13][i], -1e-4f), lam_im = c.in[14][i], dt = expf(c.in[15][i]);
        const float mag = expf(lam_re * dt); float sn, cs; sincosf(lam_im * dt, &sn, &cs);
        const float lbr = mag * cs, lbi = mag * sn, den = lam_re * lam_re + lam_im * lam_im;
        const float f_re = ((lbr - 1.0f) * lam_re + lbi * lam_im) / den, f_im = (lbi * lam_re - (lbr - 1.0f) * lam_im) / den;
        c.LBC()[2 * i] = lbr; c.LBC()[2 * i + 1] = lbi;
        const int lg = i >> 6, pp = i & 63; bf16_t* bo = c.BBAR() + ((size_t)lg * 128 + 2 * pp) * 16;
#pragma unroll
        for (int q = 0; q < 4; ++q) { const f32x4 br = *(const f32x4*)(c.in[16] + (size_t)i * 16 + q * 4), bi = *(const f32x4*)(c.in[17] + (size_t)i * 16 + q * 4); float re[4], im[4];
#pragma unroll
            for (int e = 0; e < 4; ++e) { re[e] = f_re * br[e] - f_im * bi[e]; im[e] = f_re * bi[e] + f_im * br[e]; }
            u32x2 a; a.x = pk2(re[0], re[1]); a.y = pk2(re[2], re[3]); *(u32x2*)(bo + q * 4) = a; a.x = pk2(im[0], im[1]); a.y = pk2(im[2], im[3]); *(u32x2*)(bo + 16 + q * 4) = a; }
    }
    convert_weights(c, 0, 0);
}

template <int N> struct ZsVec { typedef u32x4 T; };
template <> struct ZsVec<4> { typedef u32x2 T; };
template <int N, bool SAMP> struct ZsIn {
    typename ZsVec<N>::T cur, prb; f32x4 prf[N / 4]; f32x4 mu[N / 4]; float pm;
    __device__ __forceinline__ void load(const Ctx& c, int l, int row, int col) {
        typedef typename ZsVec<N>::T V;
        const bf16_t* zp = c.Z() + (size_t)row * ZLD + 1536 + col;
        cur = *(const V*)zp;
        pm = 1.0f;
        if (!SAMP) { const bool first = (row & (SEQ - 1)) == 0; pm = first ? 0.f : 1.f; const bf16_t* pp = first ? zp : zp - ZLD; prb = *(const V*)pp; }
        else { const float* sp = c.in[3] + ((size_t)l * NSAMP + (row - NPROMPT)) * DTM + col;
#pragma unroll
            for (int e = 0; e < N / 4; ++e) prf[e] = *(const f32x4*)(sp + 4 * e); }
        const float* m = c.in[25] + l * DTM + col;
#pragma unroll
        for (int e = 0; e < N / 4; ++e) mu[e] = *(const f32x4*)(m + 4 * e);
    }
    __device__ __forceinline__ void eval(float* out) const {
        float cu[N], pv[N];
        if constexpr (N == 8) unpack8(cur, cu); else unpack4(cur, cu);
        if (!SAMP) { if constexpr (N == 8) unpack8(prb, pv); else unpack4(prb, pv); }
        else {
#pragma unroll
            for (int e = 0; e < N; ++e) pv[e] = prf[e >> 2][e & 3]; }
#pragma unroll
        for (int e = 0; e < N; ++e) out[e] = cu[e] + mu[e >> 2][e & 3] * (pm * pv[e] - cu[e]);
    }
};

__device__ void d1_chunk(const Ctx& c, int blk, int h);
template <bool SAMP> __device__ __forceinline__ void rwkv_tok_task(const Ctx& c, int l, const bf16_t* LORAT, int blk, int h, int mt_lo, int mt_hi) {
    const int lane = c.lane, fr = lane & 15, fq = lane >> 4;
    for (int mt = mt_lo; mt < mt_hi; ++mt) {
        const int row = blk * 32 + mt * 16 + fr;
        bf16_t* tok = c.TOK() + (size_t)row * 1536;
        ZsIn<8, SAMP> za[4]; bf16x8 lf[4][4];
#pragma unroll
        for (int ks = 0; ks < 4; ++ks) za[ks].load(c, l, row, 768 + ks * 32 + 8 * fq);
#pragma unroll
        for (int nt = 0; nt < 4; ++nt)
#pragma unroll
            for (int ks = 0; ks < 4; ++ks) lf[nt][ks] = *(const bf16x8*)(LORAT + (size_t)(h * 64 + 32 * (nt >> 1) + 8 * (fr >> 2) + 4 * (nt & 1) + (fr & 3)) * 128 + ks * 32 + 8 * fq);
        bf16x8 af[4];
#pragma unroll
        for (int ks = 0; ks < 4; ++ks) { float z[8]; za[ks].eval(z);
#pragma unroll
            for (int e = 0; e < 8; ++e) z[e] = (ks == 0) ? tanh_(z[e]) : ((ks == 1) ? z[e] : sigmoidf_(z[e]));
            af[ks] = pack8(z); }
        f32x4 aw[4], aa[4], ag[4];
#pragma unroll
        for (int nt = 0; nt < 4; ++nt) { const f32x4 zero = {0.f, 0.f, 0.f, 0.f};
            aw[nt] = mfma16(lf[nt][0], af[0], zero); aa[nt] = mfma16(lf[nt][1], af[1], zero); ag[nt] = mfma16(lf[nt][2], af[2], zero); ag[nt] = mfma16(lf[nt][3], af[3], ag[nt]); }
        float n2 = 0.f, bon = 0.f; float kkr[16], av[16];
#pragma unroll
        for (int np = 0; np < 2; ++np) {
            asm volatile("" ::: "memory");
            const int cb = h * 64 + 32 * np + 8 * fq;
            ZsIn<8, SAMP> zr, zk, zv; f32x4 w0[2], a0[2], kk_[2], ka[2], rk[2];
            zr.load(c, l, row, cb); zk.load(c, l, row, 256 + cb); zv.load(c, l, row, 512 + cb);
#pragma unroll
            for (int q = 0; q < 2; ++q) { const int ch = cb + 4 * q;
                w0[q] = *(const f32x4*)(c.in[26] + l * 256 + ch); a0[q] = *(const f32x4*)(c.in[28] + l * 256 + ch); kk_[q] = *(const f32x4*)(c.in[31] + l * 256 + ch);
                ka[q] = *(const f32x4*)(c.in[32] + l * 256 + ch); rk[q] = *(const f32x4*)(c.in[33] + l * 256 + ch); }
            float rz[8], kz[8], vz[8]; zr.eval(rz); zk.eval(kz); zv.eval(vz);
            float km[8], ld[8], gg[8];
#pragma unroll
            for (int q = 0; q < 2; ++q) { const int nt = 2 * np + q;
#pragma unroll
                for (int e = 0; e < 4; ++e) { const int i8 = 4 * q + e;
                    const float x = -(w0[q][e] + aw[nt][e]); const float sp = fmaxf(x, 0.f) + __logf(1.0f + __expf(-fabsf(x))); const float wv = -sp - 0.5f; ld[i8] = -__expf(wv);
                    const float a = sigmoidf_(a0[q][e] + aa[nt][e]); gg[i8] = ag[nt][e];
                    const float kr = kz[i8] * kk_[q][e]; n2 += kr * kr; km[i8] = kz[i8] * (1.0f + (a - 1.0f) * ka[q][e]); bon += rz[i8] * km[i8] * rk[q][e];
                    kkr[nt * 4 + e] = kr; av[nt * 4 + e] = a; } }
            *(bf16x8*)(tok + cb) = pack8(rz); *(bf16x8*)(tok + 256 + cb) = pack8(km); *(bf16x8*)(tok + 512 + cb) = pack8(vz); *(bf16x8*)(tok + 1280 + cb) = pack8(ld);
            *(bf16x8*)(c.GG() + (size_t)row * 256 + cb) = pack8(gg);
        }
        n2 += __shfl_xor(n2, 16); n2 += __shfl_xor(n2, 32); bon += __shfl_xor(bon, 16); bon += __shfl_xor(bon, 32);
        const float inv = 1.0f / fmaxf(sqrtf(n2), 1e-12f);
#pragma unroll
        for (int np = 0; np < 2; ++np) { const int cb = h * 64 + 32 * np + 8 * fq; float kk[8], bv[8];
#pragma unroll
            for (int i8 = 0; i8 < 8; ++i8) { const int idx = (2 * np + (i8 >> 2)) * 4 + (i8 & 3); kk[i8] = kkr[idx] * inv; bv[i8] = kk[i8] * av[idx]; }
            *(bf16x8*)(tok + 768 + cb) = pack8(kk); *(bf16x8*)(tok + 1024 + cb) = pack8(bv); }
        if (fq == 0) c.BON()[(size_t)row * 4 + h] = bon;
        asm volatile("" ::: "memory");
    }
}
__device__ void rwkv_tok(const Ctx& c, int l, int buf) {
    const bf16_t* LORAT = (const bf16_t*)(c.WB() + (size_t)buf * WB_SIZE + WB_LORA);
    for (int task = c.gw; task < (NPROMPT / 32) * 4; task += c.nw) rwkv_tok_task<false>(c, l, LORAT, task >> 2, task & 3, 0, 2);
    for (int ht = c.w * (int)gridDim.x + (int)blockIdx.x; ht < (NSAMP / 16) * 4; ht += 8 * (int)gridDim.x) { const int b16 = ht >> 2; rwkv_tok_task<true>(c, l, LORAT, NPROMPT / 32 + (b16 >> 1), ht & 3, b16 & 1, (b16 & 1) + 1); }
}

__device__ void conv_phase(const Ctx& c, int l) {
    const float* cw = c.in[23] + l * 768; const float* cb = c.in[24] + l * 256;
    for (int task = blockIdx.x * 512 + c.tid; task < (NPROMPT / 8) * 64; task += gridDim.x * 512) {
        const int cq = (task & 63) * 4, r0 = (task >> 6) * 8;
        const f32x4 w0 = *(const f32x4*)(cw + cq), w1 = *(const f32x4*)(cw + 256 + cq), w2 = *(const f32x4*)(cw + 512 + cq), bb = *(const f32x4*)(cb + cq);
        const int t0 = r0 & (SEQ - 1); const float pm = t0 ? 1.f : 0.f; const int rp = t0 ? r0 - 2 : r0;
        u32x2 zx[10], zc[10], zb[8];
#pragma unroll
        for (int i = 0; i < 10; ++i) { const int row = (i < 2) ? rp + i : r0 + i - 2; const bf16_t* zr = c.Z() + (size_t)row * ZLD; zx[i] = *(const u32x2*)(zr + 768 + cq); zc[i] = *(const u32x2*)(zr + 1280 + cq); if (i >= 2) zb[i - 2] = *(const u32x2*)(zr + 1024 + cq); }
        float zm2[4], zm1[4];
        { float a[4], b[4]; unpack4(zx[0], a); unpack4(zc[0], b);
#pragma unroll
          for (int e = 0; e < 4; ++e) zm2[e] = pm * a[e] * b[e];
          unpack4(zx[1], a); unpack4(zc[1], b);
#pragma unroll
          for (int e = 0; e < 4; ++e) zm1[e] = pm * a[e] * b[e]; }
#pragma unroll
        for (int i = 0; i < 8; ++i) { const int row = r0 + i; bf16_t* zr = c.Z() + (size_t)row * ZLD; float a[4], b[4], g[4], z0[4], y[4];
            unpack4(zx[i + 2], a); unpack4(zc[i + 2], b); unpack4(zb[i], g);
#pragma unroll
            for (int e = 0; e < 4; ++e) { z0[e] = a[e] * b[e]; y[e] = g[e] * (bb[e] + w0[e] * zm2[e] + w1[e] * zm1[e] + w2[e] * z0[e]); zm2[e] = zm1[e]; zm1[e] = z0[e]; }
            u32x2 p; p.x = pk2(y[0], y[1]); p.y = pk2(y[2], y[3]); *(u32x2*)(zr + 1024 + cq) = p;
            const int t = row & (SEQ - 1);
            if (t >= SEQ - 2) { float* o = c.out + O_CVP + (((size_t)l * NB + (row >> 11)) * 2 + (t - (SEQ - 2))) * 256 + cq; *(f32x4*)o = (f32x4){z0[0], z0[1], z0[2], z0[3]}; } }
    }
    for (int task = blockIdx.x * 512 + c.tid; task < NSAMP * 64; task += gridDim.x * 512) {
        const int cq = (task & 63) * 4, i = task >> 6, row = NPROMPT + i; bf16_t* zr = c.Z() + (size_t)row * ZLD;
        const f32x4 w0 = *(const f32x4*)(cw + cq), w1 = *(const f32x4*)(cw + 256 + cq), w2 = *(const f32x4*)(cw + 512 + cq), bb = *(const f32x4*)(cb + cq);
        const float* sc = c.in[6] + ((size_t)l * NSAMP + i) * 512; const f32x4 b0 = *(const f32x4*)(sc + cq), b1 = *(const f32x4*)(sc + 256 + cq);
        float a[4], b[4], g[4], y[4]; f32x4 z0;
        unpack4(*(const u32x2*)(zr + 768 + cq), a); unpack4(*(const u32x2*)(zr + 1280 + cq), b); unpack4(*(const u32x2*)(zr + 1024 + cq), g);
#pragma unroll
        for (int e = 0; e < 4; ++e) { z0[e] = a[e] * b[e]; y[e] = g[e] * (bb[e] + w0[e] * b0[e] + w1[e] * b1[e] + w2[e] * z0[e]); }
        u32x2 p; p.x = pk2(y[0], y[1]); p.y = pk2(y[2], y[3]); *(u32x2*)(zr + 1024 + cq) = p;
        float* o = c.out + O_CVS + ((size_t)l * NSAMP + i) * 512; *(f32x4*)(o + cq) = b1; *(f32x4*)(o + 256 + cq) = z0;
    }
}

__device__ void shift_out(const Ctx& c, int l, int first, int stride) {
    for (int i = first; i < (NB + NSAMP) * DTM; i += stride) {
        const int s = i / DTM, col = i - s * DTM;
        if (s < NB) c.out[O_SHP + ((size_t)l * NB + s) * DTM + col] = bf2f(c.Z()[(size_t)(s * SEQ + SEQ - 1) * ZLD + 1536 + col]);
        else c.out[O_SHS + ((size_t)l * NSAMP + (s - NB)) * DTM + col] = bf2f(c.Z()[(size_t)(NPROMPT + s - NB) * ZLD + 1536 + col]);
    }
}

constexpr int LDS_U = 0, LDS_S = 32768, LDS_YG = 102400, SLD = 136, YLD = 264;
template <bool FULL> __device__ void ssm_tile(const Ctx& c, int l, int tile, int h_lo = 0, int h_hi = 2) {
    const int lane = c.lane, w = c.w, fr = lane & 15, fq = lane >> 4;
    const bool samp = tile >= 256;
    const int row0 = samp ? NPROMPT + (tile - 256) * 64 : tile * 64, b = tile >> 5, ch = tile & 31;
    LAS bf16_t* S = (LAS bf16_t*)(c.lds + LDS_S + w * (32 * SLD * 2));
    LAS unsigned* S32 = (LAS unsigned*)S;
    LAS bf16_t* YG = (LAS bf16_t*)(c.lds + LDS_YG);
    float z0_ = 0.f; asm volatile("" : "+v"(z0_)); const f32x4 zero = {z0_, z0_, z0_, z0_};
    for (int gi = 0; gi < 2; ++gi) {
        const int g = 2 * w + gi, idx = (l * 16 + g) * 64 + lane;
        const f32x2 lb = *(const f32x2*)(c.LBC() + 2 * idx); const float lbr = lb.x, lbi = lb.y;
        bf16x8 bbf[8];
#pragma unroll
        for (int it = 0; it < 8; ++it) { u32x4 v = *(const u32x4*)(c.BBAR() + ((size_t)(l * 16 + g) * 128 + it * 16 + fr) * 16 + 8 * (fq & 1)); if (fq >= 2) v = (u32x4){0u, 0u, 0u, 0u}; bbf[it] = __builtin_bit_cast(bf16x8, v); }
        float sr = 0.f, si = 0.f;
        bf16x8 cm[4];
        const f32x4 dd = *(const f32x4*)(c.in[20] + (size_t)(l * 16 + g) * 16 + 4 * fq);
        if (FULL) {
            if (!samp) {
                float pr = lbr, pi = lbi;
#pragma unroll
                for (int q = 0; q < 6; ++q) { const float nr = pr * pr - pi * pi, ni = 2.0f * pr * pi; pr = nr; pi = ni; }
                for (int cc0 = 0; cc0 < ch; cc0 += 8) { f32x2 e[8];
#pragma unroll
                    for (int u = 0; u < 8; ++u) { const int cc = (cc0 + u < ch) ? cc0 + u : cc0; e[u] = *(const f32x2*)(c.EE() + ((size_t)((b * 32 + cc) * 16 + g) * 64 + lane) * 2); }
#pragma unroll
                    for (int u = 0; u < 8; ++u) if (cc0 + u < ch) { const float nr = pr * sr - pi * si + e[u].x, ni = pr * si + pi * sr + e[u].y; sr = nr; si = ni; } }
            }
#pragma unroll
            for (int ks = 0; ks < 4; ++ks) { const size_t co = ((size_t)(l * 16 + g) * 16 + fr) * 64 + ks * 16 + 4 * fq; const f32x4 vr = *(const f32x4*)(c.in[18] + co), vi = *(const f32x4*)(c.in[19] + co);
                float z[8] = {vr[0], -vi[0], vr[1], -vi[1], vr[2], -vi[2], vr[3], -vi[3]}; cm[ks] = pack8(z); }
        }
        for (int half = h_lo; half < h_hi; ++half) {
            asm volatile("s_waitcnt lgkmcnt(0)" ::: "memory");
            u32x4 uvv[2]; u32x2 uue[2];
#pragma unroll
            for (int jt = 0; jt < 2; ++jt) { const bf16_t* up = c.Z() + (size_t)(row0 + half * 32 + jt * 16 + fr) * ZLD + 512 + g * 16; uvv[jt] = *(const u32x4*)(up + 8 * (fq & 1)); uue[jt] = *(const u32x2*)(up + 4 * fq); }
#pragma unroll
            for (int jt = 0; jt < 2; ++jt) { u32x4 uv = uvv[jt]; if (fq >= 2) uv = (u32x4){0u, 0u, 0u, 0u};
                const bf16x8 uf = __builtin_bit_cast(bf16x8, uv);
#pragma unroll
                for (int it = 0; it < 8; ++it) { const f32x4 d = mfma16(bbf[it], uf, zero); u32x2 pq; pq.x = pk2(d[0], d[1]); pq.y = pk2(d[2], d[3]); *(LAS u32x2*)(S + (jt * 16 + fr) * SLD + it * 16 + 4 * fq) = pq; } }
            asm volatile("s_waitcnt lgkmcnt(0)" ::: "memory");
            if (FULL && samp) {
#pragma unroll 1
                for (int t0 = 0; t0 < 32; t0 += 16) { float pr[16], pi[16]; const size_t sbase = ((size_t)(l * NSAMP + (row0 - NPROMPT) + half * 32 + t0) * 16 + g) * 64 + lane;
#pragma unroll
                    for (int u = 0; u < 16; ++u) { pr[u] = c.in[4][sbase + (size_t)u * 1024]; pi[u] = c.in[5][sbase + (size_t)u * 1024]; }
#pragma unroll
                    for (int u = 0; u < 16; ++u) { const unsigned wv = S32[(t0 + u) * (SLD / 2) + lane];
                        const float nr = lbr * pr[u] - lbi * pi[u] + bflo(wv), ni = lbr * pi[u] + lbi * pr[u] + bfhi(wv);
                        S32[(t0 + u) * (SLD / 2) + lane] = pk2(nr, ni); c.out[O_RES + sbase + (size_t)u * 1024] = nr; c.out[O_IMS + sbase + (size_t)u * 1024] = ni; }
                    asm volatile("" ::: "memory"); }
            } else {
#pragma unroll 1
            for (int tt0 = 0; tt0 < 32; tt0 += 8) { unsigned wv[8];
#pragma unroll
                for (int u = 0; u < 8; ++u) wv[u] = S32[(tt0 + u) * (SLD / 2) + lane];
#pragma unroll
                for (int u = 0; u < 8; ++u) { const float nr = lbr * sr - lbi * si + bflo(wv[u]), ni = lbr * si + lbi * sr + bfhi(wv[u]); sr = nr; si = ni;
                    if (FULL) S32[(tt0 + u) * (SLD / 2) + lane] = pk2(sr, si); }
            }
            }
            if (FULL) {
                asm volatile("s_waitcnt lgkmcnt(0)" ::: "memory");
#pragma unroll
                for (int mt = 0; mt < 2; ++mt) { f32x4 acc = zero;
#pragma unroll
                    for (int ks = 0; ks < 4; ++ks) { const bf16x8 sf = *(const LAS bf16x8*)(S + (mt * 16 + fr) * SLD + ks * 32 + 8 * fq); acc = mfma16(cm[ks], sf, acc); }
                    const int t = half * 32 + mt * 16 + fr; float uu[4]; unpack4(uue[mt], uu);
                    float y[4];
#pragma unroll
                    for (int e = 0; e < 4; ++e) y[e] = gelu_t(acc[e] + dd[e] * uu[e]);
                    u32x2 p; p.x = pk2(y[0], y[1]); p.y = pk2(y[2], y[3]); *(LAS u32x2*)(YG + t * YLD + g * 16 + 4 * fq) = p; }
            }
        }
        if (!FULL) { *(f32x2*)(c.EE() + ((size_t)((b * 32 + ch) * 16 + g) * 64 + lane) * 2) = (f32x2){sr, si}; }
        else if (!samp && ch == 31) { const size_t so = ((size_t)(l * NB + b) * 16 + g) * 64 + lane; c.out[O_REP + so] = sr; c.out[O_IMP + so] = si; }
    }
}
__device__ void ssm_glu(const Ctx& c, int l, int buf, int tile, int mt_lo = 0, int mt_hi = 4) {
    const bf16_t* GLUT = (const bf16_t*)(c.WB() + (size_t)buf * WB_SIZE + WB_GLU);
    const int lane = c.lane, w = c.w, fr = lane & 15, fq = lane >> 4;
    const int row0 = tile >= 256 ? NPROMPT + (tile - 256) * 64 : tile * 64;
    LAS bf16_t* YG = (LAS bf16_t*)(c.lds + LDS_YG);
    f32x4 acc[4][2];
#pragma unroll
    for (int mt = 0; mt < 4; ++mt) { acc[mt][0] = zero4(); acc[mt][1] = zero4(); }
#pragma unroll
    for (int ks = 0; ks < 8; ++ks) { bf16x8 bf[2];
#pragma unroll
        for (int nn = 0; nn < 2; ++nn) bf[nn] = *(const bf16x8*)(GLUT + (size_t)((2 * w + nn) * 16 + fr) * 256 + ks * 32 + 8 * fq);
#pragma unroll
        for (int mt = 0; mt < 4; ++mt) { const bf16x8 af = *(const LAS bf16x8*)(YG + (mt * 16 + fr) * YLD + ks * 32 + 8 * fq); acc[mt][0] = mfma16(bf[0], af, acc[mt][0]); acc[mt][1] = mfma16(bf[1], af, acc[mt][1]); } }
    f32x4 gbv[2];
#pragma unroll
    for (int nn = 0; nn < 2; ++nn) gbv[nn] = *(const f32x4*)(c.in[22] + l * 256 + (2 * w + nn) * 16 + 4 * fq);
#pragma unroll
    for (int mt = 0; mt < 4; ++mt)
#pragma unroll
        for (int nn = 0; nn < 2; ++nn) if (mt >= mt_lo && mt < mt_hi) { const int t = mt * 16 + fr, j = (2 * w + nn) * 16 + 4 * fq; float yg[4]; unpack4(*(const LAS u32x2*)(YG + t * YLD + j), yg);
            const f32x4 gb = gbv[nn]; float o[4];
#pragma unroll
            for (int e = 0; e < 4; ++e) o[e] = yg[e] * sigmoidf_(acc[mt][nn][e] + gb[e]);
            u32x2 p; p.x = pk2(o[0], o[1]); p.y = pk2(o[2], o[3]); *(u32x2*)(c.Z() + (size_t)(row0 + t) * ZLD + 512 + j) = p; }
}

template <bool WHOLE> __device__ void gmlp_tile(const Ctx& c, int l, int buf, int tile) {
    const bf16_t* WSB = (const bf16_t*)(c.WB() + (size_t)buf * WB_SIZE + WB_WSB);
    const int lane = c.lane, w = c.w, fr = lane & 15, fq = lane >> 4;
    const int b = WHOLE ? tile >> 4 : tile >> 5, cc = WHOLE ? (tile & 15) : ((tile & 31) >> 1), h_lo = WHOLE ? 0 : (tile & 1), h_hi = WHOLE ? 2 : (tile & 1) + 1, nKall = 64 * h_hi, rowc0 = b * SEQ + cc * 128;
    LAS bf16_t* VNt = (LAS bf16_t*)c.lds;
    const float* lg = c.in[9] + l * 256; const float* lb = c.in[10] + l * 256;
    u32x2 zuA[2][2][4]; float bsA[2][2];
    if constexpr (WHOLE) {
#pragma unroll
        for (int hh = 0; hh < 2; ++hh)
#pragma unroll
            for (int mi = 0; mi < 2; ++mi) { const int tt = hh * 64 + ((w & 1) * 2 + mi) * 16 + fr; bsA[hh][mi] = c.in[12][(size_t)l * 512 + (w >> 1) * 128 + tt]; const bf16_t* zr = c.Z() + (size_t)(rowc0 + tt) * ZLD;
#pragma unroll
                for (int nt = 0; nt < 4; ++nt) zuA[hh][mi][nt] = *(const u32x2*)(zr + (w >> 1) * 64 + nt * 16 + 4 * fq); }
    }
    constexpr int LNB = WHOLE ? 16 : 8;
    for (int s0 = w; s0 < nKall; s0 += 8 * LNB) { unsigned raw[LNB][4];
#pragma unroll
        for (int u = 0; u < LNB; ++u) { const bf16_t* zp = c.Z() + (size_t)(rowc0 + s0 + 8 * u) * ZLD + 256;
#pragma unroll
            for (int j = 0; j < 4; ++j) raw[u][j] = zp[lane + 64 * j]; }
#pragma unroll
        for (int u = 0; u < LNB; ++u) { const int s = s0 + 8 * u; float v[4]; float sum = 0.f;
            float q = 0.f;
#pragma unroll
            for (int j = 0; j < 4; ++j) { v[j] = gelu_t(__uint_as_float(raw[u][j] << 16)); sum += v[j]; q += v[j] * v[j]; }
            const float mean = wave_sum(sum) * (1.0f / 256.0f);
            const float rstd = rsqrtf(fmaxf(wave_sum(q) * (1.0f / 256.0f) - mean * mean, 0.f) + 1e-5f);
#pragma unroll
            for (int j = 0; j < 4; ++j) { const int chn = lane + 64 * j; VNt[chn * SLD + s] = f2bf((v[j] - mean) * rstd * lg[chn] + lb[chn]); } } }
    __syncthreads();
    const int h = w >> 1, mts = (w & 1) * 2;
#pragma unroll
    for (int half = 0; half < 2; ++half) { if (!WHOLE && (half < h_lo || half >= h_hi)) continue;
    const int nK = 64 * (half + 1);
    f32x4 acc[2][4];
#pragma unroll
    for (int mi = 0; mi < 2; ++mi)
#pragma unroll
        for (int nt = 0; nt < 4; ++nt) acc[mi][nt] = zero4();
    bf16x8 wf[4][2];
#pragma unroll
    for (int ks = 0; ks < 4; ++ks)
#pragma unroll
        for (int mi = 0; mi < 2; ++mi) { const int tt = half * 64 + (mts + mi) * 16 + fr; const int kse = (ks < nK / 32) ? ks : 0; wf[ks][mi] = *(const bf16x8*)(WSB + (size_t)(h * 128 + tt) * 128 + kse * 32 + 8 * fq); }
#pragma unroll
    for (int ks = 0; ks < 4; ++ks) if (ks < nK / 32) { bf16x8 bf[4];
#pragma unroll
        for (int nt = 0; nt < 4; ++nt) bf[nt] = *(const LAS bf16x8*)(VNt + (h * 64 + nt * 16 + fr) * SLD + ks * 32 + 8 * fq);
#pragma unroll
        for (int mi = 0; mi < 2; ++mi)
#pragma unroll
            for (int nt = 0; nt < 4; ++nt) acc[mi][nt] = mfma16(bf[nt], wf[ks][mi], acc[mi][nt]); }
    { u32x2 zu[2][4]; float bsv[2];
#pragma unroll
      for (int mi = 0; mi < 2; ++mi) { const int tt = half * 64 + (mts + mi) * 16 + fr; bsv[mi] = c.in[12][(size_t)l * 512 + h * 128 + tt]; const bf16_t* zr = c.Z() + (size_t)(rowc0 + tt) * ZLD;
#pragma unroll
          for (int nt = 0; nt < 4; ++nt) { if constexpr (WHOLE) zu[mi][nt] = zuA[half][mi][nt]; else zu[mi][nt] = *(const u32x2*)(zr + h * 64 + nt * 16 + 4 * fq); }
          if constexpr (WHOLE) bsv[mi] = bsA[half][mi]; }
#pragma unroll
      for (int mi = 0; mi < 2; ++mi) { const int tt = half * 64 + (mts + mi) * 16 + fr; bf16_t* zr = c.Z() + (size_t)(rowc0 + tt) * ZLD;
#pragma unroll
          for (int nt = 0; nt < 4; ++nt) { const int chn = h * 64 + nt * 16 + 4 * fq; float u[4]; unpack4(zu[mi][nt], u); float o[4];
#pragma unroll
              for (int e = 0; e < 4; ++e) o[e] = gelu_t(u[e]) * (acc[mi][nt][e] + bsv[mi]);
              u32x2 p; p.x = pk2(o[0], o[1]); p.y = pk2(o[2], o[3]); *(u32x2*)(zr + 768 + chn) = p; } } }
    }
    __syncthreads();
}
__device__ void gmlp_sample(const Ctx& c, int l, int first, int stride) {
    const int lane = c.lane, h = lane >> 4;
    for (int i = first; i < NSAMP; i += stride) { const int row = NPROMPT + i; bf16_t* zr = c.Z() + (size_t)row * ZLD; float v[4], u[4]; unpack4(*(const u32x2*)(zr + 256 + 4 * lane), v); unpack4(*(const u32x2*)(zr + 4 * lane), u);
        float sum = 0.f;
#pragma unroll
        for (int e = 0; e < 4; ++e) { v[e] = gelu_t(v[e]); sum += v[e]; }
        const float mean = wave_sum(sum) * (1.0f / 256.0f); float q = 0.f;
#pragma unroll
        for (int e = 0; e < 4; ++e) { const float d = v[e] - mean; q += d * d; }
        const float rstd = rsqrtf(wave_sum(q) * (1.0f / 256.0f) + 1e-5f);
        const f32x4 lg = *(const f32x4*)(c.in[9] + l * 256 + 4 * lane), lb = *(const f32x4*)(c.in[10] + l * 256 + 4 * lane);
        const float ws0 = c.in[11][(size_t)l * 65536 + h * 16384], bs0 = c.in[12][(size_t)l * 512 + h * 128]; f32x4 vn; float o[4];
#pragma unroll
        for (int e = 0; e < 4; ++e) { vn[e] = (v[e] - mean) * rstd * lg[e] + lb[e]; o[e] = gelu_t(u[e]) * (ws0 * vn[e] + bs0); }
        *(f32x4*)(c.out + O_CHV + ((size_t)l * NSAMP + i) * 256 + 4 * lane) = vn;
        u32x2 p; p.x = pk2(o[0], o[1]); p.y = pk2(o[2], o[3]); *(u32x2*)(zr + 768 + 4 * lane) = p; }
}


constexpr int CH_W = 0, CH_R = 4096, CH_ARB = 8192, CH_BT = 10240, CH_Y = 14336, CH_P1 = 18432, CH_P2 = 22528, CH_DG = 30720;
__device__ __forceinline__ bf16x8 lds_ld16(const LAS bf16_t* p) { const u32x2 a = *(const LAS u32x2*)p, b = *(const LAS u32x2*)(p + 4); u32x4 r; r.x = a.x; r.y = a.y; r.z = b.x; r.w = b.y; return __builtin_bit_cast(bf16x8, r); }
__device__ __forceinline__ u32x2 pk4(f32x4 v) { u32x2 p; p.x = pk2(v[0], v[1]); p.y = pk2(v[2], v[3]); return p; }
__device__ __forceinline__ bf16x8 pk8(f32x4 a, f32x4 b) { const u32x2 x = pk4(a), y = pk4(b); u32x4 r; r.x = x.x; r.y = x.y; r.z = y.x; r.w = y.y; return __builtin_bit_cast(bf16x8, r); }
#define LDSW() asm volatile("s_waitcnt lgkmcnt(0)" ::: "memory")
typedef short s16x4 __attribute__((ext_vector_type(4)));
__device__ __forceinline__ bf16x8 tr_frag(const LAS bf16_t* buf, int rb0, int rb1, int c, int lane) {
    const int q = (lane & 15) >> 2, p = lane & 3;
    const s16x4 lo = __builtin_amdgcn_ds_read_tr16_b64_v4i16((LAS s16x4*)(buf + (rb0 + q) * 68 + 16 * c + 4 * p));
    const s16x4 hi = __builtin_amdgcn_ds_read_tr16_b64_v4i16((LAS s16x4*)(buf + (rb1 + q) * 68 + 16 * c + 4 * p));
    return __builtin_shufflevector(lo, hi, 0, 1, 2, 3, 4, 5, 6, 7);
}
__device__ void d1_chunk(const Ctx& c, int blk, int h) {
    const int lane = c.lane, fr = lane & 15, fq = lane >> 4;
    const int b = blk >> 6, ck = blk & 63, row0 = blk * 32;
    unsigned char* chp = c.CH() + (size_t)((b * 4 + h) * 64 + ck) * CHS;
    LAS unsigned char* lw = c.lds + c.w * 17408;
    LAS bf16_t* AT = (LAS bf16_t*)lw; LAS bf16_t* BT_ = AT + 32 * 68; LAS bf16_t* KT_ = BT_ + 32 * 68; LAS bf16_t* RT_ = KT_ + 32 * 68;
    const bf16_t* tok = c.TOK() + (size_t)row0 * 1536 + h * 64 + lane;
    float z0_ = 0.f; asm volatile("" : "+v"(z0_)); const f32x4 zero = {z0_, z0_, z0_, z0_};
    float GT;
    LDSW();
    { float G = 0.f;
#pragma unroll 1
      for (int t0 = 0; t0 < 32; t0 += 16) { unsigned raw[16][5];
#pragma unroll
          for (int u = 0; u < 16; ++u) { const bf16_t* q = tok + (size_t)(t0 + u) * 1536; raw[u][0] = q[0]; raw[u][1] = q[256]; raw[u][2] = q[768]; raw[u][3] = q[1024]; raw[u][4] = q[1280]; }
#pragma unroll
          for (int u = 0; u < 16; ++u) { const int t = t0 + u; const float ld = __uint_as_float(raw[u][4] << 16); const float Gm = G; G += ld;
              const float r = __uint_as_float(raw[u][0] << 16), km = __uint_as_float(raw[u][1] << 16), a = -__uint_as_float(raw[u][2] << 16), bv = __uint_as_float(raw[u][3] << 16); const float eG = __expf(G), ie = __expf(-G), eGm = __expf(Gm);
              AT[t * 68 + lane] = f2bf(a * eGm); BT_[t * 68 + lane] = f2bf(bv * ie); KT_[t * 68 + lane] = f2bf(km * ie); RT_[t * 68 + lane] = f2bf(r * eG); }
          asm volatile("" ::: "memory"); }
      GT = G; }
    LDSW();
    f32x4 acc[2][2][2][2];
#pragma unroll
    for (int i = 0; i < 16; ++i) acc[i >> 3][(i >> 2) & 1][(i >> 1) & 1][i & 1] = zero;
#pragma unroll
    for (int ks = 0; ks < 2; ++ks) { bf16x8 af[2][2], bf[2][2];
#pragma unroll
        for (int m = 0; m < 2; ++m) { const int o = (m * 16 + fr) * 68 + ks * 32 + fq * 8; af[0][m] = lds_ld16(BT_ + o); af[1][m] = lds_ld16(KT_ + o); bf[0][m] = lds_ld16(AT + o); bf[1][m] = lds_ld16(RT_ + o); }
#pragma unroll
        for (int i = 0; i < 16; ++i) { const int as = i >> 3, bs = (i >> 2) & 1, mt = (i >> 1) & 1, nt = i & 1; acc[as][bs][mt][nt] = mfma16(af[as][mt], bf[bs][nt], acc[as][bs][mt][nt]); } }
#pragma unroll
    for (int nt = 0; nt < 2; ++nt)
#pragma unroll
        for (int ks = 0; ks < 2; ++ks) { const int t = 16 * nt + fr; const u32x2 lo = *(const LAS u32x2*)(RT_ + t * 68 + 32 * ks + 4 * fq), hi = *(const LAS u32x2*)(RT_ + t * 68 + 32 * ks + 16 + 4 * fq);
            u32x4 v; v.x = lo.x; v.y = lo.y; v.z = hi.x; v.w = hi.y; *(u32x4*)((bf16_t*)(chp + CH_R) + t * 64 + (((ks * 4 + fq) ^ (fr & 7)) * 8)) = v; }
    LDSW();
    bf16x8 aT[4], kT[4], bTp[4];
#pragma unroll
    for (int mt = 0; mt < 4; ++mt) { aT[mt] = tr_frag(AT, 8 * fq, 8 * fq + 4, mt, lane); kT[mt] = tr_frag(KT_, 8 * fq, 8 * fq + 4, mt, lane); bTp[mt] = tr_frag(BT_, 4 * fq, 16 + 4 * fq, mt, lane); }
    LDSW();
    LAS float* L = (LAS float*)lw; LAS bf16_t* AAK = (LAS bf16_t*)(lw + 4608); LAS bf16_t* ARK = (LAS bf16_t*)(lw + 7168); LAS bf16_t* TINV = (LAS bf16_t*)(lw + 9728);
    LAS float* DGL = (LAS float*)(lw + 12288); LAS bf16_t* VR = RT_;
    DGL[lane] = __expf(GT);
    {
#pragma unroll 1
      for (int t0 = 0; t0 < 32; t0 += 16) { unsigned rv[16];
#pragma unroll
          for (int u = 0; u < 16; ++u) rv[u] = tok[(size_t)(t0 + u) * 1536 + 512];
#pragma unroll
          for (int u = 0; u < 16; ++u) VR[(t0 + u) * 68 + lane] = (bf16_t)rv[u];
          asm volatile("" ::: "memory"); } }
#pragma unroll
    for (int nt = 0; nt < 2; ++nt) { const int t = 16 * nt + fr;
#pragma unroll
        for (int mt = 0; mt < 2; ++mt) { const int s0 = 16 * mt + 4 * fq; f32x4 v = acc[0][0][mt][nt], k = acc[1][0][mt][nt], q = acc[1][1][mt][nt];
#pragma unroll
            for (int e = 0; e < 4; ++e) { if (!(s0 + e < t)) { v[e] = z0_; k[e] = z0_; } if (!(s0 + e <= t)) q[e] = z0_; }
            *(LAS f32x4*)(L + t * 36 + s0) = v; *(LAS u32x2*)(AAK + t * 40 + s0) = pk4(k); *(LAS u32x2*)(ARK + t * 40 + s0) = pk4(q); }
        f32x4 v0 = acc[0][1][0][nt], v1 = acc[0][1][1][nt];
#pragma unroll
        for (int e = 0; e < 4; ++e) { if (!(4 * fq + e <= t)) v0[e] = z0_; if (!(16 + 4 * fq + e <= t)) v1[e] = z0_; }
        const u32x2 a = pk4(v0), bb = pk4(v1); u32x4 w; w.x = a.x; w.y = a.y; w.z = bb.x; w.w = bb.y; *(u32x4*)((bf16_t*)(chp + CH_ARB) + t * 32 + ((fq ^ ((fr >> 2) & 3)) * 8)) = w; }
    LDSW();
    bf16x8 vT[4];
#pragma unroll
    for (int nt = 0; nt < 4; ++nt) vT[nt] = tr_frag(VR, 8 * fq, 8 * fq + 4, nt, lane);
#pragma unroll
    for (int mt = 0; mt < 4; ++mt) { const f32x4 dg4 = *(const LAS f32x4*)(DGL + 16 * mt + 4 * fq);
#pragma unroll
        for (int nt = 0; nt < 4; ++nt) { const f32x4 p = mfma16(kT[mt], vT[nt], zero) * dg4; *(u32x2*)(chp + CH_P2 + ((nt * 4 + mt) * 64 + lane) * 8) = pk4(p); }
        const int chn = 16 * mt + fr; const float dgs = DGL[chn]; float z[8]; unpack8(__builtin_bit_cast(u32x4, bTp[mt]), z);
#pragma unroll
        for (int e = 0; e < 8; ++e) z[e] *= dgs;
        *(bf16x8*)((bf16_t*)(chp + CH_BT) + chn * 32 + ((fq ^ ((fr >> 2) & 3)) * 8)) = pack8(z); }
#pragma unroll
    for (int nt = 0; nt < 4; ++nt)
#pragma unroll
        for (int mt = 0; mt < 2; ++mt) { const f32x4 p = mfma16(*(const LAS bf16x8*)(ARK + (mt * 16 + fr) * 40 + fq * 8), vT[nt], zero); *(u32x2*)(chp + CH_P1 + ((nt * 2 + mt) * 64 + lane) * 8) = pk4(p); }
    LDSW();
    { float x[32]; const int j = lane & 31;
#pragma unroll
      for (int t = 0; t < 32; ++t) x[t] = 0.f;
#pragma unroll
      for (int t = 0; t < 32; ++t) { int jj = j; asm volatile("" : "+v"(jj)); float a = (t == jj) ? 1.f : 0.f;
#pragma unroll
          for (int s4 = 0; s4 < (t + 3) / 4; ++s4) { const f32x4 Lr = *(const LAS f32x4*)(L + t * 36 + 4 * s4); a += Lr[0] * x[4 * s4] + Lr[1] * x[4 * s4 + 1] + Lr[2] * x[4 * s4 + 2] + Lr[3] * x[4 * s4 + 3]; }
          asm volatile("" : "+v"(a) :: "memory"); x[t] = a; }
#pragma unroll
      for (int t = 0; t < 32; ++t) TINV[t * 40 + j] = f2bf(x[t]); }
    { f32x4 w[4][2];
#pragma unroll
      for (int mt = 0; mt < 4; ++mt)
#pragma unroll
          for (int nt = 0; nt < 2; ++nt) w[mt][nt] = mfma16(aT[mt], *(const LAS bf16x8*)(TINV + (nt * 16 + fr) * 40 + fq * 8), zero);
#pragma unroll
      for (int nt = 0; nt < 2; ++nt)
#pragma unroll
          for (int ks = 0; ks < 2; ++ks) { const u32x2 a = pk4(w[2 * ks][nt]), bb = pk4(w[2 * ks + 1][nt]); u32x4 v; v.x = a.x; v.y = a.y; v.z = bb.x; v.w = bb.y;
              *(u32x4*)((bf16_t*)(chp + CH_W) + (16 * nt + fr) * 64 + (((ks * 4 + fq) ^ (fr & 7)) * 8)) = v; } }
    { bf16x8 tp[2];
#pragma unroll
      for (int mt = 0; mt < 2; ++mt) { const u32x2 lo = *(const LAS u32x2*)(TINV + (mt * 16 + fr) * 40 + 4 * fq), hi = *(const LAS u32x2*)(TINV + (mt * 16 + fr) * 40 + 16 + 4 * fq); u32x4 v; v.x = lo.x; v.y = lo.y; v.z = hi.x; v.w = hi.y; tp[mt] = __builtin_bit_cast(bf16x8, v); }
#pragma unroll
      for (int nt = 0; nt < 4; ++nt) { f32x4 x[2];
#pragma unroll
          for (int mt = 0; mt < 2; ++mt) x[mt] = mfma16(*(const LAS bf16x8*)(AAK + (mt * 16 + fr) * 40 + fq * 8), vT[nt], zero);
          const bf16x8 xb = pk8(x[0], x[1]);
#pragma unroll
          for (int mt = 0; mt < 2; ++mt) { const f32x4 y = mfma16(tp[mt], xb, zero); *(u32x2*)(chp + CH_Y + ((nt * 2 + mt) * 64 + lane) * 8) = pk4(y);
 } } }
    ((bf16_t*)(chp + CH_DG))[lane] = f2bf(__expf(GT));
    LDSW();
}

__device__ void rwkv_d1(const Ctx& c) {
    asm volatile("s_waitcnt vmcnt(0)" ::: "memory");
    for (int task = c.gw; task < (NPROMPT / 32) * 4; task += c.nw) d1_chunk(c, task >> 2, task & 3);
}

struct D2F { bf16x8 w[2][2], rr[2][2], arb[2], bt[4]; u32x2 y[2], p1[2], p2[4], dg[4]; };
constexpr int D2_SLOT = 19456, D2_NSLOT = 7;
__device__ __forceinline__ void d2_dma(LAS unsigned char* slot, const unsigned char* chp, int slab, int lane) {
    const unsigned char* g = chp + lane * 16;
#pragma unroll
    for (int i = 0; i < 14; ++i) __builtin_amdgcn_global_load_lds((const unsigned*)(g + i * 1024), (LAS unsigned*)(slot + i * 1024), 16, 0, 0);
    __builtin_amdgcn_global_load_lds((const unsigned*)(g + CH_Y + slab * 1024), (LAS unsigned*)(slot + 14336), 16, 0, 0);
    __builtin_amdgcn_global_load_lds((const unsigned*)(g + CH_P1 + slab * 1024), (LAS unsigned*)(slot + 15360), 16, 0, 0);
    __builtin_amdgcn_global_load_lds((const unsigned*)(g + CH_P2 + slab * 2048), (LAS unsigned*)(slot + 16384), 16, 0, 0);
    __builtin_amdgcn_global_load_lds((const unsigned*)(g + CH_P2 + slab * 2048 + 1024), (LAS unsigned*)(slot + 17408), 16, 0, 0);
    __builtin_amdgcn_global_load_lds((const unsigned*)(g + CH_DG), (LAS unsigned*)(slot + 18432), 16, 0, 0);
}
__device__ __forceinline__ void d2_load(D2F& f, const LAS unsigned char* slot, int fr, int fq, int lane) {
    const int x8 = fr & 7, x4 = (fr >> 2) & 3;
#pragma unroll
    for (int mt = 0; mt < 2; ++mt) {
#pragma unroll
        for (int ks = 0; ks < 2; ++ks) { const int o = (16 * mt + fr) * 128 + (((ks * 4 + fq) ^ x8) * 16); f.w[mt][ks] = *(const LAS bf16x8*)(slot + CH_W + o); f.rr[mt][ks] = *(const LAS bf16x8*)(slot + CH_R + o); }
        f.arb[mt] = *(const LAS bf16x8*)(slot + CH_ARB + (16 * mt + fr) * 64 + ((fq ^ x4) * 16));
        f.y[mt] = *(const LAS u32x2*)(slot + 14336 + mt * 512 + lane * 8); f.p1[mt] = *(const LAS u32x2*)(slot + 15360 + mt * 512 + lane * 8); }
#pragma unroll
    for (int mt = 0; mt < 4; ++mt) { f.bt[mt] = *(const LAS bf16x8*)(slot + CH_BT + (16 * mt + fr) * 64 + ((fq ^ x4) * 16));
        f.p2[mt] = *(const LAS u32x2*)(slot + 16384 + mt * 512 + lane * 8); f.dg[mt] = *(const LAS u32x2*)(slot + 18432 + mt * 32 + fq * 8); }
}
__device__ __forceinline__ f32x4 up4(u32x2 u) { return (f32x4){bflo(u.x), bfhi(u.x), bflo(u.y), bfhi(u.y)}; }
__device__ __forceinline__ void d2_step(const D2F& f, f32x4 (&H)[4], float* op, int fq) {
    const bf16x8 hb0 = pk8(H[0], H[1]), hb1 = pk8(H[2], H[3]);
    f32x4 U[2], O[2];
#pragma unroll
    for (int mt = 0; mt < 2; ++mt) { U[mt] = up4(f.y[mt]); U[mt] = mfma16(f.w[mt][0], hb0, U[mt]); U[mt] = mfma16(f.w[mt][1], hb1, U[mt]);
        O[mt] = up4(f.p1[mt]); O[mt] = mfma16(f.rr[mt][0], hb0, O[mt]); O[mt] = mfma16(f.rr[mt][1], hb1, O[mt]); }
    const bf16x8 ub = pk8(U[0], U[1]);
#pragma unroll
    for (int mt = 0; mt < 2; ++mt) { O[mt] = mfma16(f.arb[mt], ub, O[mt]);
#pragma unroll
        for (int r = 0; r < 4; ++r) op[(size_t)(16 * mt + 4 * fq + r) * 256] = O[mt][r]; }
#pragma unroll
    for (int mt = 0; mt < 4; ++mt) { u32x2 p2 = f.p2[mt], dg = f.dg[mt]; asm volatile("" : "+v"(p2.x), "+v"(p2.y), "+v"(dg.x), "+v"(dg.y)); const f32x4 hn = up4(p2) + up4(dg) * H[mt]; H[mt] = mfma16(f.bt[mt], ub, hn); }
}
__device__ void rwkv_d2(const Ctx& c, int l) {
    const int lane = c.lane, fr = lane & 15, fq = lane >> 4, G = gridDim.x;
    if (c.w != 0) return;
    for (int task = blockIdx.x; task < NB * 4 * 4; task += G) {
        const int slab = task & 3, h = (task >> 2) & 3, b = task >> 4;
        const unsigned char* chb = c.CH() + (size_t)((b * 4 + h) * 64) * CHS;
        f32x4 H[4];
#pragma unroll
        for (int mt = 0; mt < 4; ++mt) H[mt] = zero4();
        float* op = c.OO() + (size_t)(b * SEQ) * 256 + h * 64 + slab * 16 + fr;
        asm volatile("s_waitcnt vmcnt(0) lgkmcnt(0)" ::: "memory");
        d2_dma(c.lds, chb, slab, lane); d2_dma(c.lds + D2_SLOT, chb + CHS, slab, lane);
        for (int ck = 0; ck < 64; ++ck) {
            if (ck + 2 < 64) d2_dma(c.lds + ((ck + 2) % D2_NSLOT) * D2_SLOT, chb + (size_t)(ck + 2) * CHS, slab, lane);
            if (ck == 0) asm volatile("s_waitcnt vmcnt(38)" ::: "memory");
            else if (ck == 1) asm volatile("s_waitcnt vmcnt(46)" ::: "memory");
            else if (ck < 62) asm volatile("s_waitcnt vmcnt(54)" ::: "memory");
            else asm volatile("s_waitcnt vmcnt(0)" ::: "memory");
            D2F f; d2_load(f, c.lds + (ck % D2_NSLOT) * D2_SLOT, fr, fq, lane);
            d2_step(f, H, op + (size_t)(ck * 32) * 256, fq);
        }
        float* so = c.out + O_WKVP + (((size_t)(l * NB + b) * 4 + h) * 64 + slab * 16 + fr) * 64;
#pragma unroll
        for (int mt = 0; mt < 4; ++mt) *(f32x4*)(so + 16 * mt + 4 * fq) = H[mt];
    }
}

__device__ void rwkv_scan(const Ctx& c, int l, int first, int stride) {
    const int lane = c.lane;
    for (int task = first; task < NSAMP * 16; task += stride) {
        const int i = task >> 4, h = (task >> 2) & 3, q4 = task & 3, row = NPROMPT + i;
        const bf16_t* tk = c.TOK() + (size_t)row * 1536 + h * 64;
        const float r = bf2f(tk[lane]), km = bf2f(tk[256 + lane]), kk = bf2f(tk[768 + lane]), bv = bf2f(tk[1024 + lane]), d = __expf(bf2f(tk[1280 + lane]));
        const size_t sb = (((size_t)(l * NSAMP + i) * 4 + h) * 64) * 64;
        float S0[16]; unsigned vraw[16];
#pragma unroll
        for (int j = 0; j < 16; ++j) { const int vr = q4 * 16 + j; S0[j] = c.in[2][sb + (size_t)vr * 64 + lane]; vraw[j] = tk[512 + vr]; }
#pragma unroll
        for (int j = 0; j < 16; ++j) { const int vr = q4 * 16 + j; float S = S0[j]; const float vv = __uint_as_float(vraw[j] << 16);
            const float sa = -wave_sum(S * kk); S = S * d + sa * bv + vv * km; const float o = wave_sum(S * r);
            __builtin_nontemporal_store(S, c.out + O_WKVS + sb + (size_t)vr * 64 + lane); if (lane == 0) c.OO()[(size_t)row * 256 + h * 64 + vr] = o; }
    }
}

__device__ void rwkv_final(const Ctx& c, int l) {
    const int lane = c.lane, h = lane >> 4;
    const f32x4 lg = *(const f32x4*)(c.in[34] + l * 256 + 4 * lane), lb = *(const f32x4*)(c.in[35] + l * 256 + 4 * lane);
    for (int row0 = c.gw; row0 < NR; row0 += 9 * c.nw) {
        f32x4 o[9]; u32x2 vv[9], gq[9]; float bon[9];
#pragma unroll
        for (int u = 0; u < 9; ++u) { const int row = (row0 + u * c.nw < NR) ? row0 + u * c.nw : row0; o[u] = *(const f32x4*)(c.OO() + (size_t)row * 256 + 4 * lane);
            vv[u] = *(const u32x2*)(c.TOK() + (size_t)row * 1536 + 512 + 4 * lane); gq[u] = *(const u32x2*)(c.GG() + (size_t)row * 256 + 4 * lane); bon[u] = c.BON()[(size_t)row * 4 + h]; }
#pragma unroll
        for (int u = 0; u < 9; ++u) { const int row = row0 + u * c.nw; if (row < NR) {
            const float m = row16_sum((o[u][0] + o[u][1]) + (o[u][2] + o[u][3])) * (1.0f / 64.0f);
            const f32x4 d = o[u] - m; const float var = row16_sum((d[0] * d[0] + d[1] * d[1]) + (d[2] * d[2] + d[3] * d[3])) * (1.0f / 64.0f);
            const float rstd = rsqrtf(var + 64e-5f);
            float v[4], g[4]; unpack4(vv[u], v); unpack4(gq[u], g);
            float y[4];
#pragma unroll
            for (int e = 0; e < 4; ++e) y[e] = (d[e] * rstd * lg[e] + lb[e] + bon[u] * v[e]) * g[e];
            u32x2 p; p.x = pk2(y[0], y[1]); p.y = pk2(y[2], y[3]); *(u32x2*)(c.Z() + (size_t)row * ZLD + 256 + 4 * lane) = p; } }
    }
}

#define XB_XCNT(j)  (256  + 64 * (j))
#define XB_XSUB(j)  (1280 + 64 * (j))
#define XB_XGEN(j)  (2304 + 64 * (j))
#define XB_TOP      3328
#define XB_TOPGEN   3392
__device__ __forceinline__ unsigned xb_ld(unsigned* p) { return __hip_atomic_load(p, __ATOMIC_RELAXED, __HIP_MEMORY_SCOPE_AGENT); }
__device__ __forceinline__ unsigned xb_add(unsigned* p, unsigned v) { return __hip_atomic_fetch_add(p, v, __ATOMIC_RELAXED, __HIP_MEMORY_SCOPE_AGENT); }
#define XB_SPIN(cond) do { unsigned _sp = 0; while (cond) { __builtin_amdgcn_s_sleep(1); if (++_sp > (1u << 24)) break; } } while (0)
__device__ __forceinline__ void gbar(unsigned* bar, unsigned x, unsigned nloc, unsigned nx, unsigned gen) {
    asm volatile("s_waitcnt vmcnt(0) lgkmcnt(0)" ::: "memory");
    __syncthreads();
    if (threadIdx.x == 0) {
        const unsigned old = xb_add(&bar[XB_XSUB(x)], 1u);
        if (old + 1u == (gen + 1u) * nloc) {
            __builtin_amdgcn_fence(__ATOMIC_RELEASE, "agent");
            asm volatile("s_waitcnt vmcnt(0)" ::: "memory");
            const unsigned og = xb_add(&bar[XB_TOP], 1u);
            const unsigned tg = gen;
            if (og + 1u == (tg + 1u) * nx) xb_add(&bar[XB_TOPGEN], 1u);
            else XB_SPIN(xb_ld(&bar[XB_TOPGEN]) == tg);
            __builtin_amdgcn_fence(__ATOMIC_ACQUIRE, "agent");
            xb_add(&bar[XB_XGEN(x)], 1u);
            asm volatile("s_waitcnt vmcnt(0)" ::: "memory");
        } else {
            XB_SPIN(xb_ld(&bar[XB_XGEN(x)]) == gen);
            __builtin_amdgcn_fence(__ATOMIC_ACQUIRE, "agent");
            asm volatile("s_waitcnt vmcnt(0)" ::: "memory");
        }
    }
    __syncthreads();
}

__global__ void __launch_bounds__(512) hybrid_fwd(Params P) {
    extern __shared__ __attribute__((aligned(16))) unsigned char lds_raw[];
    cg::grid_group grid = cg::this_grid();
    Ctx c;
    c.in = P.in; c.out = P.out; c.ws = P.ws;
    c.lds = (LAS unsigned char*)lds_raw; c.tid = threadIdx.x; c.lane = threadIdx.x & 63; c.w = __builtin_amdgcn_readfirstlane(threadIdx.x >> 6);
    c.gw = blockIdx.x * 8 + c.w; c.nw = gridDim.x * 8;
    const int G = gridDim.x;
    const int wave_id = __builtin_amdgcn_readfirstlane(threadIdx.x >> 6);
#define REFRESH() do { int w_ = wave_id; asm volatile("" : "+s"(w_)); int ln_; asm volatile("v_mbcnt_lo_u32_b32 %0, -1, 0\n\tv_mbcnt_hi_u32_b32 %0, -1, %0" : "=v"(ln_)); int t_ = w_ * 64 + ln_; { unsigned char* w2_ = P.ws; asm volatile("" : "+s"(w2_)); c.ws = w2_; } c.tid = t_; c.lane = t_ & 63; c.w = w_; c.gw = blockIdx.x * 8 + c.w; } while (0)

    unsigned* bar = (unsigned*)(P.ws + W_BAR);
    const unsigned xcc = (unsigned)__builtin_amdgcn_s_getreg((3 << 11) | 20) & 0xFu;
    if (threadIdx.x == 0) xb_add(&bar[XB_XCNT(xcc)], 1u);
    phase0(c);
    grid.sync();
    unsigned nloc = 0, nx = 0;
#pragma unroll
    for (unsigned j = 0; j < 16; ++j) { const unsigned cnt = xb_ld(&bar[XB_XCNT(j)]); nx += cnt > 0u ? 1u : 0u; nloc = (j == xcc) ? cnt : nloc; }
    nloc = __builtin_amdgcn_readfirstlane(nloc); nx = __builtin_amdgcn_readfirstlane(nx);
    if (nloc == 0u) nloc = 1u; if (nx == 0u) nx = 1u;
    unsigned bar_gen = 0;
#define GBAR() do { gbar(bar, xcc, nloc, nx, bar_gen); ++bar_gen; } while (0)
    for (int l = 0; l < NL; ++l) {
        const int buf = l & 1;
        unsigned char* wb = c.WB() + (size_t)buf * WB_SIZE;
        const bf16_t* WinT = (const bf16_t*)(wb + WB_WIN); const bf16_t* WoutT = (const bf16_t*)(wb + WB_WOUT); const bf16_t* WguT = (const bf16_t*)(wb + WB_WGU); const bf16_t* WdnT = (const bf16_t*)(wb + WB_WDN);
        REFRESH();
        { pg8::Gemm g{c.XB(), WinT, NPROMPT, ZLD, 1024, 1024}; pg8::StaticOrder S; S.init(NPROMPT, ZLD, G, blockIdx.x); EpiZ E{c.Z(), c.SSQ() + (size_t)(2 * l) * NR};
          pg8::gemm_phase<EpiZ>(c.lds, g, S, E, c.tid);
          REFRESH(); ThinZ T{c.Z(), c.SSQ() + (size_t)(2 * l) * NR};
          const bool split = (G == 256);
          if (!split) thin_gemm(c.XB() + (size_t)NPROMPT * DM, DM, WinT, 1024, INC / 32, T, c.w, c.lane);
          else if (blockIdx.x >= 128) thin_gemm(c.XB() + (size_t)NPROMPT * DM, DM, WinT, 1024, INC / 32, T, c.w, c.lane, (int)blockIdx.x - 128, 128);
          if (l + 1 < NL) { REFRESH(); if (!split) convert_weights(c, l + 1, buf ^ 1, 0); else if (blockIdx.x >= 128) convert_weights(c, l + 1, buf ^ 1, 0, (int)blockIdx.x - 128, 128); } }
        GBAR();
        REFRESH();
        conv_phase(c, l);
        REFRESH();
        for (int tile = blockIdx.x; tile < 256; tile += G) ssm_tile<false>(c, l, tile);
        REFRESH();
        rwkv_tok(c, l, buf);
        REFRESH();
        __syncthreads();
        rwkv_d1(c);
        if (G != 256) { REFRESH(); shift_out(c, l, (int)blockIdx.x * 512 + c.tid, G * 512); }
        GBAR();
        REFRESH();
        for (int tile = blockIdx.x; tile < 256; tile += G) { ssm_tile<true>(c, l, tile); __syncthreads(); ssm_glu(c, l, buf, tile); __syncthreads(); }
        { const int sb = (G >= 160) ? 128 : 0;
          for (int q = (int)blockIdx.x - sb; q >= 0 && q < 4; q += G) { const int tile = 256 + (q >> 1), hf = q & 1; ssm_tile<true>(c, l, tile, hf, hf + 1); __syncthreads(); ssm_glu(c, l, buf, tile, 2 * hf, 2 * hf + 2); __syncthreads(); } }
        if (G == 256) {
            if (blockIdx.x >= 128) { REFRESH(); gmlp_tile<true>(c, l, buf, (int)blockIdx.x - 128); }
            else { REFRESH();
                if (c.w == 0) rwkv_d2(c, l);
                else { if (c.w == 1) gmlp_sample(c, l, (int)blockIdx.x, 128); rwkv_scan(c, l, (int)blockIdx.x * 7 + c.w - 1, 128 * 7); shift_out(c, l, (int)blockIdx.x * 448 + c.tid - 64, 128 * 448); } }
        } else {
            REFRESH();
            for (int tile = blockIdx.x; tile < 256; tile += G) gmlp_tile<false>(c, l, buf, tile);
            REFRESH();
            gmlp_sample(c, l, c.gw, c.nw);
            REFRESH();
            rwkv_scan(c, l, c.gw, c.nw);
            REFRESH();
            rwkv_d2(c, l);
        }
        GBAR();
        REFRESH();
        rwkv_final(c, l);
        GBAR();
        REFRESH();
        { pg8::Gemm g{c.Z() + MIXOFF, WoutT, NPROMPT, 1024, 1024, ZLD}; pg8::StaticOrder S; S.init(NPROMPT, 1024, G, blockIdx.x); EpiRes E{c.XB(), c.SSQ() + (size_t)(2 * l + 1) * NR};
          pg8::gemm_phase<EpiRes>(c.lds, g, S, E, c.tid);
          REFRESH(); ThinRes T{c.XB(), c.SSQ() + (size_t)(2 * l + 1) * NR}; thin_gemm_sk<4>(c.lds, c.Z() + MIXOFF + (size_t)NPROMPT * ZLD, ZLD, WoutT, 1024, 32, T, c.w, c.lane); }
        GBAR();
        REFRESH();
        { pg8::Gemm g{c.XB(), WguT, NPROMPT, 5632, 1024, 1024}; pg8::StaticOrder S; S.init(NPROMPT, 5632, G, blockIdx.x); EpiAct E{c.ACT(), c.SSQ() + (size_t)(2 * l + 1) * NR};
          pg8::gemm_phase<EpiAct>(c.lds, g, S, E, c.tid);
          REFRESH(); ThinAct T{c.ACT(), c.SSQ() + (size_t)(2 * l + 1) * NR}; if (G != 256) thin_gemm(c.XB() + (size_t)NPROMPT * DM, DM, WguT, 1024, DFF / 16, T, c.w, c.lane); else if (blockIdx.x >= 128) thin_gemm(c.XB() + (size_t)NPROMPT * DM, DM, WguT, 1024, DFF / 16, T, c.w, c.lane, (int)blockIdx.x - 128, 128);
          if (l + 1 < NL) { REFRESH(); if (G != 256) convert_weights(c, l + 1, buf ^ 1, 1); else if (blockIdx.x >= 128) convert_weights(c, l + 1, buf ^ 1, 1, (int)blockIdx.x - 128, 128); } }
        GBAR();
        REFRESH();
        { pg8::Gemm g{c.ACT(), WdnT, NPROMPT, 1024, DFF, DFF}; pg8::StaticOrder S; S.init(NPROMPT, 1024, G, blockIdx.x); EpiRes E{c.XB(), c.SSQ() + (size_t)(2 * l + 2) * NR};
          pg8::gemm_phase<EpiRes>(c.lds, g, S, E, c.tid);
          REFRESH(); ThinRes T{c.XB(), c.SSQ() + (size_t)(2 * l + 2) * NR}; thin_gemm_sk<11>(c.lds, c.ACT() + (size_t)NPROMPT * DFF, DFF, WdnT, DFF, 32, T, c.w, c.lane); }
        GBAR();
    }
    REFRESH();
    { f32x4 gn[4];
#pragma unroll
      for (int j = 0; j < 4; ++j) gn[j] = *(const f32x4*)(c.in[40] + j * 256 + c.lane * 4);
      for (int row0 = c.gw; row0 < NR; row0 += 5 * c.nw) { u32x2 xv[5][4]; unsigned long long sq[5];
#pragma unroll
          for (int u = 0; u < 5; ++u) { const int row = (row0 + u * c.nw < NR) ? row0 + u * c.nw : row0; sq[u] = c.SSQ()[(size_t)8 * NR + row];
#pragma unroll
              for (int j = 0; j < 4; ++j) xv[u][j] = *(const u32x2*)(c.XB() + (size_t)row * DM + j * 256 + c.lane * 4); }
#pragma unroll
          for (int u = 0; u < 5; ++u) { const int row = row0 + u * c.nw; if (row < NR) { const float rs = rsqrtf((float)sq[u] * (1.0f / (SSQ_SCALE * 1024.0f)) + 1e-6f);
#pragma unroll
              for (int j = 0; j < 4; ++j) { float v[4]; unpack4(xv[u][j], v); __builtin_nontemporal_store((f32x4){v[0] * rs * gn[j][0], v[1] * rs * gn[j][1], v[2] * rs * gn[j][2], v[3] * rs * gn[j][3]}, (f32x4*)(c.out + (size_t)row * DM + j * 256 + c.lane * 4)); } } } } }
}

extern "C" void kernel_launch(void* const* d_in, const int* in_sizes, int n_in, void* d_out, int out_size, void* d_ws, size_t ws_size, hipStream_t stream) {
    static int grid_blocks = 0;
    if (!grid_blocks) {
        int dev = 0, cus = 0, per_cu = 0;
        hipGetDevice(&dev);
        hipDeviceGetAttribute(&cus, hipDeviceAttributeMultiprocessorCount, dev);
        hipFuncSetAttribute((const void*)hybrid_fwd, hipFuncAttributeMaxDynamicSharedMemorySize, LDS_BYTES);
        hipOccupancyMaxActiveBlocksPerMultiprocessor(&per_cu, (const void*)hybrid_fwd, 512, LDS_BYTES);
        if (per_cu < 1) per_cu = 1;
        grid_blocks = cus * per_cu;
        if (n_in != 41 || (size_t)out_size != O_END || ws_size < W_END) fprintf(stderr, "kernel_launch: unexpected sizes n_in %d out %d ws %zu\n", n_in, out_size, ws_size);
    }
    hipMemsetAsync((char*)d_ws + W_BAR, 0, 16384, stream);
    Params p{};
    for (int i = 0; i < 41; ++i) p.in[i] = (const float*)d_in[i];
    p.out = (float*)d_out; p.ws = (unsigned char*)d_ws;
    void* args[] = {&p};
    hipError_t e = hipLaunchCooperativeKernel((const void*)hybrid_fwd, dim3(grid_blocks), dim3(512), args, LDS_BYTES, stream);
    if (e != hipSuccess) fprintf(stderr, "cooperative launch failed: %s (grid %d)\n", hipGetErrorString(e), grid_blocks);
}
```

```cpp
#include <hip/hip_runtime.h>
#include <hip/hip_cooperative_groups.h>
#include <cstdio>
namespace cg = cooperative_groups;

#define LAS __attribute__((address_space(3)))
typedef unsigned short bf16_t;
typedef short bf16x8 __attribute__((ext_vector_type(8)));
typedef float f32x4 __attribute__((ext_vector_type(4)));
typedef float f32x2 __attribute__((ext_vector_type(2)));
typedef unsigned u32x4 __attribute__((ext_vector_type(4)));
typedef unsigned u32x2 __attribute__((ext_vector_type(2)));

constexpr int DM = 1024, NPROMPT = 16384, NSAMP = 128, NR = NPROMPT + NSAMP, SEQ = 2048, NB = 8, NL = 4;
constexpr int ZLD = 2560, INC = 2432, DFF = 2816, DTM = 896;
constexpr int MIXOFF = 256;
constexpr size_t O_Y = 0;
constexpr size_t O_WKVP = (size_t)NR * DM;
constexpr size_t O_WKVS = O_WKVP + (size_t)NL * NB * 4 * 64 * 64;
constexpr size_t O_SHP = O_WKVS + (size_t)NL * NSAMP * 4 * 64 * 64;
constexpr size_t O_SHS = O_SHP + (size_t)NL * NB * DTM;
constexpr size_t O_REP = O_SHS + (size_t)NL * NSAMP * DTM;
constexpr size_t O_RES = O_REP + (size_t)NL * NB * 1024;
constexpr size_t O_IMP = O_RES + (size_t)NL * NSAMP * 1024;
constexpr size_t O_IMS = O_IMP + (size_t)NL * NB * 1024;
constexpr size_t O_CVP = O_IMS + (size_t)NL * NSAMP * 1024;
constexpr size_t O_CVS = O_CVP + (size_t)NL * NB * 512;
constexpr size_t O_CHV = O_CVS + (size_t)NL * NSAMP * 512;
constexpr size_t O_END = O_CHV + (size_t)NL * NSAMP * 256;
static_assert(O_END == 27832320, "output size");
constexpr size_t W_XB = 0;
constexpr int CHS = 31232;
constexpr size_t W_ZA = W_XB + (size_t)NR * DM * 2;
constexpr size_t W_WB = W_ZA + (size_t)NR * DFF * 2;
constexpr size_t WB_WIN = 0, WB_WOUT = WB_WIN + (size_t)ZLD * 1024 * 2, WB_WGU = WB_WOUT + (size_t)1024 * 1024 * 2, WB_WDN = WB_WGU + (size_t)5632 * 1024 * 2,
                 WB_GLU = WB_WDN + (size_t)1024 * DFF * 2, WB_LORA = WB_GLU + 256 * 256 * 2, WB_WSB = WB_LORA + 256 * 128 * 2, WB_SIZE = WB_WSB + 4 * 128 * 128 * 2;
constexpr size_t W_TOK = W_WB + 2 * WB_SIZE;
constexpr size_t W_GG = W_TOK + (size_t)NR * 1536 * 2;
constexpr size_t W_OO = W_GG + (size_t)NR * 256 * 2;
constexpr size_t W_BON = W_OO + (size_t)NR * 256 * 4;
constexpr size_t W_SSQ = W_BON + (size_t)NR * 4 * 4;
constexpr size_t W_EE = W_SSQ + (size_t)9 * NR * 8;
constexpr size_t W_LBC = W_EE + (size_t)NB * 32 * 16 * 64 * 2 * 4;
constexpr size_t W_BBAR = W_LBC + (size_t)NL * 1024 * 8;
constexpr size_t W_BAR = W_BBAR + (size_t)NL * 16 * 128 * 16 * 2;
constexpr size_t W_END = W_BAR + 16384;
static_assert(W_END <= 268435456, "workspace");
static_assert((size_t)NB * 4 * 64 * CHS <= (size_t)NR * DM * 4, "chunk data lives in the y region of d_out until the final norm overwrites it");
static_assert(W_ZA % 256 == 0 && W_WB % 256 == 0 && W_TOK % 256 == 0 && W_GG % 256 == 0 && W_OO % 256 == 0 && W_BON % 256 == 0 && W_SSQ % 256 == 0 && W_EE % 256 == 0 && WB_SIZE % 256 == 0, "align");
constexpr int LDS_BYTES = 139264;

struct Params { const float* in[41]; float* out; unsigned char* ws; };

struct Ctx {
    const float* const* in; float* out; unsigned char* ws;
    LAS unsigned char* lds; int tid, lane, w, gw, nw;
    __device__ __forceinline__ float* X() const { return out; }
    __device__ __forceinline__ bf16_t* XB() const { return (bf16_t*)(ws + W_XB); }
    __device__ __forceinline__ bf16_t* Z() const { return (bf16_t*)(ws + W_ZA); }
    __device__ __forceinline__ bf16_t* ACT() const { return (bf16_t*)(ws + W_ZA); }
    __device__ __forceinline__ unsigned char* WB() const { return ws + W_WB; }
    __device__ __forceinline__ bf16_t* TOK() const { return (bf16_t*)(ws + W_TOK); }
    __device__ __forceinline__ bf16_t* GG() const { return (bf16_t*)(ws + W_GG); }
    __device__ __forceinline__ float* OO() const { return (float*)(ws + W_OO); }
    __device__ __forceinline__ float* BON() const { return (float*)(ws + W_BON); }
    __device__ __forceinline__ unsigned long long* SSQ() const { return (unsigned long long*)(ws + W_SSQ); }
    __device__ __forceinline__ float* EE() const { return (float*)(ws + W_EE); }
    __device__ __forceinline__ unsigned char* CH() const { return (unsigned char*)out; }
    __device__ __forceinline__ float* LBC() const { return (float*)(ws + W_LBC); }
    __device__ __forceinline__ bf16_t* BBAR() const { return (bf16_t*)(ws + W_BBAR); }
};

__device__ __forceinline__ float bf2f(bf16_t b) { return __uint_as_float(((unsigned)b) << 16); }
__device__ __forceinline__ float bflo(unsigned u) { return __uint_as_float(u << 16); }
__device__ __forceinline__ float bfhi(unsigned u) { return __uint_as_float(u & 0xffff0000u); }
typedef __bf16 bf16v2 __attribute__((ext_vector_type(2)));
__device__ __forceinline__ unsigned pk2(float lo, float hi) { const f32x2 v = {lo, hi}; const bf16v2 b = __builtin_convertvector(v, bf16v2); return __builtin_bit_cast(unsigned, b); }
__device__ __forceinline__ bf16_t f2bf(float f) { return (bf16_t)(pk2(f, 0.f) & 0xffffu); }
constexpr float SSQ_SCALE = 16777216.0f;
__device__ __forceinline__ float ssq_rs(const unsigned long long* p, int row) { return rsqrtf((float)p[row] * (1.0f / (SSQ_SCALE * 1024.0f)) + 1e-6f); }
__device__ __forceinline__ void ssq_add(unsigned long long* p, int row, float s) { atomicAdd(p + row, (unsigned long long)(s * SSQ_SCALE + 0.5f)); }
__device__ __forceinline__ float sigmoidf_(float x) { return 1.0f / (1.0f + __expf(-x)); }
__device__ __forceinline__ float gelu_t(float x) { const float y = 0.7978845608028654f * (x + 0.044715f * x * x * x); return x * sigmoidf_(2.0f * y); }
__device__ __forceinline__ float tanh_(float x) { return 1.0f - 2.0f / (__expf(2.0f * x) + 1.0f); }
template <int CTRL> __device__ __forceinline__ float dpp_mov(float v) { return __builtin_bit_cast(float, __builtin_amdgcn_update_dpp(0, __builtin_bit_cast(int, v), CTRL, 0xf, 0xf, true)); }
__device__ __forceinline__ float row16_sum(float v) { v += dpp_mov<0xB1>(v); v += dpp_mov<0x4E>(v); v += dpp_mov<0x141>(v); v += dpp_mov<0x140>(v); return v; }
__device__ __forceinline__ float wave_sum(float v) {
    v = row16_sum(v); const int b = __builtin_bit_cast(int, v);
    const float a0 = __builtin_bit_cast(float, __builtin_amdgcn_readlane(b, 0)), a1 = __builtin_bit_cast(float, __builtin_amdgcn_readlane(b, 16));
    const float a2 = __builtin_bit_cast(float, __builtin_amdgcn_readlane(b, 32)), a3 = __builtin_bit_cast(float, __builtin_amdgcn_readlane(b, 48));
    return (a0 + a1) + (a2 + a3);
}
__device__ __forceinline__ f32x4 zero4() { float z = 0.f; asm volatile("" : "+v"(z)); return (f32x4){z, z, z, z}; }
__device__ __forceinline__ f32x4 mfma16(bf16x8 a, bf16x8 b, f32x4 c) { return __builtin_amdgcn_mfma_f32_16x16x32_bf16(a, b, c, 0, 0, 0); }
__device__ __forceinline__ bf16x8 pack8(const float* z) { u32x4 u; u.x = pk2(z[0], z[1]); u.y = pk2(z[2], z[3]); u.z = pk2(z[4], z[5]); u.w = pk2(z[6], z[7]); return __builtin_bit_cast(bf16x8, u); }
__device__ __forceinline__ void unpack4(u32x2 u, float* z) { z[0] = bflo(u.x); z[1] = bfhi(u.x); z[2] = bflo(u.y); z[3] = bfhi(u.y); }
__device__ __forceinline__ void unpack8(u32x4 u, float* z) { z[0] = bflo(u.x); z[1] = bfhi(u.x); z[2] = bflo(u.y); z[3] = bfhi(u.y); z[4] = bflo(u.z); z[5] = bfhi(u.z); z[6] = bflo(u.w); z[7] = bfhi(u.w); }

namespace pg8 {
constexpr int BM = 256, BK = 64, HALF = 128, HTB = HALF * BK * 2, STAGE_BYTES = 8 * HTB, NXCD = 8, WGM = 8;
__device__ __forceinline__ int lds_byte(int r, int c) { const int st = (r >> 4) * 2 + (c >> 5), rr = r & 15, cc = c & 31, ob = rr * 64 + cc * 2; return st * 1024 + (ob ^ (((ob >> 9) & 1) << 5)); }
__device__ __forceinline__ void stage_rc(int b, int& R, int& C) { const int st = b / 1024, sb = b % 1024, swz = sb ^ (((sb >> 9) & 1) << 5); R = (st >> 1) * 16 + swz / 64; C = (st & 1) * 32 + (swz % 64) / 2; }
__device__ __forceinline__ int perm32(int rho) { const int n = rho >> 4, i = rho & 15; return 8 * (i >> 2) + 4 * n + (i & 3); }
struct Unit { int pm, pn; };
struct Gemm { const bf16_t* A; const bf16_t* Bt; int M, N, K, lda; };
struct StaticOrder {
    int nM, nN, nwg, G, c;
    __device__ void init(int M, int N, int G_, int c_) { nM = M / BM; nN = N / BM; nwg = nM * nN; G = G_; c = c_; }
    __device__ bool next(int i, Unit& u) const {
        const long L = (long)i * G + c; if (L >= nwg) return false;
        int wgid = (int)L; { const int q = nwg / NXCD, r = nwg % NXCD, xcd = wgid % NXCD, off = wgid / NXCD; wgid = (xcd < r ? xcd * (q + 1) : r * (q + 1) + (xcd - r) * q) + off; }
        const int nig = WGM * nN, gid = wgid / nig, fm = gid * WGM, gsz = (nM - fm) < WGM ? (nM - fm) : WGM;
        u.pm = fm + ((wgid % nig) % gsz); u.pn = (wgid % nig) / gsz; return true;
    }
};

template <class Epi>
__device__ __forceinline__ void gemm_phase(LAS unsigned char* lds, const Gemm g, const StaticOrder& S, const Epi& E, const int tid) {
    const int wid = __builtin_amdgcn_readfirstlane(tid >> 6), lane = tid & 63, wr = wid >> 2, wc = wid & 3, fr = lane & 15, fq = lane >> 4;
    const int K = g.K, nt = K / BK;
    unsigned voffA[2], voffB[2];
#pragma unroll
    for (int i = 0; i < 2; ++i) { int R, C; stage_rc(tid * 16 + i * 8192, R, C); const int Rb = Epi::PERM ? ((R & ~31) + perm32(R & 31)) : R;
        voffA[i] = (unsigned)(R * g.lda + C) * 2u; voffB[i] = (unsigned)(Rb * K + C) * 2u; }
    const size_t kstep = (size_t)(BK * 2);
    const size_t hstepA = (size_t)HALF * g.lda * 2, hstepB = (size_t)HALF * K * 2;
    const size_t tstepA = 2 * hstepA, tstepB = 2 * hstepB;
    const unsigned ldsw = (unsigned)wid * 1024u;
    const int aoff = lds_byte(wr * 64 + fr, fq * 8), boff = lds_byte(wc * 32 + fr, fq * 8);
#define PG8_SA(b, h) (((b) * 2 + (h)) * HTB)
#define PG8_SB(b, h) ((4 + (b) * 2 + (h)) * HTB)
#define PG8_STAGE(bufoff, gbase, voff) do { _Pragma("unroll") for (int _i = 0; _i < 2; ++_i) \
        __builtin_amdgcn_global_load_lds((const unsigned*)((const char*)(gbase) + (voff)[_i]), (LAS unsigned*)(lds + (bufoff) + ldsw + _i * 8192), 16, 0, 0); } while (0)
#define PG8_LDA(dst, b, h) do { _Pragma("unroll") for (int m = 0; m < 4; ++m) _Pragma("unroll") for (int k = 0; k < 2; ++k) dst[m][k] = *(const LAS bf16x8*)(lds + PG8_SA(b, h) + aoff + m * 2048 + k * 1024); } while (0)
#define PG8_LDB(dst, b, h) do { _Pragma("unroll") for (int n = 0; n < 2; ++n) _Pragma("unroll") for (int k = 0; k < 2; ++k) dst[n][k] = *(const LAS bf16x8*)(lds + PG8_SB(b, h) + boff + n * 2048 + k * 1024); } while (0)
#define PG8_MMA(ai, bj, At, Bt) do { __builtin_amdgcn_s_setprio(1); _Pragma("unroll") for (int m = 0; m < 4; ++m) _Pragma("unroll") for (int n = 0; n < 2; ++n) _Pragma("unroll") for (int k = 0; k < 2; ++k) \
        acc[ai][bj][m][n] = __builtin_amdgcn_mfma_f32_16x16x32_bf16(Bt[n][k], At[m][k], acc[ai][bj][m][n], 0, 0, 0); __builtin_amdgcn_s_setprio(0); } while (0)
#define PG8_WAIT_V(n) asm volatile("s_waitcnt vmcnt(" #n ")" ::: "memory")
#define PG8_WAIT_L(n) asm volatile("s_waitcnt lgkmcnt(" #n ")" ::: "memory")
#define PG8_BAR __builtin_amdgcn_s_barrier()
#define PG8_SCHED __builtin_amdgcn_sched_barrier(0)
    Unit cur, nxt; int ui = 0;
    if (!S.next(0, cur)) return;
    f32x4 acc[2][2][4][2];
#pragma unroll
    for (int a = 0; a < 2; ++a)
#pragma unroll
        for (int b = 0; b < 2; ++b)
#pragma unroll
            for (int m = 0; m < 4; ++m)
#pragma unroll
                for (int n = 0; n < 2; ++n) acc[a][b][m][n] = zero4();
    bf16x8 At[4][2], B0[2][2], B1[2][2];
    const char* cA = (const char*)g.A + (size_t)cur.pm * tstepA; const char* cB = (const char*)g.Bt + (size_t)cur.pn * tstepB;
    PG8_STAGE(PG8_SB(0, 0), cB, voffB); PG8_STAGE(PG8_SA(0, 0), cA, voffA); PG8_STAGE(PG8_SB(0, 1), cB + hstepB, voffB); PG8_STAGE(PG8_SA(0, 1), cA + hstepA, voffA);
    if (wr == 1) PG8_BAR;
    PG8_WAIT_V(4); PG8_BAR;
    PG8_STAGE(PG8_SB(1, 0), cB + kstep, voffB); PG8_STAGE(PG8_SA(1, 0), cA + kstep, voffA); PG8_STAGE(PG8_SB(1, 1), cB + hstepB + kstep, voffB);
    PG8_WAIT_V(6); PG8_BAR;
    for (;;) {
        const bool has_next = S.next(ui + 1, nxt);
        const char* nA = has_next ? (const char*)g.A + (size_t)nxt.pm * tstepA : cA; const char* nB = has_next ? (const char*)g.Bt + (size_t)nxt.pn * tstepB : cB;
        for (int t = 0; t < nt; t += 2) {
            const bool last = (t == nt - 2);
            const char* a1 = cA + (size_t)(t + 1) * kstep;
            const char* a2 = last ? nA : cA + (size_t)(t + 2) * kstep; const char* b2 = last ? nB : cB + (size_t)(t + 2) * kstep;
            const char* a3 = a2 + kstep; const char* b3 = b2 + kstep;
            PG8_LDB(B0, 0, 0); PG8_SCHED; PG8_LDA(At, 0, 0); PG8_STAGE(PG8_SA(1, 1), a1 + hstepA, voffA);
            PG8_WAIT_L(8); PG8_BAR; PG8_WAIT_L(0); PG8_MMA(0, 0, At, B0); PG8_BAR; PG8_SCHED;
            PG8_LDB(B1, 0, 1); PG8_STAGE(PG8_SB(0, 0), b2, voffB);
            PG8_BAR; PG8_WAIT_L(0); PG8_MMA(0, 1, At, B1); PG8_BAR;
            PG8_LDA(At, 0, 1); PG8_STAGE(PG8_SA(0, 0), a2, voffA);
            PG8_BAR; PG8_WAIT_L(0); PG8_MMA(1, 0, At, B0); PG8_BAR; PG8_SCHED;
            PG8_STAGE(PG8_SB(0, 1), b2 + hstepB, voffB);
            PG8_WAIT_V(6); PG8_BAR; PG8_MMA(1, 1, At, B1); PG8_BAR;
            PG8_LDB(B0, 1, 0); PG8_SCHED; PG8_LDA(At, 1, 0); PG8_STAGE(PG8_SA(0, 1), a2 + hstepA, voffA);
            PG8_WAIT_L(8); PG8_BAR; PG8_WAIT_L(0); PG8_MMA(0, 0, At, B0); PG8_BAR; PG8_SCHED;
            PG8_LDB(B1, 1, 1); PG8_STAGE(PG8_SB(1, 0), b3, voffB);
            PG8_BAR; PG8_WAIT_L(0); PG8_MMA(0, 1, At, B1); PG8_BAR;
            PG8_LDA(At, 1, 1); PG8_STAGE(PG8_SA(1, 0), a3, voffA);
            PG8_BAR; PG8_WAIT_L(0); PG8_MMA(1, 0, At, B0); PG8_BAR; PG8_SCHED;
            PG8_STAGE(PG8_SB(1, 1), b3 + hstepB, voffB);
            PG8_WAIT_V(6); PG8_BAR; PG8_MMA(1, 1, At, B1); PG8_BAR;
        }
        E(acc, cur, wr, wc, fr, fq);
        if (!has_next) break;
#pragma unroll
        for (int a = 0; a < 2; ++a)
#pragma unroll
            for (int b = 0; b < 2; ++b)
#pragma unroll
                for (int m = 0; m < 4; ++m)
#pragma unroll
                    for (int n = 0; n < 2; ++n) acc[a][b][m][n] = zero4();
        cur = nxt; cA = nA; cB = nB; ++ui;
    }
    PG8_WAIT_V(0);
    if (wr == 0) PG8_BAR;
    PG8_BAR;
#undef PG8_SA
#undef PG8_SB
#undef PG8_STAGE
#undef PG8_LDA
#undef PG8_LDB
#undef PG8_MMA
#undef PG8_WAIT_V
#undef PG8_WAIT_L
#undef PG8_BAR
#undef PG8_SCHED
}
}

struct EpiZ {
    static constexpr bool PERM = true;
    bf16_t* Z; const unsigned long long* ssq;
    __device__ __forceinline__ void operator()(const f32x4 (&acc)[2][2][4][2], const pg8::Unit& u, int wr, int wc, int fr, int fq) const {
        const int row0 = u.pm * 256 + wr * 64 + fr, col0 = u.pn * 256 + wc * 32 + 8 * fq;
        unsigned long long sq[8];
#pragma unroll
        for (int i = 0; i < 8; ++i) sq[i] = ssq[row0 + (i >> 2) * 128 + (i & 3) * 16];
#pragma unroll
        for (int ai = 0; ai < 2; ++ai)
#pragma unroll
            for (int m = 0; m < 4; ++m) { const int row = row0 + ai * 128 + m * 16; const float rs = rsqrtf((float)sq[ai * 4 + m] * (1.0f / (SSQ_SCALE * 1024.0f)) + 1e-6f);
                bf16_t* rowp = Z + (size_t)row * ZLD + col0;
#pragma unroll
                for (int bj = 0; bj < 2; ++bj) { if (u.pn * 256 + bj * 128 >= INC) continue;
                    const f32x4 v0 = acc[ai][bj][m][0] * rs, v1 = acc[ai][bj][m][1] * rs;
                    u32x4 w; w.x = pk2(v0[0], v0[1]); w.y = pk2(v0[2], v0[3]); w.z = pk2(v1[0], v1[1]); w.w = pk2(v1[2], v1[3]);
                    *(u32x4*)(rowp + bj * 128) = w; } }
    }
};
struct EpiRes {
    static constexpr bool PERM = true;
    bf16_t* XB; unsigned long long* ssq;
    __device__ __forceinline__ void operator()(const f32x4 (&acc)[2][2][4][2], const pg8::Unit& u, int wr, int wc, int fr, int fq) const {
        const int row0 = u.pm * 256 + wr * 64 + fr, col0 = u.pn * 256 + wc * 32 + 8 * fq;
        u32x4 xin[2][4][2];
#pragma unroll
        for (int ai = 0; ai < 2; ++ai)
#pragma unroll
            for (int m = 0; m < 4; ++m) { const bf16_t* bp = XB + (size_t)(row0 + ai * 128 + m * 16) * DM + col0;
#pragma unroll
                for (int bj = 0; bj < 2; ++bj) xin[ai][m][bj] = *(const u32x4*)(bp + bj * 128); }
#pragma unroll
        for (int ai = 0; ai < 2; ++ai)
#pragma unroll
            for (int m = 0; m < 4; ++m) { const int row = row0 + ai * 128 + m * 16; bf16_t* bp = XB + (size_t)row * DM + col0; float s = 0.f;
#pragma unroll
                for (int bj = 0; bj < 2; ++bj) { float xo[8]; unpack8(xin[ai][m][bj], xo); const f32x4 a0 = acc[ai][bj][m][0], a1 = acc[ai][bj][m][1];
                    u32x4 w; w.x = pk2(xo[0] + a0[0], xo[1] + a0[1]); w.y = pk2(xo[2] + a0[2], xo[3] + a0[3]); w.z = pk2(xo[4] + a1[0], xo[5] + a1[1]); w.w = pk2(xo[6] + a1[2], xo[7] + a1[3]);
                    *(u32x4*)(bp + bj * 128) = w; float o[8]; unpack8(w, o);
#pragma unroll
                    for (int e = 0; e < 8; ++e) s += o[e] * o[e]; }
                s += __shfl_xor(s, 16); s += __shfl_xor(s, 32);
                if (fq == 0) ssq_add(ssq, row, s); }
    }
};
struct EpiAct {
    static constexpr bool PERM = true;
    bf16_t* ACT; const unsigned long long* ssq;
    __device__ __forceinline__ void operator()(const f32x4 (&acc)[2][2][4][2], const pg8::Unit& u, int wr, int wc, int fr, int fq) const {
        const int row0 = u.pm * 256 + wr * 64 + fr, col0 = u.pn * 128 + wc * 32 + 8 * fq;
        unsigned long long sq[8];
#pragma unroll
        for (int i = 0; i < 8; ++i) sq[i] = ssq[row0 + (i >> 2) * 128 + (i & 3) * 16];
#pragma unroll
        for (int ai = 0; ai < 2; ++ai)
#pragma unroll
            for (int m = 0; m < 4; ++m) { const int row = row0 + ai * 128 + m * 16; const float rs = rsqrtf((float)sq[ai * 4 + m] * (1.0f / (SSQ_SCALE * 1024.0f)) + 1e-6f);
                float o[8];
#pragma unroll
                for (int n = 0; n < 2; ++n)
#pragma unroll
                    for (int j = 0; j < 4; ++j) { const float g = acc[ai][0][m][n][j] * rs, up = acc[ai][1][m][n][j] * rs; o[n * 4 + j] = g * sigmoidf_(g) * up; }
                u32x4 w; w.x = pk2(o[0], o[1]); w.y = pk2(o[2], o[3]); w.z = pk2(o[4], o[5]); w.w = pk2(o[6], o[7]);
                *(u32x4*)(ACT + (size_t)row * DFF + col0) = w; }
    }
};

template <class F>
__device__ __forceinline__ void thin_gemm(const bf16_t* A, int lda, const bf16_t* Bt, int K, int npairs, const F& f, int w, int lane, int wgi = -1, int G = 0) {
    if (wgi < 0) { wgi = blockIdx.x; G = gridDim.x; }
    const int fr = lane & 15, fq = lane >> 4, ntask = npairs * 8;
    for (int task = w * G + wgi; task < ntask; task += 8 * G) {
        const int rt = task & 7, pr = task >> 3;
        const bf16_t* ap = A + (size_t)(rt * 16 + fr) * lda + 8 * fq;
        const bf16_t* bp0 = Bt + (size_t)(f.b0(pr) + fr) * K + 8 * fq;
        const bf16_t* bp1 = Bt + (size_t)(f.b1(pr) + fr) * K + 8 * fq;
        f32x4 c0 = {0.f, 0.f, 0.f, 0.f}, c1 = {0.f, 0.f, 0.f, 0.f};
        for (int k0 = 0; k0 < K; k0 += 256) {
            bf16x8 a[8], x[8], y[8];
#pragma unroll
            for (int i = 0; i < 8; ++i) { a[i] = *(const bf16x8*)(ap + k0 + i * 32); x[i] = *(const bf16x8*)(bp0 + k0 + i * 32); y[i] = *(const bf16x8*)(bp1 + k0 + i * 32); }
#pragma unroll
            for (int i = 0; i < 8; ++i) { c0 = mfma16(x[i], a[i], c0); c1 = mfma16(y[i], a[i], c1); }
        }
        f.epi(rt * 16 + fr, pr, fq, c0, c1);
    }
}
template <int KS, class F>
__device__ __forceinline__ void thin_gemm_sk(LAS unsigned char* lds, const bf16_t* A, int lda, const bf16_t* Bt, int K, int npairs, const F& f, int w, int lane) {
    const int fr = lane & 15, fq = lane >> 4, ntask = npairs * 8;
    LAS float* P = (LAS float*)lds;
    for (int task = blockIdx.x; task < ntask; task += gridDim.x) {
        const int rt = task & 7, pr = task >> 3, k0 = w * KS * 32;
        const bf16_t* ap = A + (size_t)(rt * 16 + fr) * lda + 8 * fq + k0;
        const bf16_t* bp0 = Bt + (size_t)(f.b0(pr) + fr) * K + 8 * fq + k0;
        const bf16_t* bp1 = Bt + (size_t)(f.b1(pr) + fr) * K + 8 * fq + k0;
        f32x4 c0 = {0.f, 0.f, 0.f, 0.f}, c1 = {0.f, 0.f, 0.f, 0.f};
        bf16x8 a[KS], x[KS], y[KS];
#pragma unroll
        for (int i = 0; i < KS; ++i) { a[i] = *(const bf16x8*)(ap + i * 32); x[i] = *(const bf16x8*)(bp0 + i * 32); y[i] = *(const bf16x8*)(bp1 + i * 32); }
#pragma unroll
        for (int i = 0; i < KS; ++i) { c0 = mfma16(x[i], a[i], c0); c1 = mfma16(y[i], a[i], c1); }
        *(LAS f32x4*)(P + (w * 64 + lane) * 8) = c0; *(LAS f32x4*)(P + (w * 64 + lane) * 8 + 4) = c1;
        __syncthreads();
        if (w == 0) {
            f32x4 s0 = {0.f, 0.f, 0.f, 0.f}, s1 = {0.f, 0.f, 0.f, 0.f};
#pragma unroll
            for (int q = 0; q < 8; ++q) { s0 += *(const LAS f32x4*)(P + (q * 64 + lane) * 8); s1 += *(const LAS f32x4*)(P + (q * 64 + lane) * 8 + 4); }
            f.epi(rt * 16 + fr, pr, fq, s0, s1);
        }
        __syncthreads();
    }
}
struct ThinZ { bf16_t* Z; const unsigned long long* ssq;
    __device__ __forceinline__ int b0(int pr) const { return pr * 32; }
    __device__ __forceinline__ int b1(int pr) const { return pr * 32 + 16; }
    __device__ __forceinline__ void epi(int r, int pr, int fq, f32x4 c0, f32x4 c1) const {
        const int row = NPROMPT + r; const float rs = ssq_rs(ssq, row); c0 = c0 * rs; c1 = c1 * rs;
        bf16_t* zp = Z + (size_t)row * ZLD + pr * 32 + 4 * fq; u32x2 a, b; a.x = pk2(c0[0], c0[1]); a.y = pk2(c0[2], c0[3]); b.x = pk2(c1[0], c1[1]); b.y = pk2(c1[2], c1[3]);
        *(u32x2*)zp = a; *(u32x2*)(zp + 16) = b; }
};
struct ThinRes { bf16_t* XB; unsigned long long* ssq;
    __device__ __forceinline__ int b0(int pr) const { return pr * 32; }
    __device__ __forceinline__ int b1(int pr) const { return pr * 32 + 16; }
    __device__ __forceinline__ void epi(int r, int pr, int fq, f32x4 c0, f32x4 c1) const {
        const int row = NPROMPT + r; bf16_t* bp = XB + (size_t)row * DM + pr * 32 + 4 * fq;
        float x0[4], x1[4]; unpack4(*(const u32x2*)bp, x0); unpack4(*(const u32x2*)(bp + 16), x1);
        u32x2 a, b; a.x = pk2(x0[0] + c0[0], x0[1] + c0[1]); a.y = pk2(x0[2] + c0[2], x0[3] + c0[3]); b.x = pk2(x1[0] + c1[0], x1[1] + c1[1]); b.y = pk2(x1[2] + c1[2], x1[3] + c1[3]);
        *(u32x2*)bp = a; *(u32x2*)(bp + 16) = b; float o0[4], o1[4]; unpack4(a, o0); unpack4(b, o1);
        float s = (o0[0] * o0[0] + o0[1] * o0[1]) + (o0[2] * o0[2] + o0[3] * o0[3]) + (o1[0] * o1[0] + o1[1] * o1[1]) + (o1[2] * o1[2] + o1[3] * o1[3]);
        s += __shfl_xor(s, 16); s += __shfl_xor(s, 32);
        if (fq == 0) ssq_add(ssq, row, s); }
};
struct ThinAct { bf16_t* ACT; const unsigned long long* ssq;
    __device__ __forceinline__ int b0(int pr) const { const int c = pr * 16; return (c >> 7) * 256 + (c & 127); }
    __device__ __forceinline__ int b1(int pr) const { const int c = pr * 16; return (c >> 7) * 256 + 128 + (c & 127); }
    __device__ __forceinline__ void epi(int r, int pr, int fq, f32x4 c0, f32x4 c1) const {
        const int row = NPROMPT + r; const float rs = ssq_rs(ssq, row); float o[4];
#pragma unroll
        for (int j = 0; j < 4; ++j) { const float g = c0[j] * rs, up = c1[j] * rs; o[j] = g * sigmoidf_(g) * up; }
        u32x2 a; a.x = pk2(o[0], o[1]); a.y = pk2(o[2], o[3]); *(u32x2*)(ACT + (size_t)row * DFF + pr * 16 + 4 * fq) = a; }
};

struct TileDesc { const float* src; const float* gain; bf16_t* dst; int lds_src, ld_dst; };
__device__ __forceinline__ TileDesc tile_desc(const Ctx& c, int l, unsigned char* wb, int t) {
    bf16_t* WinT = (bf16_t*)(wb + WB_WIN); bf16_t* WoutT = (bf16_t*)(wb + WB_WOUT); bf16_t* WguT = (bf16_t*)(wb + WB_WGU); bf16_t* WdnT = (bf16_t*)(wb + WB_WDN); bf16_t* GLUT = (bf16_t*)(wb + WB_GLU);
    const int NT_IN = 16 * 38, NT_OUT = 256, NT_GU = 16 * 88, NT_DN = 44 * 16;
    TileDesc d; int q = t;
    if (q < NT_IN) { const int kt = q & 15, nt = q >> 4; d.src = c.in[8] + (size_t)l * 1024 * INC + (size_t)kt * 64 * INC + nt * 64; d.lds_src = INC; d.gain = c.in[7] + l * 1024 + kt * 64; d.dst = WinT + (size_t)nt * 64 * 1024 + kt * 64; d.ld_dst = 1024; return d; }
    q -= NT_IN;
    if (q < NT_OUT) { const int kt = q & 15, nt = q >> 4; const int bm = (kt >> 2) == 0 ? 3 : ((kt >> 2) == 1 ? 1 : ((kt >> 2) == 2 ? 0 : 2)); const int ks = bm * 256 + (kt & 3) * 64;
        d.src = c.in[36] + (size_t)l * 1024 * 1024 + (size_t)ks * 1024 + nt * 64; d.lds_src = 1024; d.gain = nullptr; d.dst = WoutT + (size_t)nt * 64 * 1024 + kt * 64; d.ld_dst = 1024; return d; }
    q -= NT_OUT;
    if (q < NT_GU) { const int kt = q & 15, nt = q >> 4; const int n0 = nt * 64; int dr; if (n0 < DFF) dr = (n0 >> 7) * 256 + (n0 & 127); else { const int n1 = n0 - DFF; dr = (n1 >> 7) * 256 + 128 + (n1 & 127); }
        d.src = c.in[38] + (size_t)l * 1024 * 5632 + (size_t)kt * 64 * 5632 + n0; d.lds_src = 5632; d.gain = c.in[37] + l * 1024 + kt * 64; d.dst = WguT + (size_t)dr * 1024 + kt * 64; d.ld_dst = 1024; return d; }
    q -= NT_GU;
    if (q < NT_DN) { const int nt = q & 15, kt = q >> 4; d.src = c.in[39] + (size_t)l * DFF * 1024 + (size_t)kt * 64 * 1024 + nt * 64; d.lds_src = 1024; d.gain = nullptr; d.dst = WdnT + (size_t)nt * 64 * DFF + kt * 64; d.ld_dst = DFF; return d; }
    q -= NT_DN;
    { const int kt = q & 3, nt = q >> 2; d.src = c.in[21] + (size_t)l * 65536 + (size_t)kt * 64 * 256 + nt * 64; d.lds_src = 256; d.gain = nullptr; d.dst = GLUT + (size_t)nt * 64 * 256 + kt * 64; d.ld_dst = 256; return d; }
}
struct TileRegs { f32x4 v[2]; float g[2]; };
__device__ __forceinline__ void tile_load(TileRegs& r, const TileDesc& d, int tid) {
    const int i = tid >> 4, j4 = (tid & 15) * 4;
#pragma unroll
    for (int p = 0; p < 2; ++p) { const int k = i + p * 32; r.v[p] = __builtin_nontemporal_load((const f32x4*)(d.src + (size_t)k * d.lds_src + j4)); r.g[p] = d.gain ? d.gain[k] : 1.0f; }
}
__device__ void convert_weights(const Ctx& c, int l, int buf, int part = -1, int wgi = -1, int nwg = 0) {
    if (wgi < 0) { wgi = blockIdx.x; nwg = gridDim.x; }
    asm volatile("" : "+s"(nwg), "+s"(wgi));
    unsigned char* wb = c.WB() + (size_t)buf * WB_SIZE;
    bf16_t* WinT = (bf16_t*)(wb + WB_WIN); bf16_t* LORAT = (bf16_t*)(wb + WB_LORA); bf16_t* WSB = (bf16_t*)(wb + WB_WSB);
    const int total = 16 * 38 + 256 + 16 * 88 + 44 * 16 + 16;
    const int t_lo = (part == 1) ? total / 2 : 0, t_hi = (part == 0) ? total / 2 : total;
    LAS float* T = (LAS float*)c.lds; const int tid = c.tid;
    int t = t_lo + wgi;
    if (t < t_hi) {
        TileDesc d = tile_desc(c, l, wb, t); TileRegs r; tile_load(r, d, tid);
        for (;;) {
            { const int i = tid >> 4, j4 = (tid & 15) * 4;
#pragma unroll
              for (int p = 0; p < 2; ++p) { const int k = i + p * 32; T[k * 65 + j4 + 0] = r.v[p][0] * r.g[p]; T[k * 65 + j4 + 1] = r.v[p][1] * r.g[p]; T[k * 65 + j4 + 2] = r.v[p][2] * r.g[p]; T[k * 65 + j4 + 3] = r.v[p][3] * r.g[p]; } }
            __syncthreads();
            const int tn = t + nwg; const bool more = tn < t_hi; const TileDesc dcur = d;
            if (more) { d = tile_desc(c, l, wb, tn); tile_load(r, d, tid); }
            { const int jn = tid >> 3, kq = (tid & 7) * 8; float z[8];
#pragma unroll
              for (int e = 0; e < 8; ++e) z[e] = T[(kq + e) * 65 + jn];
              *(bf16x8*)(dcur.dst + (size_t)jn * dcur.ld_dst + kq) = pack8(z); }
            __syncthreads();
            if (!more) break;
            t = tn;
        }
    }
    if (part == 1) return;
    const int gt = wgi * 512 + c.tid, gn = nwg * 512;
    for (int i = gt; i < 128 * 1024; i += gn) WinT[(size_t)INC * 1024 + i] = 0;
    for (int i = gt; i < 256 * 128; i += gn) { const int n = i >> 7, k = i & 127; float v;
        if (k < 32) v = c.in[27][(size_t)l * 32 * 256 + k * 256 + n]; else if (k < 64) v = c.in[29][(size_t)l * 32 * 256 + (k - 32) * 256 + n]; else v = c.in[30][(size_t)l * 64 * 256 + (k - 64) * 256 + n];
        LORAT[i] = f2bf(v); }
    for (int i = gt; i < 4 * 128 * 128; i += gn) { const int s = i & 127, t = (i >> 7) & 127; WSB[i] = (s <= t) ? f2bf(c.in[11][(size_t)l * 65536 + i]) : (bf16_t)0; }
}

__device__ void phase0(const Ctx& c) {
    for (int row0 = c.gw; row0 < NR; row0 += 5 * c.nw) {
        f32x4 v[5][4];
#pragma unroll
        for (int u = 0; u < 5; ++u) { const int row = (row0 + u * c.nw < NR) ? row0 + u * c.nw : row0; const float* src = row < NPROMPT ? c.in[0] + (size_t)row * DM : c.in[1] + (size_t)(row - NPROMPT) * DM;
#pragma unroll
            for (int j = 0; j < 4; ++j) v[u][j] = __builtin_nontemporal_load((const f32x4*)(src + j * 256 + c.lane * 4)); }
#pragma unroll
        for (int u = 0; u < 5; ++u) { const int row = row0 + u * c.nw; if (row < NR) { float s = 0.f;
#pragma unroll
            for (int j = 0; j < 4; ++j) { const int col = j * 256 + c.lane * 4; u32x2 w; w.x = pk2(v[u][j][0], v[u][j][1]); w.y = pk2(v[u][j][2], v[u][j][3]); *(u32x2*)(c.XB() + (size_t)row * DM + col) = w; float o[4]; unpack4(w, o); s += (o[0] * o[0] + o[1] * o[1]) + (o[2] * o[2] + o[3] * o[3]); }
            s = wave_sum(s); if (c.lane == 0) c.SSQ()[row] = (unsigned long long)(s * SSQ_SCALE + 0.5f); } }
    }
    for (int i = blockIdx.x * 512 + c.tid; i < 8 * NR; i += gridDim.x * 512) c.SSQ()[NR + i] = 0ull;
    for (int i = blockIdx.x * 512 + c.tid; i < NL * 1024; i += gridDim.x * 512) {
        const float lam_re = fminf(c.in[13][i], -1e-4f), lam_im = c.in[14][i], dt = expf(c.in[15][i]);
        const float mag = expf(lam_re * dt); float sn, cs; sincosf(lam_im * dt, &sn, &cs);
        const float lbr = mag * cs, lbi = mag * sn, den = lam_re * lam_re + lam_im * lam_im;
        const float f_re = ((lbr - 1.0f) * lam_re + lbi * lam_im) / den, f_im = (lbi * lam_re - (lbr - 1.0f) * lam_im) / den;
        c.LBC()[2 * i] = lbr; c.LBC()[2 * i + 1] = lbi;
        const int lg = i >> 6, pp = i & 63; bf16_t* bo = c.BBAR() + ((size_t)lg * 128 + 2 * pp) * 16;
#pragma unroll
        for (int q = 0; q < 4; ++q) { const f32x4 br = *(const f32x4*)(c.in[16] + (size_t)i * 16 + q * 4), bi = *(const f32x4*)(c.in[17] + (size_t)i * 16 + q * 4); float re[4], im[4];
#pragma unroll
            for (int e = 0; e < 4; ++e) { re[e] = f_re * br[e] - f_im * bi[e]; im[e] = f_re * bi[e] + f_im * br[e]; }
            u32x2 a; a.x = pk2(re[0], re[1]); a.y = pk2(re[2], re[3]); *(u32x2*)(bo + q * 4) = a; a.x = pk2(im[0], im[1]); a.y = pk2(im[2], im[3]); *(u32x2*)(bo + 16 + q * 4) = a; }
    }
    convert_weights(c, 0, 0);
}

template <int N> struct ZsVec { typedef u32x4 T; };
template <> struct ZsVec<4> { typedef u32x2 T; };
template <int N, bool SAMP> struct ZsIn {
    typename ZsVec<N>::T cur, prb; f32x4 prf[N / 4]; f32x4 mu[N / 4]; float pm;
    __device__ __forceinline__ void load(const Ctx& c, int l, int row, int col) {
        typedef typename ZsVec<N>::T V;
        const bf16_t* zp = c.Z() + (size_t)row * ZLD + 1536 + col;
        cur = *(const V*)zp;
        pm = 1.0f;
        if (!SAMP) { const bool first = (row & (SEQ - 1)) == 0; pm = first ? 0.f : 1.f; const bf16_t* pp = first ? zp : zp - ZLD; prb = *(const V*)pp; }
        else { const float* sp = c.in[3] + ((size_t)l * NSAMP + (row - NPROMPT)) * DTM + col;
#pragma unroll
            for (int e = 0; e < N / 4; ++e) prf[e] = *(const f32x4*)(sp + 4 * e); }
        const float* m = c.in[25] + l * DTM + col;
#pragma unroll
        for (int e = 0; e < N / 4; ++e) mu[e] = *(const f32x4*)(m + 4 * e);
    }
    __device__ __forceinline__ void eval(float* out) const {
        float cu[N], pv[N];
        if constexpr (N == 8) unpack8(cur, cu); else unpack4(cur, cu);
        if (!SAMP) { if constexpr (N == 8) unpack8(prb, pv); else unpack4(prb, pv); }
        else {
#pragma unroll
            for (int e = 0; e < N; ++e) pv[e] = prf[e >> 2][e & 3]; }
#pragma unroll
        for (int e = 0; e < N; ++e) out[e] = cu[e] + mu[e >> 2][e & 3] * (pm * pv[e] - cu[e]);
    }
};

__device__ void d1_chunk(const Ctx& c, int blk, int h);
template <bool SAMP> __device__ __forceinline__ void rwkv_tok_task(const Ctx& c, int l, const bf16_t* LORAT, int blk, int h, int mt_lo, int mt_hi) {
    const int lane = c.lane, fr = lane & 15, fq = lane >> 4;
    for (int mt = mt_lo; mt < mt_hi; ++mt) {
        const int row = blk * 32 + mt * 16 + fr;
        bf16_t* tok = c.TOK() + (size_t)row * 1536;
        ZsIn<8, SAMP> za[4]; bf16x8 lf[4][4];
#pragma unroll
        for (int ks = 0; ks < 4; ++ks) za[ks].load(c, l, row, 768 + ks * 32 + 8 * fq);
#pragma unroll
        for (int nt = 0; nt < 4; ++nt)
#pragma unroll
            for (int ks = 0; ks < 4; ++ks) lf[nt][ks] = *(const bf16x8*)(LORAT + (size_t)(h * 64 + 32 * (nt >> 1) + 8 * (fr >> 2) + 4 * (nt & 1) + (fr & 3)) * 128 + ks * 32 + 8 * fq);
        bf16x8 af[4];
#pragma unroll
        for (int ks = 0; ks < 4; ++ks) { float z[8]; za[ks].eval(z);
#pragma unroll
            for (int e = 0; e < 8; ++e) z[e] = (ks == 0) ? tanh_(z[e]) : ((ks == 1) ? z[e] : sigmoidf_(z[e]));
            af[ks] = pack8(z); }
        f32x4 aw[4], aa[4], ag[4];
#pragma unroll
        for (int nt = 0; nt < 4; ++nt) { const f32x4 zero = {0.f, 0.f, 0.f, 0.f};
            aw[nt] = mfma16(lf[nt][0], af[0], zero); aa[nt] = mfma16(lf[nt][1], af[1], zero); ag[nt] = mfma16(lf[nt][2], af[2], zero); ag[nt] = mfma16(lf[nt][3], af[3], ag[nt]); }
        float n2 = 0.f, bon = 0.f; float kkr[16], av[16];
#pragma unroll
        for (int np = 0; np < 2; ++np) {
            asm volatile("" ::: "memory");
            const int cb = h * 64 + 32 * np + 8 * fq;
            ZsIn<8, SAMP> zr, zk, zv; f32x4 w0[2], a0[2], kk_[2], ka[2], rk[2];
            zr.load(c, l, row, cb); zk.load(c, l, row, 256 + cb); zv.load(c, l, row, 512 + cb);
#pragma unroll
            for (int q = 0; q < 2; ++q) { const int ch = cb + 4 * q;
                w0[q] = *(const f32x4*)(c.in[26] + l * 256 + ch); a0[q] = *(const f32x4*)(c.in[28] + l * 256 + ch); kk_[q] = *(const f32x4*)(c.in[31] + l * 256 + ch);
                ka[q] = *(const f32x4*)(c.in[32] + l * 256 + ch); rk[q] = *(const f32x4*)(c.in[33] + l * 256 + ch); }
            float rz[8], kz[8], vz[8]; zr.eval(rz); zk.eval(kz); zv.eval(vz);
            float km[8], ld[8], gg[8];
#pragma unroll
            for (int q = 0; q < 2; ++q) { const int nt = 2 * np + q;
#pragma unroll
                for (int e = 0; e < 4; ++e) { const int i8 = 4 * q + e;
                    const float x = -(w0[q][e] + aw[nt][e]); const float sp = fmaxf(x, 0.f) + __logf(1.0f + __expf(-fabsf(x))); const float wv = -sp - 0.5f; ld[i8] = -__expf(wv);
                    const float a = sigmoidf_(a0[q][e] + aa[nt][e]); gg[i8] = ag[nt][e];
                    const float kr = kz[i8] * kk_[q][e]; n2 += kr * kr; km[i8] = kz[i8] * (1.0f + (a - 1.0f) * ka[q][e]); bon += rz[i8] * km[i8] * rk[q][e];
                    kkr[nt * 4 + e] = kr; av[nt * 4 + e] = a; } }
            *(bf16x8*)(tok + cb) = pack8(rz); *(bf16x8*)(tok + 256 + cb) = pack8(km); *(bf16x8*)(tok + 512 + cb) = pack8(vz); *(bf16x8*)(tok + 1280 + cb) = pack8(ld);
            *(bf16x8*)(c.GG() + (size_t)row * 256 + cb) = pack8(gg);
        }
        n2 += __shfl_xor(n2, 16); n2 += __shfl_xor(n2, 32); bon += __shfl_xor(bon, 16); bon += __shfl_xor(bon, 32);
        const float inv = 1.0f / fmaxf(sqrtf(n2), 1e-12f);
#pragma unroll
        for (int np = 0; np < 2; ++np) { const int cb = h * 64 + 32 * np + 8 * fq; float kk[8], bv[8];
#pragma unroll
            for (int i8 = 0; i8 < 8; ++i8) { const int idx = (2 * np + (i8 >> 2)) * 4 + (i8 & 3); kk[i8] = kkr[idx] * inv; bv[i8] = kk[i8] * av[idx]; }
            *(bf16x8*)(tok + 768 + cb) = pack8(kk); *(bf16x8*)(tok + 1024 + cb) = pack8(bv); }
        if (fq == 0) c.BON()[(size_t)row * 4 + h] = bon;
        asm volatile("" ::: "memory");
    }
}
__device__ void rwkv_tok(const Ctx& c, int l, int buf) {
    const bf16_t* LORAT = (const bf16_t*)(c.WB() + (size_t)buf * WB_SIZE + WB_LORA);
    for (int task = c.gw; task < (NPROMPT / 32) * 4; task += c.nw) rwkv_tok_task<false>(c, l, LORAT, task >> 2, task & 3, 0, 2);
    for (int ht = c.w * (int)gridDim.x + (int)blockIdx.x; ht < (NSAMP / 16) * 4; ht += 8 * (int)gridDim.x) { const int b16 = ht >> 2; rwkv_tok_task<true>(c, l, LORAT, NPROMPT / 32 + (b16 >> 1), ht & 3, b16 & 1, (b16 & 1) + 1); }
}

__device__ void conv_phase(const Ctx& c, int l) {
    const float* cw = c.in[23] + l * 768; const float* cb = c.in[24] + l * 256;
    for (int task = blockIdx.x * 512 + c.tid; task < (NPROMPT / 8) * 64; task += gridDim.x * 512) {
        const int cq = (task & 63) * 4, r0 = (task >> 6) * 8;
        const f32x4 w0 = *(const f32x4*)(cw + cq), w1 = *(const f32x4*)(cw + 256 + cq), w2 = *(const f32x4*)(cw + 512 + cq), bb = *(const f32x4*)(cb + cq);
        const int t0 = r0 & (SEQ - 1); const float pm = t0 ? 1.f : 0.f; const int rp = t0 ? r0 - 2 : r0;
        u32x2 zx[10], zc[10], zb[8];
#pragma unroll
        for (int i = 0; i < 10; ++i) { const int row = (i < 2) ? rp + i : r0 + i - 2; const bf16_t* zr = c.Z() + (size_t)row * ZLD; zx[i] = *(const u32x2*)(zr + 768 + cq); zc[i] = *(const u32x2*)(zr + 1280 + cq); if (i >= 2) zb[i - 2] = *(const u32x2*)(zr + 1024 + cq); }
        float zm2[4], zm1[4];
        { float a[4], b[4]; unpack4(zx[0], a); unpack4(zc[0], b);
#pragma unroll
          for (int e = 0; e < 4; ++e) zm2[e] = pm * a[e] * b[e];
          unpack4(zx[1], a); unpack4(zc[1], b);
#pragma unroll
          for (int e = 0; e < 4; ++e) zm1[e] = pm * a[e] * b[e]; }
#pragma unroll
        for (int i = 0; i < 8; ++i) { const int row = r0 + i; bf16_t* zr = c.Z() + (size_t)row * ZLD; float a[4], b[4], g[4], z0[4], y[4];
            unpack4(zx[i + 2], a); unpack4(zc[i + 2], b); unpack4(zb[i], g);
#pragma unroll
            for (int e = 0; e < 4; ++e) { z0[e] = a[e] * b[e]; y[e] = g[e] * (bb[e] + w0[e] * zm2[e] + w1[e] * zm1[e] + w2[e] * z0[e]); zm2[e] = zm1[e]; zm1[e] = z0[e]; }
            u32x2 p; p.x = pk2(y[0], y[1]); p.y = pk2(y[2], y[3]); *(u32x2*)(zr + 1024 + cq) = p;
            const int t = row & (SEQ - 1);
            if (t >= SEQ - 2) { float* o = c.out + O_CVP + (((size_t)l * NB + (row >> 11)) * 2 + (t - (SEQ - 2))) * 256 + cq; *(f32x4*)o = (f32x4){z0[0], z0[1], z0[2], z0[3]}; } }
    }
    for (int task = blockIdx.x * 512 + c.tid; task < NSAMP * 64; task += gridDim.x * 512) {
        const int cq = (task & 63) * 4, i = task >> 6, row = NPROMPT + i; bf16_t* zr = c.Z() + (size_t)row * ZLD;
        const f32x4 w0 = *(const f32x4*)(cw + cq), w1 = *(const f32x4*)(cw + 256 + cq), w2 = *(const f32x4*)(cw + 512 + cq), bb = *(const f32x4*)(cb + cq);
        const float* sc = c.in[6] + ((size_t)l * NSAMP + i) * 512; const f32x4 b0 = *(const f32x4*)(sc + cq), b1 = *(const f32x4*)(sc + 256 + cq);
        float a[4], b[4], g[4], y[4]; f32x4 z0;
        unpack4(*(const u32x2*)(zr + 768 + cq), a); unpack4(*(const u32x2*)(zr + 1280 + cq), b); unpack4(*(const u32x2*)(zr + 1024 + cq), g);
#pragma unroll
        for (int e = 0; e < 4; ++e) { z0[e] = a[e] * b[e]; y[e] = g[e] * (bb[e] + w0[e] * b0[e] + w1[e] * b1[e] + w2[e] * z0[e]); }
        u32x2 p; p.x = pk2(y[0], y[1]); p.y = pk2(y[2], y[3]); *(u32x2*)(zr + 1024 + cq) = p;
        float* o = c.out + O_CVS + ((size_t)l * NSAMP + i) * 512; *(f32x4*)(o + cq) = b1; *(f32x4*)(o + 256 + cq) = z0;
    }
}

__device__ void shift_out(const Ctx& c, int l, int first, int stride) {
    for (int i = first; i < (NB + NSAMP) * DTM; i += stride) {
        const int s = i / DTM, col = i - s * DTM;
        if (s < NB) c.out[O_SHP + ((size_t)l * NB + s) * DTM + col] = bf2f(c.Z()[(size_t)(s * SEQ + SEQ - 1) * ZLD + 1536 + col]);
        else c.out[O_SHS + ((size_t)l * NSAMP + (s - NB)) * DTM + col] = bf2f(c.Z()[(size_t)(NPROMPT + s - NB) * ZLD + 1536 + col]);
    }
}

constexpr int LDS_U = 0, LDS_S = 32768, LDS_YG = 102400, SLD = 136, YLD = 264;
template <bool FULL> __device__ void ssm_tile(const Ctx& c, int l, int tile, int h_lo = 0, int h_hi = 2) {
    const int lane = c.lane, w = c.w, fr = lane & 15, fq = lane >> 4;
    const bool samp = tile >= 256;
    const int row0 = samp ? NPROMPT + (tile - 256) * 64 : tile * 64, b = tile >> 5, ch = tile & 31;
    LAS bf16_t* S = (LAS bf16_t*)(c.lds + LDS_S + w * (32 * SLD * 2));
    LAS unsigned* S32 = (LAS unsigned*)S;
    LAS bf16_t* YG = (LAS bf16_t*)(c.lds + LDS_YG);
    float z0_ = 0.f; asm volatile("" : "+v"(z0_)); const f32x4 zero = {z0_, z0_, z0_, z0_};
    for (int gi = 0; gi < 2; ++gi) {
        const int g = 2 * w + gi, idx = (l * 16 + g) * 64 + lane;
        const f32x2 lb = *(const f32x2*)(c.LBC() + 2 * idx); const float lbr = lb.x, lbi = lb.y;
        bf16x8 bbf[8];
#pragma unroll
        for (int it = 0; it < 8; ++it) { u32x4 v = *(const u32x4*)(c.BBAR() + ((size_t)(l * 16 + g) * 128 + it * 16 + fr) * 16 + 8 * (fq & 1)); if (fq >= 2) v = (u32x4){0u, 0u, 0u, 0u}; bbf[it] = __builtin_bit_cast(bf16x8, v); }
        float sr = 0.f, si = 0.f;
        bf16x8 cm[4];
        const f32x4 dd = *(const f32x4*)(c.in[20] + (size_t)(l * 16 + g) * 16 + 4 * fq);
        if (FULL) {
            if (!samp) {
                float pr = lbr, pi = lbi;
#pragma unroll
                for (int q = 0; q < 6; ++q) { const float nr = pr * pr - pi * pi, ni = 2.0f * pr * pi; pr = nr; pi = ni; }
                for (int cc0 = 0; cc0 < ch; cc0 += 8) { f32x2 e[8];
#pragma unroll
                    for (int u = 0; u < 8; ++u) { const int cc = (cc0 + u < ch) ? cc0 + u : cc0; e[u] = *(const f32x2*)(c.EE() + ((size_t)((b * 32 + cc) * 16 + g) * 64 + lane) * 2); }
#pragma unroll
                    for (int u = 0; u < 8; ++u) if (cc0 + u < ch) { const float nr = pr * sr - pi * si + e[u].x, ni = pr * si + pi * sr + e[u].y; sr = nr; si = ni; } }
            }
#pragma unroll
            for (int ks = 0; ks < 4; ++ks) { const size_t co = ((size_t)(l * 16 + g) * 16 + fr) * 64 + ks * 16 + 4 * fq; const f32x4 vr = *(const f32x4*)(c.in[18] + co), vi = *(const f32x4*)(c.in[19] + co);
                float z[8] = {vr[0], -vi[0], vr[1], -vi[1], vr[2], -vi[2], vr[3], -vi[3]}; cm[ks] = pack8(z); }
        }
        for (int half = h_lo; half < h_hi; ++half) {
            asm volatile("s_waitcnt lgkmcnt(0)" ::: "memory");
            u32x4 uvv[2]; u32x2 uue[2];
#pragma unroll
            for (int jt = 0; jt < 2; ++jt) { const bf16_t* up = c.Z() + (size_t)(row0 + half * 32 + jt * 16 + fr) * ZLD + 512 + g * 16; uvv[jt] = *(const u32x4*)(up + 8 * (fq & 1)); uue[jt] = *(const u32x2*)(up + 4 * fq); }
#pragma unroll
            for (int jt = 0; jt < 2; ++jt) { u32x4 uv = uvv[jt]; if (fq >= 2) uv = (u32x4){0u, 0u, 0u, 0u};
                const bf16x8 uf = __builtin_bit_cast(bf16x8, uv);
#pragma unroll
                for (int it = 0; it < 8; ++it) { const f32x4 d = mfma16(bbf[it], uf, zero); u32x2 pq; pq.x = pk2(d[0], d[1]); pq.y = pk2(d[2], d[3]); *(LAS u32x2*)(S + (jt * 16 + fr) * SLD + it * 16 + 4 * fq) = pq; } }
            asm volatile("s_waitcnt lgkmcnt(0)" ::: "memory");
            if (FULL && samp) {
#pragma unroll 1
                for (int t0 = 0; t0 < 32; t0 += 16) { float pr[16], pi[16]; const size_t sbase = ((size_t)(l * NSAMP + (row0 - NPROMPT) + half * 32 + t0) * 16 + g) * 64 + lane;
#pragma unroll
                    for (int u = 0; u < 16; ++u) { pr[u] = c.in[4][sbase + (size_t)u * 1024]; pi[u] = c.in[5][sbase + (size_t)u * 1024]; }
#pragma unroll
                    for (int u = 0; u < 16; ++u) { const unsigned wv = S32[(t0 + u) * (SLD / 2) + lane];
                        const float nr = lbr * pr[u] - lbi * pi[u] + bflo(wv), ni = lbr * pi[u] + lbi * pr[u] + bfhi(wv);
                        S32[(t0 + u) * (SLD / 2) + lane] = pk2(nr, ni); c.out[O_RES + sbase + (size_t)u * 1024] = nr; c.out[O_IMS + sbase + (size_t)u * 1024] = ni; }
                    asm volatile("" ::: "memory"); }
            } else {
#pragma unroll 1
            for (int tt0 = 0; tt0 < 32; tt0 += 8) { unsigned wv[8];
#pragma unroll
                for (int u = 0; u < 8; ++u) wv[u] = S32[(tt0 + u) * (SLD / 2) + lane];
#pragma unroll
                for (int u = 0; u < 8; ++u) { const float nr = lbr * sr - lbi * si + bflo(wv[u]), ni = lbr * si + lbi * sr + bfhi(wv[u]); sr = nr; si = ni;
                    if (FULL) S32[(tt0 + u) * (SLD / 2) + lane] = pk2(sr, si); }
            }
            }
            if (FULL) {
                asm volatile("s_waitcnt lgkmcnt(0)" ::: "memory");
#pragma unroll
                for (int mt = 0; mt < 2; ++mt) { f32x4 acc = zero;
#pragma unroll
                    for (int ks = 0; ks < 4; ++ks) { const bf16x8 sf = *(const LAS bf16x8*)(S + (mt * 16 + fr) * SLD + ks * 32 + 8 * fq); acc = mfma16(cm[ks], sf, acc); }
                    const int t = half * 32 + mt * 16 + fr; float uu[4]; unpack4(uue[mt], uu);
                    float y[4];
#pragma unroll
                    for (int e = 0; e < 4; ++e) y[e] = gelu_t(acc[e] + dd[e] * uu[e]);
                    u32x2 p; p.x = pk2(y[0], y[1]); p.y = pk2(y[2], y[3]); *(LAS u32x2*)(YG + t * YLD + g * 16 + 4 * fq) = p; }
            }
        }
        if (!FULL) { *(f32x2*)(c.EE() + ((size_t)((b * 32 + ch) * 16 + g) * 64 + lane) * 2) = (f32x2){sr, si}; }
        else if (!samp && ch == 31) { const size_t so = ((size_t)(l * NB + b) * 16 + g) * 64 + lane; c.out[O_REP + so] = sr; c.out[O_IMP + so] = si; }
    }
}
__device__ void ssm_glu(const Ctx& c, int l, int buf, int tile, int mt_lo = 0, int mt_hi = 4) {
    const bf16_t* GLUT = (const bf16_t*)(c.WB() + (size_t)buf * WB_SIZE + WB_GLU);
    const int lane = c.lane, w = c.w, fr = lane & 15, fq = lane >> 4;
    const int row0 = tile >= 256 ? NPROMPT + (tile - 256) * 64 : tile * 64;
    LAS bf16_t* YG = (LAS bf16_t*)(c.lds + LDS_YG);
    f32x4 acc[4][2];
#pragma unroll
    for (int mt = 0; mt < 4; ++mt) { acc[mt][0] = zero4(); acc[mt][1] = zero4(); }
#pragma unroll
    for (int ks = 0; ks < 8; ++ks) { bf16x8 bf[2];
#pragma unroll
        for (int nn = 0; nn < 2; ++nn) bf[nn] = *(const bf16x8*)(GLUT + (size_t)((2 * w + nn) * 16 + fr) * 256 + ks * 32 + 8 * fq);
#pragma unroll
        for (int mt = 0; mt < 4; ++mt) { const bf16x8 af = *(const LAS bf16x8*)(YG + (mt * 16 + fr) * YLD + ks * 32 + 8 * fq); acc[mt][0] = mfma16(bf[0], af, acc[mt][0]); acc[mt][1] = mfma16(bf[1], af, acc[mt][1]); } }
    f32x4 gbv[2];
#pragma unroll
    for (int nn = 0; nn < 2; ++nn) gbv[nn] = *(const f32x4*)(c.in[22] + l * 256 + (2 * w + nn) * 16 + 4 * fq);
#pragma unroll
    for (int mt = 0; mt < 4; ++mt)
#pragma unroll
        for (int nn = 0; nn < 2; ++nn) if (mt >= mt_lo && mt < mt_hi) { const int t = mt * 16 + fr, j = (2 * w + nn) * 16 + 4 * fq; float yg[4]; unpack4(*(const LAS u32x2*)(YG + t * YLD + j), yg);
            const f32x4 gb = gbv[nn]; float o[4];
#pragma unroll
            for (int e = 0; e < 4; ++e) o[e] = yg[e] * sigmoidf_(acc[mt][nn][e] + gb[e]);
            u32x2 p; p.x = pk2(o[0], o[1]); p.y = pk2(o[2], o[3]); *(u32x2*)(c.Z() + (size_t)(row0 + t) * ZLD + 512 + j) = p; }
}

template <bool WHOLE> __device__ void gmlp_tile(const Ctx& c, int l, int buf, int tile) {
    const bf16_t* WSB = (const bf16_t*)(c.WB() + (size_t)buf * WB_SIZE + WB_WSB);
    const int lane = c.lane, w = c.w, fr = lane & 15, fq = lane >> 4;
    const int b = WHOLE ? tile >> 4 : tile >> 5, cc = WHOLE ? (tile & 15) : ((tile & 31) >> 1), h_lo = WHOLE ? 0 : (tile & 1), h_hi = WHOLE ? 2 : (tile & 1) + 1, nKall = 64 * h_hi, rowc0 = b * SEQ + cc * 128;
    LAS bf16_t* VNt = (LAS bf16_t*)c.lds;
    const float* lg = c.in[9] + l * 256; const float* lb = c.in[10] + l * 256;
    u32x2 zuA[2][2][4]; float bsA[2][2];
    if constexpr (WHOLE) {
#pragma unroll
        for (int hh = 0; hh < 2; ++hh)
#pragma unroll
            for (int mi = 0; mi < 2; ++mi) { const int tt = hh * 64 + ((w & 1) * 2 + mi) * 16 + fr; bsA[hh][mi] = c.in[12][(size_t)l * 512 + (w >> 1) * 128 + tt]; const bf16_t* zr = c.Z() + (size_t)(rowc0 + tt) * ZLD;
#pragma unroll
                for (int nt = 0; nt < 4; ++nt) zuA[hh][mi][nt] = *(const u32x2*)(zr + (w >> 1) * 64 + nt * 16 + 4 * fq); }
    }
    constexpr int LNB = WHOLE ? 16 : 8;
    for (int s0 = w; s0 < nKall; s0 += 8 * LNB) { unsigned raw[LNB][4];
#pragma unroll
        for (int u = 0; u < LNB; ++u) { const bf16_t* zp = c.Z() + (size_t)(rowc0 + s0 + 8 * u) * ZLD + 256;
#pragma unroll
            for (int j = 0; j < 4; ++j) raw[u][j] = zp[lane + 64 * j]; }
#pragma unroll
        for (int u = 0; u < LNB; ++u) { const int s = s0 + 8 * u; float v[4]; float sum = 0.f;
            float q = 0.f;
#pragma unroll
            for (int j = 0; j < 4; ++j) { v[j] = gelu_t(__uint_as_float(raw[u][j] << 16)); sum += v[j]; q += v[j] * v[j]; }
            const float mean = wave_sum(sum) * (1.0f / 256.0f);
            const float rstd = rsqrtf(fmaxf(wave_sum(q) * (1.0f / 256.0f) - mean * mean, 0.f) + 1e-5f);
#pragma unroll
            for (int j = 0; j < 4; ++j) { const int chn = lane + 64 * j; VNt[chn * SLD + s] = f2bf((v[j] - mean) * rstd * lg[chn] + lb[chn]); } } }
    __syncthreads();
    const int h = w >> 1, mts = (w & 1) * 2;
#pragma unroll
    for (int half = 0; half < 2; ++half) { if (!WHOLE && (half < h_lo || half >= h_hi)) continue;
    const int nK = 64 * (half + 1);
    f32x4 acc[2][4];
#pragma unroll
    for (int mi = 0; mi < 2; ++mi)
#pragma unroll
        for (int nt = 0; nt < 4; ++nt) acc[mi][nt] = zero4();
    bf16x8 wf[4][2];
#pragma unroll
    for (int ks = 0; ks < 4; ++ks)
#pragma unroll
        for (int mi = 0; mi < 2; ++mi) { const int tt = half * 64 + (mts + mi) * 16 + fr; const int kse = (ks < nK / 32) ? ks : 0; wf[ks][mi] = *(const bf16x8*)(WSB + (size_t)(h * 128 + tt) * 128 + kse * 32 + 8 * fq); }
#pragma unroll
    for (int ks = 0; ks < 4; ++ks) if (ks < nK / 32) { bf16x8 bf[4];
#pragma unroll
        for (int nt = 0; nt < 4; ++nt) bf[nt] = *(const LAS bf16x8*)(VNt + (h * 64 + nt * 16 + fr) * SLD + ks * 32 + 8 * fq);
#pragma unroll
        for (int mi = 0; mi < 2; ++mi)
#pragma unroll
            for (int nt = 0; nt < 4; ++nt) acc[mi][nt] = mfma16(bf[nt], wf[ks][mi], acc[mi][nt]); }
    { u32x2 zu[2][4]; float bsv[2];
#pragma unroll
      for (int mi = 0; mi < 2; ++mi) { const int tt = half * 64 + (mts + mi) * 16 + fr; bsv[mi] = c.in[12][(size_t)l * 512 + h * 128 + tt]; const bf16_t* zr = c.Z() + (size_t)(rowc0 + tt) * ZLD;
#pragma unroll
          for (int nt = 0; nt < 4; ++nt) { if constexpr (WHOLE) zu[mi][nt] = zuA[half][mi][nt]; else zu[mi][nt] = *(const u32x2*)(zr + h * 64 + nt * 16 + 4 * fq); }
          if constexpr (WHOLE) bsv[mi] = bsA[half][mi]; }
#pragma unroll
      for (int mi = 0; mi < 2; ++mi) { const int tt = half * 64 + (mts + mi) * 16 + fr; bf16_t* zr = c.Z() + (size_t)(rowc0 + tt) * ZLD;
#pragma unroll
          for (int nt = 0; nt < 4; ++nt) { const int chn = h * 64 + nt * 16 + 4 * fq; float u[4]; unpack4(zu[mi][nt], u); float o[4];
#pragma unroll
              for (int e = 0; e < 4; ++e) o[e] = gelu_t(u[e]) * (acc[mi][nt][e] + bsv[mi]);
              u32x2 p; p.x = pk2(o[0], o[1]); p.y = pk2(o[2], o[3]); *(u32x2*)(zr + 768 + chn) = p; } } }
    }
    __syncthreads();
}
__device__ void gmlp_sample(const Ctx& c, int l, int first, int stride) {
    const int lane = c.lane, h = lane >> 4;
    for (int i = first; i < NSAMP; i += stride) { const int row = NPROMPT + i; bf16_t* zr = c.Z() + (size_t)row * ZLD; float v[4], u[4]; unpack4(*(const u32x2*)(zr + 256 + 4 * lane), v); unpack4(*(const u32x2*)(zr + 4 * lane), u);
        float sum = 0.f;
#pragma unroll
        for (int e = 0; e < 4; ++e) { v[e] = gelu_t(v[e]); sum += v[e]; }
        const float mean = wave_sum(sum) * (1.0f / 256.0f); float q = 0.f;
#pragma unroll
        for (int e = 0; e < 4; ++e) { const float d = v[e] - mean; q += d * d; }
        const float rstd = rsqrtf(wave_sum(q) * (1.0f / 256.0f) + 1e-5f);
        const f32x4 lg = *(const f32x4*)(c.in[9] + l * 256 + 4 * lane), lb = *(const f32x4*)(c.in[10] + l * 256 + 4 * lane);
        const float ws0 = c.in[11][(size_t)l * 65536 + h * 16384], bs0 = c.in[12][(size_t)l * 512 + h * 128]; f32x4 vn; float o[4];
#pragma unroll
        for (int e = 0; e < 4; ++e) { vn[e] = (v[e] - mean) * rstd * lg[e] + lb[e]; o[e] = gelu_t(u[e]) * (ws0 * vn[e] + bs0); }
        *(f32x4*)(c.out + O_CHV + ((size_t)l * NSAMP + i) * 256 + 4 * lane) = vn;
        u32x2 p; p.x = pk2(o[0], o[1]); p.y = pk2(o[2], o[3]); *(u32x2*)(zr + 768 + 4 * lane) = p; }
}


constexpr int CH_W = 0, CH_R = 4096, CH_ARB = 8192, CH_BT = 10240, CH_Y = 14336, CH_P1 = 18432, CH_P2 = 22528, CH_DG = 30720;
__device__ __forceinline__ bf16x8 lds_ld16(const LAS bf16_t* p) { const u32x2 a = *(const LAS u32x2*)p, b = *(const LAS u32x2*)(p + 4); u32x4 r; r.x = a.x; r.y = a.y; r.z = b.x; r.w = b.y; return __builtin_bit_cast(bf16x8, r); }
__device__ __forceinline__ u32x2 pk4(f32x4 v) { u32x2 p; p.x = pk2(v[0], v[1]); p.y = pk2(v[2], v[3]); return p; }
__device__ __forceinline__ bf16x8 pk8(f32x4 a, f32x4 b) { const u32x2 x = pk4(a), y = pk4(b); u32x4 r; r.x = x.x; r.y = x.y; r.z = y.x; r.w = y.y; return __builtin_bit_cast(bf16x8, r); }
#define LDSW() asm volatile("s_waitcnt lgkmcnt(0)" ::: "memory")
typedef short s16x4 __attribute__((ext_vector_type(4)));
__device__ __forceinline__ bf16x8 tr_frag(const LAS bf16_t* buf, int rb0, int rb1, int c, int lane) {
    const int q = (lane & 15) >> 2, p = lane & 3;
    const s16x4 lo = __builtin_amdgcn_ds_read_tr16_b64_v4i16((LAS s16x4*)(buf + (rb0 + q) * 68 + 16 * c + 4 * p));
    const s16x4 hi = __builtin_amdgcn_ds_read_tr16_b64_v4i16((LAS s16x4*)(buf + (rb1 + q) * 68 + 16 * c + 4 * p));
    return __builtin_shufflevector(lo, hi, 0, 1, 2, 3, 4, 5, 6, 7);
}
__device__ void d1_chunk(const Ctx& c, int blk, int h) {
    const int lane = c.lane, fr = lane & 15, fq = lane >> 4;
    const int b = blk >> 6, ck = blk & 63, row0 = blk * 32;
    unsigned char* chp = c.CH() + (size_t)((b * 4 + h) * 64 + ck) * CHS;
    LAS unsigned char* lw = c.lds + c.w * 17408;
    LAS bf16_t* AT = (LAS bf16_t*)lw; LAS bf16_t* BT_ = AT + 32 * 68; LAS bf16_t* KT_ = BT_ + 32 * 68; LAS bf16_t* RT_ = KT_ + 32 * 68;
    const bf16_t* tok = c.TOK() + (size_t)row0 * 1536 + h * 64 + lane;
    float z0_ = 0.f; asm volatile("" : "+v"(z0_)); const f32x4 zero = {z0_, z0_, z0_, z0_};
    float GT;
    LDSW();
    { float G = 0.f;
#pragma unroll 1
      for (int t0 = 0; t0 < 32; t0 += 16) { unsigned raw[16][5];
#pragma unroll
          for (int u = 0; u < 16; ++u) { const bf16_t* q = tok + (size_t)(t0 + u) * 1536; raw[u][0] = q[0]; raw[u][1] = q[256]; raw[u][2] = q[768]; raw[u][3] = q[1024]; raw[u][4] = q[1280]; }
#pragma unroll
          for (int u = 0; u < 16; ++u) { const int t = t0 + u; const float ld = __uint_as_float(raw[u][4] << 16); const float Gm = G; G += ld;
              const float r = __uint_as_float(raw[u][0] << 16), km = __uint_as_float(raw[u][1] << 16), a = -__uint_as_float(raw[u][2] << 16), bv = __uint_as_float(raw[u][3] << 16); const float eG = __expf(G), ie = __expf(-G), eGm = __expf(Gm);
              AT[t * 68 + lane] = f2bf(a * eGm); BT_[t * 68 + lane] = f2bf(bv * ie); KT_[t * 68 + lane] = f2bf(km * ie); RT_[t * 68 + lane] = f2bf(r * eG); }
          asm volatile("" ::: "memory"); }
      GT = G; }
    LDSW();
    f32x4 acc[2][2][2][2];
#pragma unroll
    for (int i = 0; i < 16; ++i) acc[i >> 3][(i >> 2) & 1][(i >> 1) & 1][i & 1] = zero;
#pragma unroll
    for (int ks = 0; ks < 2; ++ks) { bf16x8 af[2][2], bf[2][2];
#pragma unroll
        for (int m = 0; m < 2; ++m) { const int o = (m * 16 + fr) * 68 + ks * 32 + fq * 8; af[0][m] = lds_ld16(BT_ + o); af[1][m] = lds_ld16(KT_ + o); bf[0][m] = lds_ld16(AT + o); bf[1][m] = lds_ld16(RT_ + o); }
#pragma unroll
        for (int i = 0; i < 16; ++i) { const int as = i >> 3, bs = (i >> 2) & 1, mt = (i >> 1) & 1, nt = i & 1; acc[as][bs][mt][nt] = mfma16(af[as][mt], bf[bs][nt], acc[as][bs][mt][nt]); } }
#pragma unroll
    for (int nt = 0; nt < 2; ++nt)
#pragma unroll
        for (int ks = 0; ks < 2; ++ks) { const int t = 16 * nt + fr; const u32x2 lo = *(const LAS u32x2*)(RT_ + t * 68 + 32 * ks + 4 * fq), hi = *(const LAS u32x2*)(RT_ + t * 68 + 32 * ks + 16 + 4 * fq);
            u32x4 v; v.x = lo.x; v.y = lo.y; v.z = hi.x; v.w = hi.y; *(u32x4*)((bf16_t*)(chp + CH_R) + t * 64 + (((ks * 4 + fq) ^ (fr & 7)) * 8)) = v; }
    LDSW();
    bf16x8 aT[4], kT[4], bTp[4];
#pragma unroll
    for (int mt = 0; mt < 4; ++mt) { aT[mt] = tr_frag(AT, 8 * fq, 8 * fq + 4, mt, lane); kT[mt] = tr_frag(KT_, 8 * fq, 8 * fq + 4, mt, lane); bTp[mt] = tr_frag(BT_, 4 * fq, 16 + 4 * fq, mt, lane); }
    LDSW();
    LAS float* L = (LAS float*)lw; LAS bf16_t* AAK = (LAS bf16_t*)(lw + 4608); LAS bf16_t* ARK = (LAS bf16_t*)(lw + 7168); LAS bf16_t* TINV = (LAS bf16_t*)(lw + 9728);
    LAS float* DGL = (LAS float*)(lw + 12288); LAS bf16_t* VR = RT_;
    DGL[lane] = __expf(GT);
    {
#pragma unroll 1
      for (int t0 = 0; t0 < 32; t0 += 16) { unsigned rv[16];
#pragma unroll
          for (int u = 0; u < 16; ++u) rv[u] = tok[(size_t)(t0 + u) * 1536 + 512];
#pragma unroll
          for (int u = 0; u < 16; ++u) VR[(t0 + u) * 68 + lane] = (bf16_t)rv[u];
          asm volatile("" ::: "memory"); } }
#pragma unroll
    for (int nt = 0; nt < 2; ++nt) { const int t = 16 * nt + fr;
#pragma unroll
        for (int mt = 0; mt < 2; ++mt) { const int s0 = 16 * mt + 4 * fq; f32x4 v = acc[0][0][mt][nt], k = acc[1][0][mt][nt], q = acc[1][1][mt][nt];
#pragma unroll
            for (int e = 0; e < 4; ++e) { if (!(s0 + e < t)) { v[e] = z0_; k[e] = z0_; } if (!(s0 + e <= t)) q[e] = z0_; }
            *(LAS f32x4*)(L + t * 36 + s0) = v; *(LAS u32x2*)(AAK + t * 40 + s0) = pk4(k); *(LAS u32x2*)(ARK + t * 40 + s0) = pk4(q); }
        f32x4 v0 = acc[0][1][0][nt], v1 = acc[0][1][1][nt];
#pragma unroll
        for (int e = 0; e < 4; ++e) { if (!(4 * fq + e <= t)) v0[e] = z0_; if (!(16 + 4 * fq + e <= t)) v1[e] = z0_; }
        const u32x2 a = pk4(v0), bb = pk4(v1); u32x4 w; w.x = a.x; w.y = a.y; w.z = bb.x; w.w = bb.y; *(u32x4*)((bf16_t*)(chp + CH_ARB) + t * 32 + ((fq ^ ((fr >> 2) & 3)) * 8)) = w; }
    LDSW();
    bf16x8 vT[4];
#pragma unroll
    for (int nt = 0; nt < 4; ++nt) vT[nt] = tr_frag(VR, 8 * fq, 8 * fq + 4, nt, lane);
#pragma unroll
    for (int mt = 0; mt < 4; ++mt) { const f32x4 dg4 = *(const LAS f32x4*)(DGL + 16 * mt + 4 * fq);
#pragma unroll
        for (int nt = 0; nt < 4; ++nt) { const f32x4 p = mfma16(kT[mt], vT[nt], zero) * dg4; *(u32x2*)(chp + CH_P2 + ((nt * 4 + mt) * 64 + lane) * 8) = pk4(p); }
        const int chn = 16 * mt + fr; const float dgs = DGL[chn]; float z[8]; unpack8(__builtin_bit_cast(u32x4, bTp[mt]), z);
#pragma unroll
        for (int e = 0; e < 8; ++e) z[e] *= dgs;
        *(bf16x8*)((bf16_t*)(chp + CH_BT) + chn * 32 + ((fq ^ ((fr >> 2) & 3)) * 8)) = pack8(z); }
#pragma unroll
    for (int nt = 0; nt < 4; ++nt)
#pragma unroll
        for (int mt = 0; mt < 2; ++mt) { const f32x4 p = mfma16(*(const LAS bf16x8*)(ARK + (mt * 16 + fr) * 40 + fq * 8), vT[nt], zero); *(u32x2*)(chp + CH_P1 + ((nt * 2 + mt) * 64 + lane) * 8) = pk4(p); }
    LDSW();
    { float x[32]; const int j = lane & 31;
#pragma unroll
      for (int t = 0; t < 32; ++t) x[t] = 0.f;
#pragma unroll
      for (int t = 0; t < 32; ++t) { int jj = j; asm volatile("" : "+v"(jj)); float a = (t == jj) ? 1.f : 0.f;
#pragma unroll
          for (int s4 = 0; s4 < (t + 3) / 4; ++s4) { const f32x4 Lr = *(const LAS f32x4*)(L + t * 36 + 4 * s4); a += Lr[0] * x[4 * s4] + Lr[1] * x[4 * s4 + 1] + Lr[2] * x[4 * s4 + 2] + Lr[3] * x[4 * s4 + 3]; }
          asm volatile("" : "+v"(a) :: "memory"); x[t] = a; }
#pragma unroll
      for (int t = 0; t < 32; ++t) TINV[t * 40 + j] = f2bf(x[t]); }
    { f32x4 w[4][2];
#pragma unroll
      for (int mt = 0; mt < 4; ++mt)
#pragma unroll
          for (int nt = 0; nt < 2; ++nt) w[mt][nt] = mfma16(aT[mt], *(const LAS bf16x8*)(TINV + (nt * 16 + fr) * 40 + fq * 8), zero);
#pragma unroll
      for (int nt = 0; nt < 2; ++nt)
#pragma unroll
          for (int ks = 0; ks < 2; ++ks) { const u32x2 a = pk4(w[2 * ks][nt]), bb = pk4(w[2 * ks + 1][nt]); u32x4 v; v.x = a.x; v.y = a.y; v.z = bb.x; v.w = bb.y;
              *(u32x4*)((bf16_t*)(chp + CH_W) + (16 * nt + fr) * 64 + (((ks * 4 + fq) ^ (fr & 7)) * 8)) = v; } }
    { bf16x8 tp[2];
#pragma unroll
      for (int mt = 0; mt < 2; ++mt) { const u32x2 lo = *(const LAS u32x2*)(TINV + (mt * 16 + fr) * 40 + 4 * fq), hi = *(const LAS u32x2*)(TINV + (mt * 16 + fr) * 40 + 16 + 4 * fq); u32x4 v; v.x = lo.x; v.y = lo.y; v.z = hi.x; v.w = hi.y; tp[mt] = __builtin_bit_cast(bf16x8, v); }
#pragma unroll
      for (int nt = 0; nt < 4; ++nt) { f32x4 x[2];
#pragma unroll
          for (int mt = 0; mt < 2; ++mt) x[mt] = mfma16(*(const LAS bf16x8*)(AAK + (mt * 16 + fr) * 40 + fq * 8), vT[nt], zero);
          const bf16x8 xb = pk8(x[0], x[1]);
#pragma unroll
          for (int mt = 0; mt < 2; ++mt) { const f32x4 y = mfma16(tp[mt], xb, zero); *(u32x2*)(chp + CH_Y + ((nt * 2 + mt) * 64 + lane) * 8) = pk4(y);
 } } }
    ((bf16_t*)(chp + CH_DG))[lane] = f2bf(__expf(GT));
    LDSW();
}

__device__ void rwkv_d1(const Ctx& c) {
    asm volatile("s_waitcnt vmcnt(0)" ::: "memory");
    for (int task = c.gw; task < (NPROMPT / 32) * 4; task += c.nw) d1_chunk(c, task >> 2, task & 3);
}

struct D2F { bf16x8 w[2][2], rr[2][2], arb[2], bt[4]; u32x2 y[2], p1[2], p2[4], dg[4]; };
constexpr int D2_SLOT = 19456, D2_NSLOT = 7;
__device__ __forceinline__ void d2_dma(LAS unsigned char* slot, const unsigned char* chp, int slab, int lane) {
    const unsigned char* g = chp + lane * 16;
#pragma unroll
    for (int i = 0; i < 14; ++i) __builtin_amdgcn_global_load_lds((const unsigned*)(g + i * 1024), (LAS unsigned*)(slot + i * 1024), 16, 0, 0);
    __builtin_amdgcn_global_load_lds((const unsigned*)(g + CH_Y + slab * 1024), (LAS unsigned*)(slot + 14336), 16, 0, 0);
    __builtin_amdgcn_global_load_lds((const unsigned*)(g + CH_P1 + slab * 1024), (LAS unsigned*)(slot + 15360), 16, 0, 0);
    __builtin_amdgcn_global_load_lds((const unsigned*)(g + CH_P2 + slab * 2048), (LAS unsigned*)(slot + 16384), 16, 0, 0);
    __builtin_amdgcn_global_load_lds((const unsigned*)(g + CH_P2 + slab * 2048 + 1024), (LAS unsigned*)(slot + 17408), 16, 0, 0);
    __builtin_amdgcn_global_load_lds((const unsigned*)(g + CH_DG), (LAS unsigned*)(slot + 18432), 16, 0, 0);
}
__device__ __forceinline__ void d2_load(D2F& f, const LAS unsigned char* slot, int fr, int fq, int lane) {
    const int x8 = fr & 7, x4 = (fr >> 2) & 3;
#pragma unroll
    for (int mt = 0; mt < 2; ++mt) {
#pragma unroll
        for (int ks = 0; ks < 2; ++ks) { const int o = (16 * mt + fr) * 128 + (((ks * 4 + fq) ^ x8) * 16); f.w[mt][ks] = *(const LAS bf16x8*)(slot + CH_W + o); f.rr[mt][ks] = *(const LAS bf16x8*)(slot + CH_R + o); }
        f.arb[mt] = *(const LAS bf16x8*)(slot + CH_ARB + (16 * mt + fr) * 64 + ((fq ^ x4) * 16));
        f.y[mt] = *(const LAS u32x2*)(slot + 14336 + mt * 512 + lane * 8); f.p1[mt] = *(const LAS u32x2*)(slot + 15360 + mt * 512 + lane * 8); }
#pragma unroll
    for (int mt = 0; mt < 4; ++mt) { f.bt[mt] = *(const LAS bf16x8*)(slot + CH_BT + (16 * mt + fr) * 64 + ((fq ^ x4) * 16));
        f.p2[mt] = *(const LAS u32x2*)(slot + 16384 + mt * 512 + lane * 8); f.dg[mt] = *(const LAS u32x2*)(slot + 18432 + mt * 32 + fq * 8); }
}
__device__ __forceinline__ f32x4 up4(u32x2 u) { return (f32x4){bflo(u.x), bfhi(u.x), bflo(u.y), bfhi(u.y)}; }
__device__ __forceinline__ void d2_step(const D2F& f, f32x4 (&H)[4], float* op, int fq) {
    const bf16x8 hb0 = pk8(H[0], H[1]), hb1 = pk8(H[2], H[3]);
    f32x4 U[2], O[2];
#pragma unroll
    for (int mt = 0; mt < 2; ++mt) { U[mt] = up4(f.y[mt]); U[mt] = mfma16(f.w[mt][0], hb0, U[mt]); U[mt] = mfma16(f.w[mt][1], hb1, U[mt]);
        O[mt] = up4(f.p1[mt]); O[mt] = mfma16(f.rr[mt][0], hb0, O[mt]); O[mt] = mfma16(f.rr[mt][1], hb1, O[mt]); }
    const bf16x8 ub = pk8(U[0], U[1]);
#pragma unroll
    for (int mt = 0; mt < 2; ++mt) { O[mt] = mfma16(f.arb[mt], ub, O[mt]);
#pragma unroll
        for (int r = 0; r < 4; ++r) op[(size_t)(16 * mt + 4 * fq + r) * 256] = O[mt][r]; }
#pragma unroll
    for (int mt = 0; mt < 4; ++mt) { u32x2 p2 = f.p2[mt], dg = f.dg[mt]; asm volatile("" : "+v"(p2.x), "+v"(p2.y), "+v"(dg.x), "+v"(dg.y)); const f32x4 hn = up4(p2) + up4(dg) * H[mt]; H[mt] = mfma16(f.bt[mt], ub, hn); }
}
__device__ void rwkv_d2(const Ctx& c, int l) {
    const int lane = c.lane, fr = lane & 15, fq = lane >> 4, G = gridDim.x;
    if (c.w != 0) return;
    for (int task = blockIdx.x; task < NB * 4 * 4; task += G) {
        const int slab = task & 3, h = (task >> 2) & 3, b = task >> 4;
        const unsigned char* chb = c.CH() + (size_t)((b * 4 + h) * 64) * CHS;
        f32x4 H[4];
#pragma unroll
        for (int mt = 0; mt < 4; ++mt) H[mt] = zero4();
        float* op = c.OO() + (size_t)(b * SEQ) * 256 + h * 64 + slab * 16 + fr;
        asm volatile("s_waitcnt vmcnt(0) lgkmcnt(0)" ::: "memory");
        d2_dma(c.lds, chb, slab, lane); d2_dma(c.lds + D2_SLOT, chb + CHS, slab, lane);
        for (int ck = 0; ck < 64; ++ck) {
            if (ck + 2 < 64) d2_dma(c.lds + ((ck + 2) % D2_NSLOT) * D2_SLOT, chb + (size_t)(ck + 2) * CHS, slab, lane);
            if (ck == 0) asm volatile("s_waitcnt vmcnt(38)" ::: "memory");
            else if (ck == 1) asm volatile("s_waitcnt vmcnt(46)" ::: "memory");
            else if (ck < 62) asm volatile("s_waitcnt vmcnt(54)" ::: "memory");
            else asm volatile("s_waitcnt vmcnt(0)" ::: "memory");
            D2F f; d2_load(f, c.lds + (ck % D2_NSLOT) * D2_SLOT, fr, fq, lane);
            d2_step(f, H, op + (size_t)(ck * 32) * 256, fq);
        }
        float* so = c.out + O_WKVP + (((size_t)(l * NB + b) * 4 + h) * 64 + slab * 16 + fr) * 64;
#pragma unroll
        for (int mt = 0; mt < 4; ++mt) *(f32x4*)(so + 16 * mt + 4 * fq) = H[mt];
    }
}

__device__ void rwkv_scan(const Ctx& c, int l, int first, int stride) {
    const int lane = c.lane;
    for (int task = first; task < NSAMP * 16; task += stride) {
        const int i = task >> 4, h = (task >> 2) & 3, q4 = task & 3, row = NPROMPT + i;
        const bf16_t* tk = c.TOK() + (size_t)row * 1536 + h * 64;
        const float r = bf2f(tk[lane]), km = bf2f(tk[256 + lane]), kk = bf2f(tk[768 + lane]), bv = bf2f(tk[1024 + lane]), d = __expf(bf2f(tk[1280 + lane]));
        const size_t sb = (((size_t)(l * NSAMP + i) * 4 + h) * 64) * 64;
        float S0[16]; unsigned vraw[16];
#pragma unroll
        for (int j = 0; j < 16; ++j) { const int vr = q4 * 16 + j; S0[j] = c.in[2][sb + (size_t)vr * 64 + lane]; vraw[j] = tk[512 + vr]; }
#pragma unroll
        for (int j = 0; j < 16; ++j) { const int vr = q4 * 16 + j; float S = S0[j]; const float vv = __uint_as_float(vraw[j] << 16);
            const float sa = -wave_sum(S * kk); S = S * d + sa * bv + vv * km; const float o = wave_sum(S * r);
            __builtin_nontemporal_store(S, c.out + O_WKVS + sb + (size_t)vr * 64 + lane); if (lane == 0) c.OO()[(size_t)row * 256 + h * 64 + vr] = o; }
    }
}

__device__ void rwkv_final(const Ctx& c, int l) {
    const int lane = c.lane, h = lane >> 4;
    const f32x4 lg = *(const f32x4*)(c.in[34] + l * 256 + 4 * lane), lb = *(const f32x4*)(c.in[35] + l * 256 + 4 * lane);
    for (int row0 = c.gw; row0 < NR; row0 += 9 * c.nw) {
        f32x4 o[9]; u32x2 vv[9], gq[9]; float bon[9];
#pragma unroll
        for (int u = 0; u < 9; ++u) { const int row = (row0 + u * c.nw < NR) ? row0 + u * c.nw : row0; o[u] = *(const f32x4*)(c.OO() + (size_t)row * 256 + 4 * lane);
            vv[u] = *(const u32x2*)(c.TOK() + (size_t)row * 1536 + 512 + 4 * lane); gq[u] = *(const u32x2*)(c.GG() + (size_t)row * 256 + 4 * lane); bon[u] = c.BON()[(size_t)row * 4 + h]; }
#pragma unroll
        for (int u = 0; u < 9; ++u) { const int row = row0 + u * c.nw; if (row < NR) {
            const float m = row16_sum((o[u][0] + o[u][1]) + (o[u][2] + o[u][3])) * (1.0f / 64.0f);
            const f32x4 d = o[u] - m; const float var = row16_sum((d[0] * d[0] + d[1] * d[1]) + (d[2] * d[2] + d[3] * d[3])) * (1.0f / 64.0f);
            const float rstd = rsqrtf(var + 64e-5f);
            float v[4], g[4]; unpack4(vv[u], v); unpack4(gq[u], g);
            float y[4];
#pragma unroll
            for (int e = 0; e < 4; ++e) y[e] = (d[e] * rstd * lg[e] + lb[e] + bon[u] * v[e]) * g[e];
            u32x2 p; p.x = pk2(y[0], y[1]); p.y = pk2(y[2], y[3]); *(u32x2*)(c.Z() + (size_t)row * ZLD + 256 + 4 * lane) = p; } }
    }
}

#define XB_XCNT(j)  (256  + 64 * (j))
#define XB_XSUB(j)  (1280 + 64 * (j))
#define XB_XGEN(j)  (2304 + 64 * (j))
#define XB_TOP      3328
#define XB_TOPGEN   3392
__device__ __forceinline__ unsigned xb_ld(unsigned* p) { return __hip_atomic_load(p, __ATOMIC_RELAXED, __HIP_MEMORY_SCOPE_AGENT); }
__device__ __forceinline__ unsigned xb_add(unsigned* p, unsigned v) { return __hip_atomic_fetch_add(p, v, __ATOMIC_RELAXED, __HIP_MEMORY_SCOPE_AGENT); }
#define XB_SPIN(cond) do { unsigned _sp = 0; while (cond) { __builtin_amdgcn_s_sleep(1); if (++_sp > (1u << 24)) break; } } while (0)
__device__ __forceinline__ void gbar(unsigned* bar, unsigned x, unsigned nloc, unsigned nx, unsigned gen) {
    asm volatile("s_waitcnt vmcnt(0) lgkmcnt(0)" ::: "memory");
    __syncthreads();
    if (threadIdx.x == 0) {
        const unsigned old = xb_add(&bar[XB_XSUB(x)], 1u);
        if (old + 1u == (gen + 1u) * nloc) {
            __builtin_amdgcn_fence(__ATOMIC_RELEASE, "agent");
            asm volatile("s_waitcnt vmcnt(0)" ::: "memory");
            const unsigned og = xb_add(&bar[XB_TOP], 1u);
            const unsigned tg = gen;
            if (og + 1u == (tg + 1u) * nx) xb_add(&bar[XB_TOPGEN], 1u);
            else XB_SPIN(xb_ld(&bar[XB_TOPGEN]) == tg);
            __builtin_amdgcn_fence(__ATOMIC_ACQUIRE, "agent");
            xb_add(&bar[XB_XGEN(x)], 1u);
            asm volatile("s_waitcnt vmcnt(0)" ::: "memory");
        } else {
            XB_SPIN(xb_ld(&bar[XB_XGEN(x)]) == gen);
            __builtin_amdgcn_fence(__ATOMIC_ACQUIRE, "agent");
            asm volatile("s_waitcnt vmcnt(0)" ::: "memory");
        }
    }
    __syncthreads();
}

__global__ void __launch_bounds__(512) hybrid_fwd(Params P) {
    extern __shared__ __attribute__((aligned(16))) unsigned char lds_raw[];
    cg::grid_group grid = cg::this_grid();
    Ctx c;
    c.in = P.in; c.out = P.out; c.ws = P.ws;
    c.lds = (LAS unsigned char*)lds_raw; c.tid = threadIdx.x; c.lane = threadIdx.x & 63; c.w = __builtin_amdgcn_readfirstlane(threadIdx.x >> 6);
    c.gw = blockIdx.x * 8 + c.w; c.nw = gridDim.x * 8;
    const int G = gridDim.x;
    const int wave_id = __builtin_amdgcn_readfirstlane(threadIdx.x >> 6);
#define REFRESH() do { int w_ = wave_id; asm volatile("" : "+s"(w_)); int ln_; asm volatile("v_mbcnt_lo_u32_b32 %0, -1, 0\n\tv_mbcnt_hi_u32_b32 %0, -1, %0" : "=v"(ln_)); int t_ = w_ * 64 + ln_; { unsigned char* w2_ = P.ws; asm volatile("" : "+s"(w2_)); c.ws = w2_; } c.tid = t_; c.lane = t_ & 63; c.w = w_; c.gw = blockIdx.x * 8 + c.w; } while (0)

    unsigned* bar = (unsigned*)(P.ws + W_BAR);
    const unsigned xcc = (unsigned)__builtin_amdgcn_s_getreg((3 << 11) | 20) & 0xFu;
    if (threadIdx.x == 0) xb_add(&bar[XB_XCNT(xcc)], 1u);
    phase0(c);
    grid.sync();
    unsigned nloc = 0, nx = 0;
#pragma unroll
    for (unsigned j = 0; j < 16; ++j) { const unsigned cnt = xb_ld(&bar[XB_XCNT(j)]); nx += cnt > 0u ? 1u : 0u; nloc = (j == xcc) ? cnt : nloc; }
    nloc = __builtin_amdgcn_readfirstlane(nloc); nx = __builtin_amdgcn_readfirstlane(nx);
    if (nloc == 0u) nloc = 1u; if (nx == 0u) nx = 1u;
    unsigned bar_gen = 0;
#define GBAR() do { gbar(bar, xcc, nloc, nx, bar_gen); ++bar_gen; } while (0)
    for (int l = 0; l < NL; ++l) {
        const int buf = l & 1;
        unsigned char* wb = c.WB() + (size_t)buf * WB_SIZE;
        const bf16_t* WinT = (const bf16_t*)(wb + WB_WIN); const bf16_t* WoutT = (const bf16_t*)(wb + WB_WOUT); const bf16_t* WguT = (const bf16_t*)(wb + WB_WGU); const bf16_t* WdnT = (const bf16_t*)(wb + WB_WDN);
        REFRESH();
        { pg8::Gemm g{c.XB(), WinT, NPROMPT, ZLD, 1024, 1024}; pg8::StaticOrder S; S.init(NPROMPT, ZLD, G, blockIdx.x); EpiZ E{c.Z(), c.SSQ() + (size_t)(2 * l) * NR};
          pg8::gemm_phase<EpiZ>(c.lds, g, S, E, c.tid);
          REFRESH(); ThinZ T{c.Z(), c.SSQ() + (size_t)(2 * l) * NR};
          const bool split = (G == 256);
          if (!split) thin_gemm(c.XB() + (size_t)NPROMPT * DM, DM, WinT, 1024, INC / 32, T, c.w, c.lane);
          else if (blockIdx.x >= 128) thin_gemm(c.XB() + (size_t)NPROMPT * DM, DM, WinT, 1024, INC / 32, T, c.w, c.lane, (int)blockIdx.x - 128, 128);
          if (l + 1 < NL) { REFRESH(); if (!split) convert_weights(c, l + 1, buf ^ 1, 0); else if (blockIdx.x >= 128) convert_weights(c, l + 1, buf ^ 1, 0, (int)blockIdx.x - 128, 128); } }
        GBAR();
        REFRESH();
        conv_phase(c, l);
        REFRESH();
        for (int tile = blockIdx.x; tile < 256; tile += G) ssm_tile<false>(c, l, tile);
        REFRESH();
        rwkv_tok(c, l, buf);
        REFRESH();
        __syncthreads();
        rwkv_d1(c);
        if (G != 256) { REFRESH(); shift_out(c, l, (int)blockIdx.x * 512 + c.tid, G * 512); }
        GBAR();
        REFRESH();
        for (int tile = blockIdx.x; tile < 256; tile += G) { ssm_tile<true>(c, l, tile); __syncthreads(); ssm_glu(c, l, buf, tile); __syncthreads(); }
        { const int sb = (G >= 160) ? 128 : 0;
          for (int q = (int)blockIdx.x - sb; q >= 0 && q < 4; q += G) { const int tile = 256 + (q >> 1), hf = q & 1; ssm_tile<true>(c, l, tile, hf, hf + 1); __syncthreads(); ssm_glu(c, l, buf, tile, 2 * hf, 2 * hf + 2); __syncthreads(); } }
        if (G == 256) {
            if (blockIdx.x >= 128) { REFRESH(); gmlp_tile<true>(c, l, buf, (int)blockIdx.x - 128); }
            else { REFRESH();
                if (c.w == 0) rwkv_d2(c, l);
                else { if (c.w == 1) gmlp_sample(c, l, (int)blockIdx.x, 128); rwkv_scan(c, l, (int)blockIdx.x * 7 + c.w - 1, 128 * 7); shift_out(c, l, (int)blockIdx.x * 448 + c.tid - 64, 128 * 448); } }
        } else {
            REFRESH();
            for (int tile = blockIdx.x; tile < 256; tile += G) gmlp_tile<false>(c, l, buf, tile);
            REFRESH();
            gmlp_sample(c, l, c.gw, c.nw);
            REFRESH();
            rwkv_scan(c, l, c.gw, c.nw);
            REFRESH();
            rwkv_d2(c, l);
        }
        GBAR();
        REFRESH();
        rwkv_final(c, l);
        GBAR();
        REFRESH();
        { pg8::Gemm g{c.Z() + MIXOFF, WoutT, NPROMPT, 1024, 1024, ZLD}; pg8::StaticOrder S; S.init(NPROMPT, 1024, G, blockIdx.x); EpiRes E{c.XB(), c.SSQ() + (size_t)(2 * l + 1) * NR};
          pg8::gemm_phase<EpiRes>(c.lds, g, S, E, c.tid);
          REFRESH(); ThinRes T{c.XB(), c.SSQ() + (size_t)(2 * l + 1) * NR}; thin_gemm_sk<4>(c.lds, c.Z() + MIXOFF + (size_t)NPROMPT * ZLD, ZLD, WoutT, 1024, 32, T, c.w, c.lane); }
        GBAR();
        REFRESH();
        { pg8::Gemm g{c.XB(), WguT, NPROMPT, 5632, 1024, 1024}; pg8::StaticOrder S; S.init(NPROMPT, 5632, G, blockIdx.x); EpiAct E{c.ACT(), c.SSQ() + (size_t)(2 * l + 1) * NR};
          pg8::gemm_phase<EpiAct>(c.lds, g, S, E, c.tid);
          REFRESH(); ThinAct T{c.ACT(), c.SSQ() + (size_t)(2 * l + 1) * NR}; if (G != 256) thin_gemm(c.XB() + (size_t)NPROMPT * DM, DM, WguT, 1024, DFF / 16, T, c.w, c.lane); else if (blockIdx.x >= 128) thin_gemm(c.XB() + (size_t)NPROMPT * DM, DM, WguT, 1024, DFF / 16, T, c.w, c.lane, (int)blockIdx.x - 128, 128);
          if (l + 1 < NL) { REFRESH(); if (G != 256) convert_weights(c, l + 1, buf ^ 1, 1); else if (blockIdx.x >= 128) convert_weights(c, l + 1, buf ^ 1, 1, (int)blockIdx.x - 128, 128); } }
        GBAR();
        REFRESH();
        { pg8::Gemm g{c.ACT(), WdnT, NPROMPT, 1024, DFF, DFF}; pg8::StaticOrder S; S.init(NPROMPT, 1024, G, blockIdx.x); EpiRes E{c.XB(), c.SSQ() + (size_t)(2 * l + 2) * NR};
          pg8::gemm_phase<EpiRes>(c.lds, g, S, E, c.tid);
          REFRESH(); ThinRes T{c.XB(), c.SSQ() + (size_t)(2 * l + 2) * NR}; thin_gemm_sk<11>(c.lds, c.ACT() + (size_t)NPROMPT * DFF, DFF, WdnT, DFF, 32, T, c.w, c.lane); }
        GBAR();
    }
    REFRESH();
    { f32x4 gn[4];
#pragma unroll
      for (int j = 0; j < 4; ++j) gn[j] = *(const f32x4*)(c.in[40] + j * 256 + c.lane * 4);
      for (int row0 = c.gw; row0 < NR; row0 += 5 * c.nw) { u32x2 xv[5][4]; unsigned long long sq[5];
#pragma unroll
          for (int u = 0; u < 5; ++u) { const int row = (row0 + u * c.nw < NR) ? row0 + u * c.nw : row0; sq[u] = c.SSQ()[(size_t)8 * NR + row];
#pragma unroll
              for (int j = 0; j < 4; ++j) xv[u][j] = *(const u32x2*)(c.XB() + (size_t)row * DM + j * 256 + c.lane * 4); }
#pragma unroll
          for (int u = 0; u < 5; ++u) { const int row = row0 + u * c.nw; if (row < NR) { const float rs = rsqrtf((float)sq[u] * (1.0f / (SSQ_SCALE * 1024.0f)) + 1e-6f);
#pragma unroll
              for (int j = 0; j < 4; ++j) { float v[4]; unpack4(xv[u][j], v); __builtin_nontemporal_store((f32x4){v[0] * rs * gn[j][0], v[1] * rs * gn[j][1], v[2] * rs * gn[j][2], v[3] * rs * gn[j][3]}, (f32x4*)(c.out + (size_t)row * DM + j * 256 + c.lane * 4)); } } } } }
}

extern "C" void kernel_launch(void* const* d_in, const int* in_sizes, int n_in, void* d_out, int out_size, void* d_ws, size_t ws_size, hipStream_t stream) {
    static int grid_blocks = 0;
    if (!grid_blocks) {
        int dev = 0, cus = 0, per_cu = 0;
        hipGetDevice(&dev);
        hipDeviceGetAttribute(&cus, hipDeviceAttributeMultiprocessorCount, dev);
        hipFuncSetAttribute((const void*)hybrid_fwd, hipFuncAttributeMaxDynamicSharedMemorySize, LDS_BYTES);
        hipOccupancyMaxActiveBlocksPerMultiprocessor(&per_cu, (const void*)hybrid_fwd, 512, LDS_BYTES);
        if (per_cu < 1) per_cu = 1;
        grid_blocks = cus * per_cu;
        if (n_in != 41 || (size_t)out_size != O_END || ws_size < W_END) fprintf(stderr, "kernel_launch: unexpected sizes n_in %d out %d ws %zu\n", n_in, out_size, ws_size);
    }
    hipMemsetAsync((char*)d_ws + W_BAR, 0, 16384, stream);
    Params p{};
    for (int i = 0; i < 41; ++i) p.in[i] = (const float*)d_in[i];
    p.out = (float*)d_out; p.ws = (unsigned char*)d_ws;
    void* args[] = {&p};
    hipError_t e = hipLaunchCooperativeKernel((const void*)hybrid_fwd, dim3(grid_blocks), dim3(512), args, LDS_BYTES, stream);
    if (e != hipSuccess) fprintf(stderr, "cooperative launch failed: %s (grid %d)\n", hipGetErrorString(e), grid_blocks);
}
```

```cpp
#include <hip/hip_runtime.h>
#include <hip/hip_cooperative_groups.h>
#include <cstdio>
namespace cg = cooperative_groups;

#define LAS __attribute__((address_space(3)))
typedef unsigned short bf16_t;
typedef short bf16x8 __attribute__((ext_vector_type(8)));
typedef float f32x4 __attribute__((ext_vector_type(4)));
typedef float f32x2 __attribute__((ext_vector_type(2)));
typedef unsigned u32x4 __attribute__((ext_vector_type(4)));
typedef unsigned u32x2 __attribute__((ext_vector_type(2)));

constexpr int DM = 1024, NPROMPT = 16384, NSAMP = 128, NR = NPROMPT + NSAMP, SEQ = 2048, NB = 8, NL = 4;
constexpr int ZLD = 2560, INC = 2432, DFF = 2816, DTM = 896;
constexpr int MIXOFF = 256;
constexpr size_t O_Y = 0;
constexpr size_t O_WKVP = (size_t)NR * DM;
constexpr size_t O_WKVS = O_WKVP + (size_t)NL * NB * 4 * 64 * 64;
constexpr size_t O_SHP = O_WKVS + (size_t)NL * NSAMP * 4 * 64 * 64;
constexpr size_t O_SHS = O_SHP + (size_t)NL * NB * DTM;
constexpr size_t O_REP = O_SHS + (size_t)NL * NSAMP * DTM;
constexpr size_t O_RES = O_REP + (size_t)NL * NB * 1024;
constexpr size_t O_IMP = O_RES + (size_t)NL * NSAMP * 1024;
constexpr size_t O_IMS = O_IMP + (size_t)NL * NB * 1024;
constexpr size_t O_CVP = O_IMS + (size_t)NL * NSAMP * 1024;
constexpr size_t O_CVS = O_CVP + (size_t)NL * NB * 512;
constexpr size_t O_CHV = O_CVS + (size_t)NL * NSAMP * 512;
constexpr size_t O_END = O_CHV + (size_t)NL * NSAMP * 256;
static_assert(O_END == 27832320, "output size");
constexpr size_t W_XB = 0;
constexpr int CHS = 31232;
constexpr size_t W_ZA = W_XB + (size_t)NR * DM * 2;
constexpr size_t W_WB = W_ZA + (size_t)NR * DFF * 2;
constexpr size_t WB_WIN = 0, WB_WOUT = WB_WIN + (size_t)ZLD * 1024 * 2, WB_WGU = WB_WOUT + (size_t)1024 * 1024 * 2, WB_WDN = WB_WGU + (size_t)5632 * 1024 * 2,
                 WB_GLU = WB_WDN + (size_t)1024 * DFF * 2, WB_LORA = WB_GLU + 256 * 256 * 2, WB_WSB = WB_LORA + 256 * 128 * 2, WB_SIZE = WB_WSB + 4 * 128 * 128 * 2;
constexpr size_t W_TOK = W_WB + 2 * WB_SIZE;
constexpr size_t W_GG = W_TOK + (size_t)NR * 1536 * 2;
constexpr size_t W_OO = W_GG + (size_t)NR * 256 * 2;
constexpr size_t W_BON = W_OO + (size_t)NR * 256 * 4;
constexpr size_t W_SSQ = W_BON + (size_t)NR * 4 * 4;
constexpr size_t W_EE = W_SSQ + (size_t)9 * NR * 8;
constexpr size_t W_LBC = W_EE + (size_t)NB * 32 * 16 * 64 * 2 * 4;
constexpr size_t W_BBAR = W_LBC + (size_t)NL * 1024 * 8;
constexpr size_t W_BAR = W_BBAR + (size_t)NL * 16 * 128 * 16 * 2;
constexpr size_t W_END = W_BAR + 16384;
static_assert(W_END <= 268435456, "workspace");
static_assert((size_t)NB * 4 * 64 * CHS <= (size_t)NR * DM * 4, "chunk data lives in the y region of d_out until the final norm overwrites it");
static_assert(W_ZA % 256 == 0 && W_WB % 256 == 0 && W_TOK % 256 == 0 && W_GG % 256 == 0 && W_OO % 256 == 0 && W_BON % 256 == 0 && W_SSQ % 256 == 0 && W_EE % 256 == 0 && WB_SIZE % 256 == 0, "align");
constexpr int LDS_BYTES = 139264;

struct Params { const float* in[41]; float* out; unsigned char* ws; };

struct Ctx {
    const float* const* in; float* out; unsigned char* ws;
    LAS unsigned char* lds; int tid, lane, w, gw, nw;
    __device__ __forceinline__ float* X() const { return out; }
    __device__ __forceinline__ bf16_t* XB() const { return (bf16_t*)(ws + W_XB); }
    __device__ __forceinline__ bf16_t* Z() const { return (bf16_t*)(ws + W_ZA); }
    __device__ __forceinline__ bf16_t* ACT() const { return (bf16_t*)(ws + W_ZA); }
    __device__ __forceinline__ unsigned char* WB() const { return ws + W_WB; }
    __device__ __forceinline__ bf16_t* TOK() const { return (bf16_t*)(ws + W_TOK); }
    __device__ __forceinline__ bf16_t* GG() const { return (bf16_t*)(ws + W_GG); }
    __device__ __forceinline__ float* OO() const { return (float*)(ws + W_OO); }
    __device__ __forceinline__ float* BON() const { return (float*)(ws + W_BON); }
    __device__ __forceinline__ unsigned long long* SSQ() const { return (unsigned long long*)(ws + W_SSQ); }
    __device__ __forceinline__ float* EE() const { return (float*)(ws + W_EE); }
    __device__ __forceinline__ unsigned char* CH() const { return (unsigned char*)out; }
    __device__ __forceinline__ float* LBC() const { return (float*)(ws + W_LBC); }
    __device__ __forceinline__ bf16_t* BBAR() const { return (bf16_t*)(ws + W_BBAR); }
};

__device__ __forceinline__ float bf2f(bf16_t b) { return __uint_as_float(((unsigned)b) << 16); }
__device__ __forceinline__ float bflo(unsigned u) { return __uint_as_float(u << 16); }
__device__ __forceinline__ float bfhi(unsigned u) { return __uint_as_float(u & 0xffff0000u); }
typedef __bf16 bf16v2 __attribute__((ext_vector_type(2)));
__device__ __forceinline__ unsigned pk2(float lo, float hi) { const f32x2 v = {lo, hi}; const bf16v2 b = __builtin_convertvector(v, bf16v2); return __builtin_bit_cast(unsigned, b); }
__device__ __forceinline__ bf16_t f2bf(float f) { return (bf16_t)(pk2(f, 0.f) & 0xffffu); }
constexpr float SSQ_SCALE = 16777216.0f;
__device__ __forceinline__ float ssq_rs(const unsigned long long* p, int row) { return rsqrtf((float)p[row] * (1.0f / (SSQ_SCALE * 1024.0f)) + 1e-6f); }
__device__ __forceinline__ void ssq_add(unsigned long long* p, int row, float s) { atomicAdd(p + row, (unsigned long long)(s * SSQ_SCALE + 0.5f)); }
__device__ __forceinline__ float sigmoidf_(float x) { return 1.0f / (1.0f + __expf(-x)); }
__device__ __forceinline__ float gelu_t(float x) { const float y = 0.7978845608028654f * (x + 0.044715f * x * x * x); return x * sigmoidf_(2.0f * y); }
__device__ __forceinline__ float tanh_(float x) { return 1.0f - 2.0f / (__expf(2.0f * x) + 1.0f); }
template <int CTRL> __device__ __forceinline__ float dpp_mov(float v) { return __builtin_bit_cast(float, __builtin_amdgcn_update_dpp(0, __builtin_bit_cast(int, v), CTRL, 0xf, 0xf, true)); }
__device__ __forceinline__ float row16_sum(float v) { v += dpp_mov<0xB1>(v); v += dpp_mov<0x4E>(v); v += dpp_mov<0x141>(v); v += dpp_mov<0x140>(v); return v; }
__device__ __forceinline__ float wave_sum(float v) {
    v = row16_sum(v); const int b = __builtin_bit_cast(int, v);
    const float a0 = __builtin_bit_cast(float, __builtin_amdgcn_readlane(b, 0)), a1 = __builtin_bit_cast(float, __builtin_amdgcn_readlane(b, 16));
    const float a2 = __builtin_bit_cast(float, __builtin_amdgcn_readlane(b, 32)), a3 = __builtin_bit_cast(float, __builtin_amdgcn_readlane(b, 48));
    return (a0 + a1) + (a2 + a3);
}
__device__ __forceinline__ f32x4 zero4() { float z = 0.f; asm volatile("" : "+v"(z)); return (f32x4){z, z, z, z}; }
__device__ __forceinline__ f32x4 mfma16(bf16x8 a, bf16x8 b, f32x4 c) { return __builtin_amdgcn_mfma_f32_16x16x32_bf16(a, b, c, 0, 0, 0); }
__device__ __forceinline__ bf16x8 pack8(const float* z) { u32x4 u; u.x = pk2(z[0], z[1]); u.y = pk2(z[2], z[3]); u.z = pk2(z[4], z[5]); u.w = pk2(z[6], z[7]); return __builtin_bit_cast(bf16x8, u); }
__device__ __forceinline__ void unpack4(u32x2 u, float* z) { z[0] = bflo(u.x); z[1] = bfhi(u.x); z[2] = bflo(u.y); z[3] = bfhi(u.y); }
__device__ __forceinline__ void unpack8(u32x4 u, float* z) { z[0] = bflo(u.x); z[1] = bfhi(u.x); z[2] = bflo(u.y); z[3] = bfhi(u.y); z[4] = bflo(u.z); z[5] = bfhi(u.z); z[6] = bflo(u.w); z[7] = bfhi(u.w); }

namespace pg8 {
constexpr int BM = 256, BK = 64, HALF = 128, HTB = HALF * BK * 2, STAGE_BYTES = 8 * HTB, NXCD = 8, WGM = 8;
__device__ __forceinline__ int lds_byte(int r, int c) { const int st = (r >> 4) * 2 + (c >> 5), rr = r & 15, cc = c & 31, ob = rr * 64 + cc * 2; return st * 1024 + (ob ^ (((ob >> 9) & 1) << 5)); }
__device__ __forceinline__ void stage_rc(int b, int& R, int& C) { const int st = b / 1024, sb = b % 1024, swz = sb ^ (((sb >> 9) & 1) << 5); R = (st >> 1) * 16 + swz / 64; C = (st & 1) * 32 + (swz % 64) / 2; }
__device__ __forceinline__ int perm32(int rho) { const int n = rho >> 4, i = rho & 15; return 8 * (i >> 2) + 4 * n + (i & 3); }
struct Unit { int pm, pn; };
struct Gemm { const bf16_t* A; const bf16_t* Bt; int M, N, K, lda; };
struct StaticOrder {
    int nM, nN, nwg, G, c;
    __device__ void init(int M, int N, int G_, int c_) { nM = M / BM; nN = N / BM; nwg = nM * nN; G = G_; c = c_; }
    __device__ bool next(int i, Unit& u) const {
        const long L = (long)i * G + c; if (L >= nwg) return false;
        int wgid = (int)L; { const int q = nwg / NXCD, r = nwg % NXCD, xcd = wgid % NXCD, off = wgid / NXCD; wgid = (xcd < r ? xcd * (q + 1) : r * (q + 1) + (xcd - r) * q) + off; }
        const int nig = WGM * nN, gid = wgid / nig, fm = gid * WGM, gsz = (nM - fm) < WGM ? (nM - fm) : WGM;
        u.pm = fm + ((wgid % nig) % gsz); u.pn = (wgid % nig) / gsz; return true;
    }
};

template <class Epi>
__device__ __forceinline__ void gemm_phase(LAS unsigned char* lds, const Gemm g, const StaticOrder& S, const Epi& E, const int tid) {
    const int wid = __builtin_amdgcn_readfirstlane(tid >> 6), lane = tid & 63, wr = wid >> 2, wc = wid & 3, fr = lane & 15, fq = lane >> 4;
    const int K = g.K, nt = K / BK;
    unsigned voffA[2], voffB[2];
#pragma unroll
    for (int i = 0; i < 2; ++i) { int R, C; stage_rc(tid * 16 + i * 8192, R, C); const int Rb = Epi::PERM ? ((R & ~31) + perm32(R & 31)) : R;
        voffA[i] = (unsigned)(R * g.lda + C) * 2u; voffB[i] = (unsigned)(Rb * K + C) * 2u; }
    const size_t kstep = (size_t)(BK * 2);
    const size_t hstepA = (size_t)HALF * g.lda * 2, hstepB = (size_t)HALF * K * 2;
    const size_t tstepA = 2 * hstepA, tstepB = 2 * hstepB;
    const unsigned ldsw = (unsigned)wid * 1024u;
    const int aoff = lds_byte(wr * 64 + fr, fq * 8), boff = lds_byte(wc * 32 + fr, fq * 8);
#define PG8_SA(b, h) (((b) * 2 + (h)) * HTB)
#define PG8_SB(b, h) ((4 + (b) * 2 + (h)) * HTB)
#define PG8_STAGE(bufoff, gbase, voff) do { _Pragma("unroll") for (int _i = 0; _i < 2; ++_i) \
        __builtin_amdgcn_global_load_lds((const unsigned*)((const char*)(gbase) + (voff)[_i]), (LAS unsigned*)(lds + (bufoff) + ldsw + _i * 8192), 16, 0, 0); } while (0)
#define PG8_LDA(dst, b, h) do { _Pragma("unroll") for (int m = 0; m < 4; ++m) _Pragma("unroll") for (int k = 0; k < 2; ++k) dst[m][k] = *(const LAS bf16x8*)(lds + PG8_SA(b, h) + aoff + m * 2048 + k * 1024); } while (0)
#define PG8_LDB(dst, b, h) do { _Pragma("unroll") for (int n = 0; n < 2; ++n) _Pragma("unroll") for (int k = 0; k < 2; ++k) dst[n][k] = *(const LAS bf16x8*)(lds + PG8_SB(b, h) + boff + n * 2048 + k * 1024); } while (0)
#define PG8_MMA(ai, bj, At, Bt) do { __builtin_amdgcn_s_setprio(1); _Pragma("unroll") for (int m = 0; m < 4; ++m) _Pragma("unroll") for (int n = 0; n < 2; ++n) _Pragma("unroll") for (int k = 0; k < 2; ++k) \
        acc[ai][bj][m][n] = __builtin_amdgcn_mfma_f32_16x16x32_bf16(Bt[n][k], At[m][k], acc[ai][bj][m][n], 0, 0, 0); __builtin_amdgcn_s_setprio(0); } while (0)
#define PG8_WAIT_V(n) asm volatile("s_waitcnt vmcnt(" #n ")" ::: "memory")
#define PG8_WAIT_L(n) asm volatile("s_waitcnt lgkmcnt(" #n ")" ::: "memory")
#define PG8_BAR __builtin_amdgcn_s_barrier()
#define PG8_SCHED __builtin_amdgcn_sched_barrier(0)
    Unit cur, nxt; int ui = 0;
    if (!S.next(0, cur)) return;
    f32x4 acc[2][2][4][2];
#pragma unroll
    for (int a = 0; a < 2; ++a)
#pragma unroll
        for (int b = 0; b < 2; ++b)
#pragma unroll
            for (int m = 0; m < 4; ++m)
#pragma unroll
                for (int n = 0; n < 2; ++n) acc[a][b][m][n] = zero4();
    bf16x8 At[4][2], B0[2][2], B1[2][2];
    const char* cA = (const char*)g.A + (size_t)cur.pm * tstepA; const char* cB = (const char*)g.Bt + (size_t)cur.pn * tstepB;
    PG8_STAGE(PG8_SB(0, 0), cB, voffB); PG8_STAGE(PG8_SA(0, 0), cA, voffA); PG8_STAGE(PG8_SB(0, 1), cB + hstepB, voffB); PG8_STAGE(PG8_SA(0, 1), cA + hstepA, voffA);
    if (wr == 1) PG8_BAR;
    PG8_WAIT_V(4); PG8_BAR;
    PG8_STAGE(PG8_SB(1, 0), cB + kstep, voffB); PG8_STAGE(PG8_SA(1, 0), cA + kstep, voffA); PG8_STAGE(PG8_SB(1, 1), cB + hstepB + kstep, voffB);
    PG8_WAIT_V(6); PG8_BAR;
    for (;;) {
        const bool has_next = S.next(ui + 1, nxt);
        const char* nA = has_next ? (const char*)g.A + (size_t)nxt.pm * tstepA : cA; const char* nB = has_next ? (const char*)g.Bt + (size_t)nxt.pn * tstepB : cB;
        for (int t = 0; t < nt; t += 2) {
            const bool last = (t == nt - 2);
            const char* a1 = cA + (size_t)(t + 1) * kstep;
            const char* a2 = last ? nA : cA + (size_t)(t + 2) * kstep; const char* b2 = last ? nB : cB + (size_t)(t + 2) * kstep;
            const char* a3 = a2 + kstep; const char* b3 = b2 + kstep;
            PG8_LDB(B0, 0, 0); PG8_SCHED; PG8_LDA(At, 0, 0); PG8_STAGE(PG8_SA(1, 1), a1 + hstepA, voffA);
            PG8_WAIT_L(8); PG8_BAR; PG8_WAIT_L(0); PG8_MMA(0, 0, At, B0); PG8_BAR; PG8_SCHED;
            PG8_LDB(B1, 0, 1); PG8_STAGE(PG8_SB(0, 0), b2, voffB);
            PG8_BAR; PG8_WAIT_L(0); PG8_MMA(0, 1, At, B1); PG8_BAR;
            PG8_LDA(At, 0, 1); PG8_STAGE(PG8_SA(0, 0), a2, voffA);
            PG8_BAR; PG8_WAIT_L(0); PG8_MMA(1, 0, At, B0); PG8_BAR; PG8_SCHED;
            PG8_STAGE(PG8_SB(0, 1), b2 + hstepB, voffB);
            PG8_WAIT_V(6); PG8_BAR; PG8_MMA(1, 1, At, B1); PG8_BAR;
            PG8_LDB(B0, 1, 0); PG8_SCHED; PG8_LDA(At, 1, 0); PG8_STAGE(PG8_SA(0, 1), a2 + hstepA, voffA);
            PG8_WAIT_L(8); PG8_BAR; PG8_WAIT_L(0); PG8_MMA(0, 0, At, B0); PG8_BAR; PG8_SCHED;
            PG8_LDB(B1, 1, 1); PG8_STAGE(PG8_SB(1, 0), b3, voffB);
            PG8_BAR; PG8_WAIT_L(0); PG8_MMA(0, 1, At, B1); PG8_BAR;
            PG8_LDA(At, 1, 1); PG8_STAGE(PG8_SA(1, 0), a3, voffA);
            PG8_BAR; PG8_WAIT_L(0); PG8_MMA(1, 0, At, B0); PG8_BAR; PG8_SCHED;
            PG8_STAGE(PG8_SB(1, 1), b3 + hstepB, voffB);
            PG8_WAIT_V(6); PG8_BAR; PG8_MMA(1, 1, At, B1); PG8_BAR;
        }
        E(acc, cur, wr, wc, fr, fq);
        if (!has_next) break;
#pragma unroll
        for (int a = 0; a < 2; ++a)
#pragma unroll
            for (int b = 0; b < 2; ++b)
#pragma unroll
                for (int m = 0; m < 4; ++m)
#pragma unroll
                    for (int n = 0; n < 2; ++n) acc[a][b][m][n] = zero4();
        cur = nxt; cA = nA; cB = nB; ++ui;
    }
    PG8_WAIT_V(0);
    if (wr == 0) PG8_BAR;
    PG8_BAR;
#undef PG8_SA
#undef PG8_SB
#undef PG8_STAGE
#undef PG8_LDA
#undef PG8_LDB
#undef PG8_MMA
#undef PG8_WAIT_V
#undef PG8_WAIT_L
#undef PG8_BAR
#undef PG8_SCHED
}
}

struct EpiZ {
    static constexpr bool PERM = true;
    bf16_t* Z; const unsigned long long* ssq;
    __device__ __forceinline__ void operator()(const f32x4 (&acc)[2][2][4][2], const pg8::Unit& u, int wr, int wc, int fr, int fq) const {
        const int row0 = u.pm * 256 + wr * 64 + fr, col0 = u.pn * 256 + wc * 32 + 8 * fq;
        unsigned long long sq[8];
#pragma unroll
        for (int i = 0; i < 8; ++i) sq[i] = ssq[row0 + (i >> 2) * 128 + (i & 3) * 16];
#pragma unroll
        for (int ai = 0; ai < 2; ++ai)
#pragma unroll
            for (int m = 0; m < 4; ++m) { const int row = row0 + ai * 128 + m * 16; const float rs = rsqrtf((float)sq[ai * 4 + m] * (1.0f / (SSQ_SCALE * 1024.0f)) + 1e-6f);
                bf16_t* rowp = Z + (size_t)row * ZLD + col0;
#pragma unroll
                for (int bj = 0; bj < 2; ++bj) { if (u.pn * 256 + bj * 128 >= INC) continue;
                    const f32x4 v0 = acc[ai][bj][m][0] * rs, v1 = acc[ai][bj][m][1] * rs;
                    u32x4 w; w.x = pk2(v0[0], v0[1]); w.y = pk2(v0[2], v0[3]); w.z = pk2(v1[0], v1[1]); w.w = pk2(v1[2], v1[3]);
                    *(u32x4*)(rowp + bj * 128) = w; } }
    }
};
struct EpiRes {
    static constexpr bool PERM = true;
    bf16_t* XB; unsigned long long* ssq;
    __device__ __forceinline__ void operator()(const f32x4 (&acc)[2][2][4][2], const pg8::Unit& u, int wr, int wc, int fr, int fq) const {
        const int row0 = u.pm * 256 + wr * 64 + fr, col0 = u.pn * 256 + wc * 32 + 8 * fq;
        u32x4 xin[2][4][2];
#pragma unroll
        for (int ai = 0; ai < 2; ++ai)
#pragma unroll
            for (int m = 0; m < 4; ++m) { const bf16_t* bp = XB + (size_t)(row0 + ai * 128 + m * 16) * DM + col0;
#pragma unroll
                for (int bj = 0; bj < 2; ++bj) xin[ai][m][bj] = *(const u32x4*)(bp + bj * 128); }
#pragma unroll
        for (int ai = 0; ai < 2; ++ai)
#pragma unroll
            for (int m = 0; m < 4; ++m) { const int row = row0 + ai * 128 + m * 16; bf16_t* bp = XB + (size_t)row * DM + col0; float s = 0.f;
#pragma unroll
                for (int bj = 0; bj < 2; ++bj) { float xo[8]; unpack8(xin[ai][m][bj], xo); const f32x4 a0 = acc[ai][bj][m][0], a1 = acc[ai][bj][m][1];
                    u32x4 w; w.x = pk2(xo[0] + a0[0], xo[1] + a0[1]); w.y = pk2(xo[2] + a0[2], xo[3] + a0[3]); w.z = pk2(xo[4] + a1[0], xo[5] + a1[1]); w.w = pk2(xo[6] + a1[2], xo[7] + a1[3]);
                    *(u32x4*)(bp + bj * 128) = w; float o[8]; unpack8(w, o);
#pragma unroll
                    for (int e = 0; e < 8; ++e) s += o[e] * o[e]; }
                s += __shfl_xor(s, 16); s += __shfl_xor(s, 32);
                if (fq == 0) ssq_add(ssq, row, s); }
    }
};
struct EpiAct {
    static constexpr bool PERM = true;
    bf16_t* ACT; const unsigned long long* ssq;
    __device__ __forceinline__ void operator()(const f32x4 (&acc)[2][2][4][2], const pg8::Unit& u, int wr, int wc, int fr, int fq) const {
        const int row0 = u.pm * 256 + wr * 64 + fr, col0 = u.pn * 128 + wc * 32 + 8 * fq;
        unsigned long long sq[8];
#pragma unroll
        for (int i = 0; i < 8; ++i) sq[i] = ssq[row0 + (i >> 2) * 128 + (i & 3) * 16];
#pragma unroll
        for (int ai = 0; ai < 2; ++ai)
#pragma unroll
            for (int m = 0; m < 4; ++m) { const int row = row0 + ai * 128 + m * 16; const float rs = rsqrtf((float)sq[ai * 4 + m] * (1.0f / (SSQ_SCALE * 1024.0f)) + 1e-6f);
                float o[8];
#pragma unroll
                for (int n = 0; n < 2; ++n)
#pragma unroll
                    for (int j = 0; j < 4; ++j) { const float g = acc[ai][0][m][n][j] * rs, up = acc[ai][1][m][n][j] * rs; o[n * 4 + j] = g * sigmoidf_(g) * up; }
                u32x4 w; w.x = pk2(o[0], o[1]); w.y = pk2(o[2], o[3]); w.z = pk2(o[4], o[5]); w.w = pk2(o[6], o[7]);
                *(u32x4*)(ACT + (size_t)row * DFF + col0) = w; }
    }
};

template <class F>
__device__ __forceinline__ void thin_gemm(const bf16_t* A, int lda, const bf16_t* Bt, int K, int npairs, const F& f, int w, int lane, int wgi = -1, int G = 0) {
    if (wgi < 0) { wgi = blockIdx.x; G = gridDim.x; }
    const int fr = lane & 15, fq = lane >> 4, ntask = npairs * 8;
    for (int task = w * G + wgi; task < ntask; task += 8 * G) {
        const int rt = task & 7, pr = task >> 3;
        const bf16_t* ap = A + (size_t)(rt * 16 + fr) * lda + 8 * fq;
        const bf16_t* bp0 = Bt + (size_t)(f.b0(pr) + fr) * K + 8 * fq;
        const bf16_t* bp1 = Bt + (size_t)(f.b1(pr) + fr) * K + 8 * fq;
        f32x4 c0 = {0.f, 0.f, 0.f, 0.f}, c1 = {0.f, 0.f, 0.f, 0.f};
        for (int k0 = 0; k0 < K; k0 += 256) {
            bf16x8 a[8], x[8], y[8];
#pragma unroll
            for (int i = 0; i < 8; ++i) { a[i] = *(const bf16x8*)(ap + k0 + i * 32); x[i] = *(const bf16x8*)(bp0 + k0 + i * 32); y[i] = *(const bf16x8*)(bp1 + k0 + i * 32); }
#pragma unroll
            for (int i = 0; i < 8; ++i) { c0 = mfma16(x[i], a[i], c0); c1 = mfma16(y[i], a[i], c1); }
        }
        f.epi(rt * 16 + fr, pr, fq, c0, c1);
    }
}
template <int KS, class F>
__device__ __forceinline__ void thin_gemm_sk(LAS unsigned char* lds, const bf16_t* A, int lda, const bf16_t* Bt, int K, int npairs, const F& f, int w, int lane) {
    const int fr = lane & 15, fq = lane >> 4, ntask = npairs * 8;
    LAS float* P = (LAS float*)lds;
    for (int task = blockIdx.x; task < ntask; task += gridDim.x) {
        const int rt = task & 7, pr = task >> 3, k0 = w * KS * 32;
        const bf16_t* ap = A + (size_t)(rt * 16 + fr) * lda + 8 * fq + k0;
        const bf16_t* bp0 = Bt + (size_t)(f.b0(pr) + fr) * K + 8 * fq + k0;
        const bf16_t* bp1 = Bt + (size_t)(f.b1(pr) + fr) * K + 8 * fq + k0;
        f32x4 c0 = {0.f, 0.f, 0.f, 0.f}, c1 = {0.f, 0.f, 0.f, 0.f};
        bf16x8 a[KS], x[KS], y[KS];
#pragma unroll
        for (int i = 0; i < KS; ++i) { a[i] = *(const bf16x8*)(ap + i * 32); x[i] = *(const bf16x8*)(bp0 + i * 32); y[i] = *(const bf16x8*)(bp1 + i * 32); }
#pragma unroll
        for (int i = 0; i < KS; ++i) { c0 = mfma16(x[i], a[i], c0); c1 = mfma16(y[i], a[i], c1); }
        *(LAS f32x4*)(P + (w * 64 + lane) * 8) = c0; *(LAS f32x4*)(P + (w * 64 + lane) * 8 + 4) = c1;
        __syncthreads();
        if (w == 0) {
            f32x4 s0 = {0.f, 0.f, 0.f, 0.f}, s1 = {0.f, 0.f, 0.f, 0.f};
#pragma unroll
            for (int q = 0; q < 8; ++q) { s0 += *(const LAS f32x4*)(P + (q * 64 + lane) * 8); s1 += *(const LAS f32x4*)(P + (q * 64 + lane) * 8 + 4); }
            f.epi(rt * 16 + fr, pr, fq, s0, s1);
        }
        __syncthreads();
    }
}
struct ThinZ { bf16_t* Z; const unsigned long long* ssq;
    __device__ __forceinline__ int b0(int pr) const { return pr * 32; }
    __device__ __forceinline__ int b1(int pr) const { return pr * 32 + 16; }
    __device__ __forceinline__ void epi(int r, int pr, int fq, f32x4 c0, f32x4 c1) const {
        const int row = NPROMPT + r; const float rs = ssq_rs(ssq, row); c0 = c0 * rs; c1 = c1 * rs;
        bf16_t* zp = Z + (size_t)row * ZLD + pr * 32 + 4 * fq; u32x2 a, b; a.x = pk2(c0[0], c0[1]); a.y = pk2(c0[2], c0[3]); b.x = pk2(c1[0], c1[1]); b.y = pk2(c1[2], c1[3]);
        *(u32x2*)zp = a; *(u32x2*)(zp + 16) = b; }
};
struct ThinRes { bf16_t* XB; unsigned long long* ssq;
    __device__ __forceinline__ int b0(int pr) const { return pr * 32; }
    __device__ __forceinline__ int b1(int pr) const { return pr * 32 + 16; }
    __device__ __forceinline__ void epi(int r, int pr, int fq, f32x4 c0, f32x4 c1) const {
        const int row = NPROMPT + r; bf16_t* bp = XB + (size_t)row * DM + pr * 32 + 4 * fq;
        float x0[4], x1[4]; unpack4(*(const u32x2*)bp, x0); unpack4(*(const u32x2*)(bp + 16), x1);
        u32x2 a, b; a.x = pk2(x0[0] + c0[0], x0[1] + c0[1]); a.y = pk2(x0[2] + c0[2], x0[3] + c0[3]); b.x = pk2(x1[0] + c1[0], x1[1] + c1[1]); b.y = pk2(x1[2] + c1[2], x1[3] + c1[3]);
        *(u32x2*)bp = a; *(u32x2*)(bp + 16) = b; float o0[4], o1[4]; unpack4(a, o0); unpack4(b, o1);
        float s = (o0[0] * o0[0] + o0[1] * o0[1]) + (o0[2] * o0[2] + o0[3] * o0[3]) + (o1[0] * o1[0] + o1[1] * o1[1]) + (o1[2] * o1[2] + o1[3] * o1[3]);
        s += __shfl_xor(s, 16); s += __shfl_xor(s, 32);
        if (fq == 0) ssq_add(ssq, row, s); }
};
struct ThinAct { bf16_t* ACT; const unsigned long long* ssq;
    __device__ __forceinline__ int b0(int pr) const { const int c = pr * 16; return (c >> 7) * 256 + (c & 127); }
    __device__ __forceinline__ int b1(int pr) const { const int c = pr * 16; return (c >> 7) * 256 + 128 + (c & 127); }
    __device__ __forceinline__ void epi(int r, int pr, int fq, f32x4 c0, f32x4 c1) const {
        const int row = NPROMPT + r; const float rs = ssq_rs(ssq, row); float o[4];
#pragma unroll
        for (int j = 0; j < 4; ++j) { const float g = c0[j] * rs, up = c1[j] * rs; o[j] = g * sigmoidf_(g) * up; }
        u32x2 a; a.x = pk2(o[0], o[1]); a.y = pk2(o[2], o[3]); *(u32x2*)(ACT + (size_t)row * DFF + pr * 16 + 4 * fq) = a; }
};

struct TileDesc { const float* src; const float* gain; bf16_t* dst; int lds_src, ld_dst; };
__device__ __forceinline__ TileDesc tile_desc(const Ctx& c, int l, unsigned char* wb, int t) {
    bf16_t* WinT = (bf16_t*)(wb + WB_WIN); bf16_t* WoutT = (bf16_t*)(wb + WB_WOUT); bf16_t* WguT = (bf16_t*)(wb + WB_WGU); bf16_t* WdnT = (bf16_t*)(wb + WB_WDN); bf16_t* GLUT = (bf16_t*)(wb + WB_GLU);
    const int NT_IN = 16 * 38, NT_OUT = 256, NT_GU = 16 * 88, NT_DN = 44 * 16;
    TileDesc d; int q = t;
    if (q < NT_IN) { const int kt = q & 15, nt = q >> 4; d.src = c.in[8] + (size_t)l * 1024 * INC + (size_t)kt * 64 * INC + nt * 64; d.lds_src = INC; d.gain = c.in[7] + l * 1024 + kt * 64; d.dst = WinT + (size_t)nt * 64 * 1024 + kt * 64; d.ld_dst = 1024; return d; }
    q -= NT_IN;
    if (q < NT_OUT) { const int kt = q & 15, nt = q >> 4; const int bm = (kt >> 2) == 0 ? 3 : ((kt >> 2) == 1 ? 1 : ((kt >> 2) == 2 ? 0 : 2)); const int ks = bm * 256 + (kt & 3) * 64;
        d.src = c.in[36] + (size_t)l * 1024 * 1024 + (size_t)ks * 1024 + nt * 64; d.lds_src = 1024; d.gain = nullptr; d.dst = WoutT + (size_t)nt * 64 * 1024 + kt * 64; d.ld_dst = 1024; return d; }
    q -= NT_OUT;
    if (q < NT_GU) { const int kt = q & 15, nt = q >> 4; const int n0 = nt * 64; int dr; if (n0 < DFF) dr = (n0 >> 7) * 256 + (n0 & 127); else { const int n1 = n0 - DFF; dr = (n1 >> 7) * 256 + 128 + (n1 & 127); }
        d.src = c.in[38] + (size_t)l * 1024 * 5632 + (size_t)kt * 64 * 5632 + n0; d.lds_src = 5632; d.gain = c.in[37] + l * 1024 + kt * 64; d.dst = WguT + (size_t)dr * 1024 + kt * 64; d.ld_dst = 1024; return d; }
    q -= NT_GU;
    if (q < NT_DN) { const int nt = q & 15, kt = q >> 4; d.src = c.in[39] + (size_t)l * DFF * 1024 + (size_t)kt * 64 * 1024 + nt * 64; d.lds_src = 1024; d.gain = nullptr; d.dst = WdnT + (size_t)nt * 64 * DFF + kt * 64; d.ld_dst = DFF; return d; }
    q -= NT_DN;
    { const int kt = q & 3, nt = q >> 2; d.src = c.in[21] + (size_t)l * 65536 + (size_t)kt * 64 * 256 + nt * 64; d.lds_src = 256; d.gain = nullptr; d.dst = GLUT + (size_t)nt * 64 * 256 + kt * 64; d.ld_dst = 256; return d; }
}
struct TileRegs { f32x4 v[2]; float g[2]; };
__device__ __forceinline__ void tile_load(TileRegs& r, const TileDesc& d, int tid) {
    const int i = tid >> 4, j4 = (tid & 15) * 4;
#pragma unroll
    for (int p = 0; p < 2; ++p) { const int k = i + p * 32; r.v[p] = __builtin_nontemporal_load((const f32x4*)(d.src + (size_t)k * d.lds_src + j4)); r.g[p] = d.gain ? d.gain[k] : 1.0f; }
}
__device__ void convert_weights(const Ctx& c, int l, int buf, int part = -1, int wgi = -1, int nwg = 0) {
    if (wgi < 0) { wgi = blockIdx.x; nwg = gridDim.x; }
    asm volatile("" : "+s"(nwg), "+s"(wgi));
    unsigned char* wb = c.WB() + (size_t)buf * WB_SIZE;
    bf16_t* WinT = (bf16_t*)(wb + WB_WIN); bf16_t* LORAT = (bf16_t*)(wb + WB_LORA); bf16_t* WSB = (bf16_t*)(wb + WB_WSB);
    const int total = 16 * 38 + 256 + 16 * 88 + 44 * 16 + 16;
    const int t_lo = (part == 1) ? total / 2 : 0, t_hi = (part == 0) ? total / 2 : total;
    LAS float* T = (LAS float*)c.lds; const int tid = c.tid;
    int t = t_lo + wgi;
    if (t < t_hi) {
        TileDesc d = tile_desc(c, l, wb, t); TileRegs r; tile_load(r, d, tid);
        for (;;) {
            { const int i = tid >> 4, j4 = (tid & 15) * 4;
#pragma unroll
              for (int p = 0; p < 2; ++p) { const int k = i + p * 32; T[k * 65 + j4 + 0] = r.v[p][0] * r.g[p]; T[k * 65 + j4 + 1] = r.v[p][1] * r.g[p]; T[k * 65 + j4 + 2] = r.v[p][2] * r.g[p]; T[k * 65 + j4 + 3] = r.v[p][3] * r.g[p]; } }
            __syncthreads();
            const int tn = t + nwg; const bool more = tn < t_hi; const TileDesc dcur = d;
            if (more) { d = tile_desc(c, l, wb, tn); tile_load(r, d, tid); }
            { const int jn = tid >> 3, kq = (tid & 7) * 8; float z[8];
#pragma unroll
              for (int e = 0; e < 8; ++e) z[e] = T[(kq + e) * 65 + jn];
              *(bf16x8*)(dcur.dst + (size_t)jn * dcur.ld_dst + kq) = pack8(z); }
            __syncthreads();
            if (!more) break;
            t = tn;
        }
    }
    if (part == 1) return;
    const int gt = wgi * 512 + c.tid, gn = nwg * 512;
    for (int i = gt; i < 128 * 1024; i += gn) WinT[(size_t)INC * 1024 + i] = 0;
    for (int i = gt; i < 256 * 128; i += gn) { const int n = i >> 7, k = i & 127; float v;
        if (k < 32) v = c.in[27][(size_t)l * 32 * 256 + k * 256 + n]; else if (k < 64) v = c.in[29][(size_t)l * 32 * 256 + (k - 32) * 256 + n]; else v = c.in[30][(size_t)l * 64 * 256 + (k - 64) * 256 + n];
        LORAT[i] = f2bf(v); }
    for (int i = gt; i < 4 * 128 * 128; i += gn) { const int s = i & 127, t = (i >> 7) & 127; WSB[i] = (s <= t) ? f2bf(c.in[11][(size_t)l * 65536 + i]) : (bf16_t)0; }
}

__device__ void phase0(const Ctx& c) {
    for (int row0 = c.gw; row0 < NR; row0 += 5 * c.nw) {
        f32x4 v[5][4];
#pragma unroll
        for (int u = 0; u < 5; ++u) { const int row = (row0 + u * c.nw < NR) ? row0 + u * c.nw : row0; const float* src = row < NPROMPT ? c.in[0] + (size_t)row * DM : c.in[1] + (size_t)(row - NPROMPT) * DM;
#pragma unroll
            for (int j = 0; j < 4; ++j) v[u][j] = __builtin_nontemporal_load((const f32x4*)(src + j * 256 + c.lane * 4)); }
#pragma unroll
        for (int u = 0; u < 5; ++u) { const int row = row0 + u * c.nw; if (row < NR) { float s = 0.f;
#pragma unroll
            for (int j = 0; j < 4; ++j) { const int col = j * 256 + c.lane * 4; u32x2 w; w.x = pk2(v[u][j][0], v[u][j][1]); w.y = pk2(v[u][j][2], v[u][j][3]); *(u32x2*)(c.XB() + (size_t)row * DM + col) = w; float o[4]; unpack4(w, o); s += (o[0] * o[0] + o[1] * o[1]) + (o[2] * o[2] + o[3] * o[3]); }
            s = wave_sum(s); if (c.lane == 0) c.SSQ()[row] = (unsigned long long)(s * SSQ_SCALE + 0.5f); } }
    }
    for (int i = blockIdx.x * 512 + c.tid; i < 8 * NR; i += gridDim.x * 512) c.SSQ()[NR + i] = 0ull;
    for (int i = blockIdx.x * 512 + c.tid; i < NL * 1024; i += gridDim.x * 512) {
        const float lam_re = fminf(c.in[13][i], -1e-4f), lam_im = c.in[14][i], dt = expf(c.in[15][i]);
        const float mag = expf(lam_re * dt); float sn, cs; sincosf(lam_im * dt, &sn, &cs);
        const float lbr = mag * cs, lbi = mag * sn, den = lam_re * lam_re + lam_im * lam_im;
        const float f_re = ((lbr - 1.0f) * lam_re + lbi * lam_im) / den, f_im = (lbi * lam_re - (lbr - 1.0f) * lam_im) / den;
        c.LBC()[2 * i] = lbr; c.LBC()[2 * i + 1] = lbi;
        const int lg = i >> 6, pp = i & 63; bf16_t* bo = c.BBAR() + ((size_t)lg * 128 + 2 * pp) * 16;
#pragma unroll
        for (int q = 0; q < 4; ++q) { const f32x4 br = *(const f32x4*)(c.in[16] + (size_t)i * 16 + q * 4), bi = *(const f32x4*)(c.in[17] + (size_t)i * 16 + q * 4); float re[4], im[4];
#pragma unroll
            for (int e = 0; e < 4; ++e) { re[e] = f_re * br[e] - f_im * bi[e]; im[e] = f_re * bi[e] + f_im * br[e]; }
            u32x2 a; a.x = pk2(re[0], re[1]); a.y = pk2(re[2], re[3]); *(u32x2*)(bo + q * 4) = a; a.x = pk2(im[0], im[1]); a.y = pk2(im[2], im[3]); *(u32x2*)(bo + 16 + q * 4) = a; }
    }
    convert_weights(c, 0, 0);
}

template <int N> struct ZsVec { typedef u32x4 T; };
template <> struct ZsVec<4> { typedef u32x2 T; };
template <int N, bool SAMP> struct ZsIn {
    typename ZsVec<N>::T cur, prb; f32x4 prf[N / 4]; f32x4 mu[N / 4]; float pm;
    __device__ __forceinline__ void load(const Ctx& c, int l, int row, int col) {
        typedef typename ZsVec<N>::T V;
        const bf16_t* zp = c.Z() + (size_t)row * ZLD + 1536 + col;
        cur = *(const V*)zp;
        pm = 1.0f;
        if (!SAMP) { const bool first = (row & (SEQ - 1)) == 0; pm = first ? 0.f : 1.f; const bf16_t* pp = first ? zp : zp - ZLD; prb = *(const V*)pp; }
        else { const float* sp = c.in[3] + ((size_t)l * NSAMP + (row - NPROMPT)) * DTM + col;
#pragma unroll
            for (int e = 0; e < N / 4; ++e) prf[e] = *(const f32x4*)(sp + 4 * e); }
        const float* m = c.in[25] + l * DTM + col;
#pragma unroll
        for (int e = 0; e < N / 4; ++e) mu[e] = *(const f32x4*)(m + 4 * e);
    }
    __device__ __forceinline__ void eval(float* out) const {
        float cu[N], pv[N];
        if constexpr (N == 8) unpack8(cur, cu); else unpack4(cur, cu);
        if (!SAMP) { if constexpr (N == 8) unpack8(prb, pv); else unpack4(prb, pv); }
        else {
#pragma unroll
            for (int e = 0; e < N; ++e) pv[e] = prf[e >> 2][e & 3]; }
#pragma unroll
        for (int e = 0; e < N; ++e) out[e] = cu[e] + mu[e >> 2][e & 3] * (pm * pv[e] - cu[e]);
    }
};

__device__ void d1_chunk(const Ctx& c, int blk, int h);
template <bool SAMP> __device__ __forceinline__ void rwkv_tok_task(const Ctx& c, int l, const bf16_t* LORAT, int blk, int h, int mt_lo, int mt_hi) {
    const int lane = c.lane, fr = lane & 15, fq = lane >> 4;
    for (int mt = mt_lo; mt < mt_hi; ++mt) {
        const int row = blk * 32 + mt * 16 + fr;
        bf16_t* tok = c.TOK() + (size_t)row * 1536;
        ZsIn<8, SAMP> za[4]; bf16x8 lf[4][4];
#pragma unroll
        for (int ks = 0; ks < 4; ++ks) za[ks].load(c, l, row, 768 + ks * 32 + 8 * fq);
#pragma unroll
        for (int nt = 0; nt < 4; ++nt)
#pragma unroll
            for (int ks = 0; ks < 4; ++ks) lf[nt][ks] = *(const bf16x8*)(LORAT + (size_t)(h * 64 + 32 * (nt >> 1) + 8 * (fr >> 2) + 4 * (nt & 1) + (fr & 3)) * 128 + ks * 32 + 8 * fq);
        bf16x8 af[4];
#pragma unroll
        for (int ks = 0; ks < 4; ++ks) { float z[8]; za[ks].eval(z);
#pragma unroll
            for (int e = 0; e < 8; ++e) z[e] = (ks == 0) ? tanh_(z[e]) : ((ks == 1) ? z[e] : sigmoidf_(z[e]));
            af[ks] = pack8(z); }
        f32x4 aw[4], aa[4], ag[4];
#pragma unroll
        for (int nt = 0; nt < 4; ++nt) { const f32x4 zero = {0.f, 0.f, 0.f, 0.f};
            aw[nt] = mfma16(lf[nt][0], af[0], zero); aa[nt] = mfma16(lf[nt][1], af[1], zero); ag[nt] = mfma16(lf[nt][2], af[2], zero); ag[nt] = mfma16(lf[nt][3], af[3], ag[nt]); }
        float n2 = 0.f, bon = 0.f; float kkr[16], av[16];
#pragma unroll
        for (int np = 0; np < 2; ++np) {
            asm volatile("" ::: "memory");
            const int cb = h * 64 + 32 * np + 8 * fq;
            ZsIn<8, SAMP> zr, zk, zv; f32x4 w0[2], a0[2], kk_[2], ka[2], rk[2];
            zr.load(c, l, row, cb); zk.load(c, l, row, 256 + cb); zv.load(c, l, row, 512 + cb);
#pragma unroll
            for (int q = 0; q < 2; ++q) { const int ch = cb + 4 * q;
                w0[q] = *(const f32x4*)(c.in[26] + l * 256 + ch); a0[q] = *(const f32x4*)(c.in[28] + l * 256 + ch); kk_[q] = *(const f32x4*)(c.in[31] + l * 256 + ch);
                ka[q] = *(const f32x4*)(c.in[32] + l * 256 + ch); rk[q] = *(const f32x4*)(c.in[33] + l * 256 + ch); }
            float rz[8], kz[8], vz[8]; zr.eval(rz); zk.eval(kz); zv.eval(vz);
            float km[8], ld[8], gg[8];
#pragma unroll
            for (int q = 0; q < 2; ++q) { const int nt = 2 * np + q;
#pragma unroll
                for (int e = 0; e < 4; ++e) { const int i8 = 4 * q + e;
                    const float x = -(w0[q][e] + aw[nt][e]); const float sp = fmaxf(x, 0.f) + __logf(1.0f + __expf(-fabsf(x))); const float wv = -sp - 0.5f; ld[i8] = -__expf(wv);
                    const float a = sigmoidf_(a0[q][e] + aa[nt][e]); gg[i8] = ag[nt][e];
                    const float kr = kz[i8] * kk_[q][e]; n2 += kr * kr; km[i8] = kz[i8] * (1.0f + (a - 1.0f) * ka[q][e]); bon += rz[i8] * km[i8] * rk[q][e];
                    kkr[nt * 4 + e] = kr; av[nt * 4 + e] = a; } }
            *(bf16x8*)(tok + cb) = pack8(rz); *(bf16x8*)(tok + 256 + cb) = pack8(km); *(bf16x8*)(tok + 512 + cb) = pack8(vz); *(bf16x8*)(tok + 1280 + cb) = pack8(ld);
            *(bf16x8*)(c.GG() + (size_t)row * 256 + cb) = pack8(gg);
        }
        n2 += __shfl_xor(n2, 16); n2 += __shfl_xor(n2, 32); bon += __shfl_xor(bon, 16); bon += __shfl_xor(bon, 32);
        const float inv = 1.0f / fmaxf(sqrtf(n2), 1e-12f);
#pragma unroll
        for (int np = 0; np < 2; ++np) { const int cb = h * 64 + 32 * np + 8 * fq; float kk[8], bv[8];
#pragma unroll
            for (int i8 = 0; i8 < 8; ++i8) { const int idx = (2 * np + (i8 >> 2)) * 4 + (i8 & 3); kk[i8] = kkr[idx] * inv; bv[i8] = kk[i8] * av[idx]; }
            *(bf16x8*)(tok + 768 + cb) = pack8(kk); *(bf16x8*)(tok + 1024 + cb) = pack8(bv); }
        if (fq == 0) c.BON()[(size_t)row * 4 + h] = bon;
        asm volatile("" ::: "memory");
    }
}
__device__ void rwkv_tok(const Ctx& c, int l, int buf) {
    const bf16_t* LORAT = (const bf16_t*)(c.WB() + (size_t)buf * WB_SIZE + WB_LORA);
    for (int task = c.gw; task < (NPROMPT / 32) * 4; task += c.nw) rwkv_tok_task<false>(c, l, LORAT, task >> 2, task & 3, 0, 2);
    for (int ht = c.w * (int)gridDim.x + (int)blockIdx.x; ht < (NSAMP / 16) * 4; ht += 8 * (int)gridDim.x) { const int b16 = ht >> 2; rwkv_tok_task<true>(c, l, LORAT, NPROMPT / 32 + (b16 >> 1), ht & 3, b16 & 1, (b16 & 1) + 1); }
}

__device__ void conv_phase(const Ctx& c, int l) {
    const float* cw = c.in[23] + l * 768; const float* cb = c.in[24] + l * 256;
    for (int task = blockIdx.x * 512 + c.tid; task < (NPROMPT / 8) * 64; task += gridDim.x * 512) {
        const int cq = (task & 63) * 4, r0 = (task >> 6) * 8;
        const f32x4 w0 = *(const f32x4*)(cw + cq), w1 = *(const f32x4*)(cw + 256 + cq), w2 = *(const f32x4*)(cw + 512 + cq), bb = *(const f32x4*)(cb + cq);
        const int t0 = r0 & (SEQ - 1); const float pm = t0 ? 1.f : 0.f; const int rp = t0 ? r0 - 2 : r0;
        u32x2 zx[10], zc[10], zb[8];
#pragma unroll
        for (int i = 0; i < 10; ++i) { const int row = (i < 2) ? rp + i : r0 + i - 2; const bf16_t* zr = c.Z() + (size_t)row * ZLD; zx[i] = *(const u32x2*)(zr + 768 + cq); zc[i] = *(const u32x2*)(zr + 1280 + cq); if (i >= 2) zb[i - 2] = *(const u32x2*)(zr + 1024 + cq); }
        float zm2[4], zm1[4];
        { float a[4], b[4]; unpack4(zx[0], a); unpack4(zc[0], b);
#pragma unroll
          for (int e = 0; e < 4; ++e) zm2[e] = pm * a[e] * b[e];
          unpack4(zx[1], a); unpack4(zc[1], b);
#pragma unroll
          for (int e = 0; e < 4; ++e) zm1[e] = pm * a[e] * b[e]; }
#pragma unroll
        for (int i = 0; i < 8; ++i) { const int row = r0 + i; bf16_t* zr = c.Z() + (size_t)row * ZLD; float a[4], b[4], g[4], z0[4], y[4];
            unpack4(zx[i + 2], a); unpack4(zc[i + 2], b); unpack4(zb[i], g);
#pragma unroll
            for (int e = 0; e < 4; ++e) { z0[e] = a[e] * b[e]; y[e] = g[e] * (bb[e] + w0[e] * zm2[e] + w1[e] * zm1[e] + w2[e] * z0[e]); zm2[e] = zm1[e]; zm1[e] = z0[e]; }
            u32x2 p; p.x = pk2(y[0], y[1]); p.y = pk2(y[2], y[3]); *(u32x2*)(zr + 1024 + cq) = p;
            const int t = row & (SEQ - 1);
            if (t >= SEQ - 2) { float* o = c.out + O_CVP + (((size_t)l * NB + (row >> 11)) * 2 + (t - (SEQ - 2))) * 256 + cq; *(f32x4*)o = (f32x4){z0[0], z0[1], z0[2], z0[3]}; } }
    }
    for (int task = blockIdx.x * 512 + c.tid; task < NSAMP * 64; task += gridDim.x * 512) {
        const int cq = (task & 63) * 4, i = task >> 6, row = NPROMPT + i; bf16_t* zr = c.Z() + (size_t)row * ZLD;
        const f32x4 w0 = *(const f32x4*)(cw + cq), w1 = *(const f32x4*)(cw + 256 + cq), w2 = *(const f32x4*)(cw + 512 + cq), bb = *(const f32x4*)(cb + cq);
        const float* sc = c.in[6] + ((size_t)l * NSAMP + i) * 512; const f32x4 b0 = *(const f32x4*)(sc + cq), b1 = *(const f32x4*)(sc + 256 + cq);
        float a[4], b[4], g[4], y[4]; f32x4 z0;
        unpack4(*(const u32x2*)(zr + 768 + cq), a); unpack4(*(const u32x2*)(zr + 1280 + cq), b); unpack4(*(const u32x2*)(zr + 1024 + cq), g);
#pragma unroll
        for (int e = 0; e < 4; ++e) { z0[e] = a[e] * b[e]; y[e] = g[e] * (bb[e] + w0[e] * b0[e] + w1[e] * b1[e] + w2[e] * z0[e]); }
        u32x2 p; p.x = pk2(y[0], y[1]); p.y = pk2(y[2], y[3]); *(u32x2*)(zr + 1024 + cq) = p;
        float* o = c.out + O_CVS + ((size_t)l * NSAMP + i) * 512; *(f32x4*)(o + cq) = b1; *(f32x4*)(o + 256 + cq) = z0;
    }
}

__device__ void shift_out(const Ctx& c, int l, int first, int stride) {
    for (int i = first; i < (NB + NSAMP) * DTM; i += stride) {
        const int s = i / DTM, col = i - s * DTM;
        if (s < NB) c.out[O_SHP + ((size_t)l * NB + s) * DTM + col] = bf2f(c.Z()[(size_t)(s * SEQ + SEQ - 1) * ZLD + 1536 + col]);
        else c.out[O_SHS + ((size_t)l * NSAMP + (s - NB)) * DTM + col] = bf2f(c.Z()[(size_t)(NPROMPT + s - NB) * ZLD + 1536 + col]);
    }
}

constexpr int LDS_U = 0, LDS_S = 32768, LDS_YG = 102400, SLD = 136, YLD = 264;
template <bool FULL> __device__ void ssm_tile(const Ctx& c, int l, int tile, int h_lo = 0, int h_hi = 2) {
    const int lane = c.lane, w = c.w, fr = lane & 15, fq = lane >> 4;
    const bool samp = tile >= 256;
    const int row0 = samp ? NPROMPT + (tile - 256) * 64 : tile * 64, b = tile >> 5, ch = tile & 31;
    LAS bf16_t* S = (LAS bf16_t*)(c.lds + LDS_S + w * (32 * SLD * 2));
    LAS unsigned* S32 = (LAS unsigned*)S;
    LAS bf16_t* YG = (LAS bf16_t*)(c.lds + LDS_YG);
    float z0_ = 0.f; asm volatile("" : "+v"(z0_)); const f32x4 zero = {z0_, z0_, z0_, z0_};
    for (int gi = 0; gi < 2; ++gi) {
        const int g = 2 * w + gi, idx = (l * 16 + g) * 64 + lane;
        const f32x2 lb = *(const f32x2*)(c.LBC() + 2 * idx); const float lbr = lb.x, lbi = lb.y;
        bf16x8 bbf[8];
#pragma unroll
        for (int it = 0; it < 8; ++it) { u32x4 v = *(const u32x4*)(c.BBAR() + ((size_t)(l * 16 + g) * 128 + it * 16 + fr) * 16 + 8 * (fq & 1)); if (fq >= 2) v = (u32x4){0u, 0u, 0u, 0u}; bbf[it] = __builtin_bit_cast(bf16x8, v); }
        float sr = 0.f, si = 0.f;
        bf16x8 cm[4];
        const f32x4 dd = *(const f32x4*)(c.in[20] + (size_t)(l * 16 + g) * 16 + 4 * fq);
        if (FULL) {
            if (!samp) {
                float pr = lbr, pi = lbi;
#pragma unroll
                for (int q = 0; q < 6; ++q) { const float nr = pr * pr - pi * pi, ni = 2.0f * pr * pi; pr = nr; pi = ni; }
                for (int cc0 = 0; cc0 < ch; cc0 += 8) { f32x2 e[8];
#pragma unroll
                    for (int u = 0; u < 8; ++u) { const int cc = (cc0 + u < ch) ? cc0 + u : cc0; e[u] = *(const f32x2*)(c.EE() + ((size_t)((b * 32 + cc) * 16 + g) * 64 + lane) * 2); }
#pragma unroll
                    for (int u = 0; u < 8; ++u) if (cc0 + u < ch) { const float nr = pr * sr - pi * si + e[u].x, ni = pr * si + pi * sr + e[u].y; sr = nr; si = ni; } }
            }
#pragma unroll
            for (int ks = 0; ks < 4; ++ks) { const size_t co = ((size_t)(l * 16 + g) * 16 + fr) * 64 + ks * 16 + 4 * fq; const f32x4 vr = *(const f32x4*)(c.in[18] + co), vi = *(const f32x4*)(c.in[19] + co);
                float z[8] = {vr[0], -vi[0], vr[1], -vi[1], vr[2], -vi[2], vr[3], -vi[3]}; cm[ks] = pack8(z); }
        }
        for (int half = h_lo; half < h_hi; ++half) {
            asm volatile("s_waitcnt lgkmcnt(0)" ::: "memory");
            u32x4 uvv[2]; u32x2 uue[2];
#pragma unroll
            for (int jt = 0; jt < 2; ++jt) { const bf16_t* up = c.Z() + (size_t)(row0 + half * 32 + jt * 16 + fr) * ZLD + 512 + g * 16; uvv[jt] = *(const u32x4*)(up + 8 * (fq & 1)); uue[jt] = *(const u32x2*)(up + 4 * fq); }
#pragma unroll
            for (int jt = 0; jt < 2; ++jt) { u32x4 uv = uvv[jt]; if (fq >= 2) uv = (u32x4){0u, 0u, 0u, 0u};
                const bf16x8 uf = __builtin_bit_cast(bf16x8, uv);
#pragma unroll
                for (int it = 0; it < 8; ++it) { const f32x4 d = mfma16(bbf[it], uf, zero); u32x2 pq; pq.x = pk2(d[0], d[1]); pq.y = pk2(d[2], d[3]); *(LAS u32x2*)(S + (jt * 16 + fr) * SLD + it * 16 + 4 * fq) = pq; } }
            asm volatile("s_waitcnt lgkmcnt(0)" ::: "memory");
            if (FULL && samp) {
#pragma unroll 1
                for (int t0 = 0; t0 < 32; t0 += 16) { float pr[16], pi[16]; const size_t sbase = ((size_t)(l * NSAMP + (row0 - NPROMPT) + half * 32 + t0) * 16 + g) * 64 + lane;
#pragma unroll
                    for (int u = 0; u < 16; ++u) { pr[u] = c.in[4][sbase + (size_t)u * 1024]; pi[u] = c.in[5][sbase + (size_t)u * 1024]; }
#pragma unroll
                    for (int u = 0; u < 16; ++u) { const unsigned wv = S32[(t0 + u) * (SLD / 2) + lane];
                        const float nr = lbr * pr[u] - lbi * pi[u] + bflo(wv), ni = lbr * pi[u] + lbi * pr[u] + bfhi(wv);
                        S32[(t0 + u) * (SLD / 2) + lane] = pk2(nr, ni); c.out[O_RES + sbase + (size_t)u * 1024] = nr; c.out[O_IMS + sbase + (size_t)u * 1024] = ni; }
                    asm volatile("" ::: "memory"); }
            } else {
#pragma unroll 1
            for (int tt0 = 0; tt0 < 32; tt0 += 8) { unsigned wv[8];
#pragma unroll
                for (int u = 0; u < 8; ++u) wv[u] = S32[(tt0 + u) * (SLD / 2) + lane];
#pragma unroll
                for (int u = 0; u < 8; ++u) { const float nr = lbr * sr - lbi * si + bflo(wv[u]), ni = lbr * si + lbi * sr + bfhi(wv[u]); sr = nr; si = ni;
                    if (FULL) S32[(tt0 + u) * (SLD / 2) + lane] = pk2(sr, si); }
            }
            }
            if (FULL) {
                asm volatile("s_waitcnt lgkmcnt(0)" ::: "memory");
#pragma unroll
                for (int mt = 0; mt < 2; ++mt) { f32x4 acc = zero;
#pragma unroll
                    for (int ks = 0; ks < 4; ++ks) { const bf16x8 sf = *(const LAS bf16x8*)(S + (mt * 16 + fr) * SLD + ks * 32 + 8 * fq); acc = mfma16(cm[ks], sf, acc); }
                    const int t = half * 32 + mt * 16 + fr; float uu[4]; unpack4(uue[mt], uu);
                    float y[4];
#pragma unroll
                    for (int e = 0; e < 4; ++e) y[e] = gelu_t(acc[e] + dd[e] * uu[e]);
                    u32x2 p; p.x = pk2(y[0], y[1]); p.y = pk2(y[2], y[3]); *(LAS u32x2*)(YG + t * YLD + g * 16 + 4 * fq) = p; }
            }
        }
        if (!FULL) { *(f32x2*)(c.EE() + ((size_t)((b * 32 + ch) * 16 + g) * 64 + lane) * 2) = (f32x2){sr, si}; }
        else if (!samp && ch == 31) { const size_t so = ((size_t)(l * NB + b) * 16 + g) * 64 + lane; c.out[O_REP + so] = sr; c.out[O_IMP + so] = si; }
    }
}
__device__ void ssm_glu(const Ctx& c, int l, int buf, int tile, int mt_lo = 0, int mt_hi = 4) {
    const bf16_t* GLUT = (const bf16_t*)(c.WB() + (size_t)buf * WB_SIZE + WB_GLU);
    const int lane = c.lane, w = c.w, fr = lane & 15, fq = lane >> 4;
    const int row0 = tile >= 256 ? NPROMPT + (tile - 256) * 64 : tile * 64;
    LAS bf16_t* YG = (LAS bf16_t*)(c.lds + LDS_YG);
    f32x4 acc[4][2];
#pragma unroll
    for (int mt = 0; mt < 4; ++mt) { acc[mt][0] = zero4(); acc[mt][1] = zero4(); }
#pragma unroll
    for (int ks = 0; ks < 8; ++ks) { bf16x8 bf[2];
#pragma unroll
        for (int nn = 0; nn < 2; ++nn) bf[nn] = *(const bf16x8*)(GLUT + (size_t)((2 * w + nn) * 16 + fr) * 256 + ks * 32 + 8 * fq);
#pragma unroll
        for (int mt = 0; mt < 4; ++mt) { const bf16x8 af = *(const LAS bf16x8*)(YG + (mt * 16 + fr) * YLD + ks * 32 + 8 * fq); acc[mt][0] = mfma16(bf[0], af, acc[mt][0]); acc[mt][1] = mfma16(bf[1], af, acc[mt][1]); } }
    f32x4 gbv[2];
#pragma unroll
    for (int nn = 0; nn < 2; ++nn) gbv[nn] = *(const f32x4*)(c.in[22] + l * 256 + (2 * w + nn) * 16 + 4 * fq);
#pragma unroll
    for (int mt = 0; mt < 4; ++mt)
#pragma unroll
        for (int nn = 0; nn < 2; ++nn) if (mt >= mt_lo && mt < mt_hi) { const int t = mt * 16 + fr, j = (2 * w + nn) * 16 + 4 * fq; float yg[4]; unpack4(*(const LAS u32x2*)(YG + t * YLD + j), yg);
            const f32x4 gb = gbv[nn]; float o[4];
#pragma unroll
            for (int e = 0; e < 4; ++e) o[e] = yg[e] * sigmoidf_(acc[mt][nn][e] + gb[e]);
            u32x2 p; p.x = pk2(o[0], o[1]); p.y = pk2(o[2], o[3]); *(u32x2*)(c.Z() + (size_t)(row0 + t) * ZLD + 512 + j) = p; }
}

template <bool WHOLE> __device__ void gmlp_tile(const Ctx& c, int l, int buf, int tile) {
    const bf16_t* WSB = (const bf16_t*)(c.WB() + (size_t)buf * WB_SIZE + WB_WSB);
    const int lane = c.lane, w = c.w, fr = lane & 15, fq = lane >> 4;
    const int b = WHOLE ? tile >> 4 : tile >> 5, cc = WHOLE ? (tile & 15) : ((tile & 31) >> 1), h_lo = WHOLE ? 0 : (tile & 1), h_hi = WHOLE ? 2 : (tile & 1) + 1, nKall = 64 * h_hi, rowc0 = b * SEQ + cc * 128;
    LAS bf16_t* VNt = (LAS bf16_t*)c.lds;
    const float* lg = c.in[9] + l * 256; const float* lb = c.in[10] + l * 256;
    u32x2 zuA[2][2][4]; float bsA[2][2];
    if constexpr (WHOLE) {
#pragma unroll
        for (int hh = 0; hh < 2; ++hh)
#pragma unroll
            for (int mi = 0; mi < 2; ++mi) { const int tt = hh * 64 + ((w & 1) * 2 + mi) * 16 + fr; bsA[hh][mi] = c.in[12][(size_t)l * 512 + (w >> 1) * 128 + tt]; const bf16_t* zr = c.Z() + (size_t)(rowc0 + tt) * ZLD;
#pragma unroll
                for (int nt = 0; nt < 4; ++nt) zuA[hh][mi][nt] = *(const u32x2*)(zr + (w >> 1) * 64 + nt * 16 + 4 * fq); }
    }
    constexpr int LNB = WHOLE ? 16 : 8;
    for (int s0 = w; s0 < nKall; s0 += 8 * LNB) { unsigned raw[LNB][4];
#pragma unroll
        for (int u = 0; u < LNB; ++u) { const bf16_t* zp = c.Z() + (size_t)(rowc0 + s0 + 8 * u) * ZLD + 256;
#pragma unroll
            for (int j = 0; j < 4; ++j) raw[u][j] = zp[lane + 64 * j]; }
#pragma unroll
        for (int u = 0; u < LNB; ++u) { const int s = s0 + 8 * u; float v[4]; float sum = 0.f;
            float q = 0.f;
#pragma unroll
            for (int j = 0; j < 4; ++j) { v[j] = gelu_t(__uint_as_float(raw[u][j] << 16)); sum += v[j]; q += v[j] * v[j]; }
            const float mean = wave_sum(sum) * (1.0f / 256.0f);
            const float rstd = rsqrtf(fmaxf(wave_sum(q) * (1.0f / 256.0f) - mean * mean, 0.f) + 1e-5f);
#pragma unroll
            for (int j = 0; j < 4; ++j) { const int chn = lane + 64 * j; VNt[chn * SLD + s] = f2bf((v[j] - mean) * rstd * lg[chn] + lb[chn]); } } }
    __syncthreads();
    const int h = w >> 1, mts = (w & 1) * 2;
#pragma unroll
    for (int half = 0; half < 2; ++half) { if (!WHOLE && (half < h_lo || half >= h_hi)) continue;
    const int nK = 64 * (half + 1);
    f32x4 acc[2][4];
#pragma unroll
    for (int mi = 0; mi < 2; ++mi)
#pragma unroll
        for (int nt = 0; nt < 4; ++nt) acc[mi][nt] = zero4();
    bf16x8 wf[4][2];
#pragma unroll
    for (int ks = 0; ks < 4; ++ks)
#pragma unroll
        for (int mi = 0; mi < 2; ++mi) { const int tt = half * 64 + (mts + mi) * 16 + fr; const int kse = (ks < nK / 32) ? ks : 0; wf[ks][mi] = *(const bf16x8*)(WSB + (size_t)(h * 128 + tt) * 128 + kse * 32 + 8 * fq); }
#pragma unroll
    for (int ks = 0; ks < 4; ++ks) if (ks < nK / 32) { bf16x8 bf[4];
#pragma unroll
        for (int nt = 0; nt < 4; ++nt) bf[nt] = *(const LAS bf16x8*)(VNt + (h * 64 + nt * 16 + fr) * SLD + ks * 32 + 8 * fq);
#pragma unroll
        for (int mi = 0; mi < 2; ++mi)
#pragma unroll
            for (int nt = 0; nt < 4; ++nt) acc[mi][nt] = mfma16(bf[nt], wf[ks][mi], acc[mi][nt]); }
    { u32x2 zu[2][4]; float bsv[2];
#pragma unroll
      for (int mi = 0; mi < 2; ++mi) { const int tt = half * 64 + (mts + mi) * 16 + fr; bsv[mi] = c.in[12][(size_t)l * 512 + h * 128 + tt]; const bf16_t* zr = c.Z() + (size_t)(rowc0 + tt) * ZLD;
#pragma unroll
          for (int nt = 0; nt < 4; ++nt) { if constexpr (WHOLE) zu[mi][nt] = zuA[half][mi][nt]; else zu[mi][nt] = *(const u32x2*)(zr + h * 64 + nt * 16 + 4 * fq); }
          if constexpr (WHOLE) bsv[mi] = bsA[half][mi]; }
#pragma unroll
      for (int mi = 0; mi < 2; ++mi) { const int tt = half * 64 + (mts + mi) * 16 + fr; bf16_t* zr = c.Z() + (size_t)(rowc0 + tt) * ZLD;
#pragma unroll
          for (int nt = 0; nt < 4; ++nt) { const int chn = h * 64 + nt * 16 + 4 * fq; float u[4]; unpack4(zu[mi][nt], u); float o[4];
#pragma unroll
              for (int e = 0; e < 4; ++e) o[e] = gelu_t(u[e]) * (acc[mi][nt][e] + bsv[mi]);
              u32x2 p; p.x = pk2(o[0], o[1]); p.y = pk2(o[2], o[3]); *(u32x2*)(zr + 768 + chn) = p; } } }
    }
    __syncthreads();
}
__device__ void gmlp_sample(const Ctx& c, int l, int first, int stride) {
    const int lane = c.lane, h = lane >> 4;
    for (int i = first; i < NSAMP; i += stride) { const int row = NPROMPT + i; bf16_t* zr = c.Z() + (size_t)row * ZLD; float v[4], u[4]; unpack4(*(const u32x2*)(zr + 256 + 4 * lane), v); unpack4(*(const u32x2*)(zr + 4 * lane), u);
        float sum = 0.f;
#pragma unroll
        for (int e = 0; e < 4; ++e) { v[e] = gelu_t(v[e]); sum += v[e]; }
        const float mean = wave_sum(sum) * (1.0f / 256.0f); float q = 0.f;
#pragma unroll
        for (int e = 0; e < 4; ++e) { const float d = v[e] - mean; q += d * d; }
        const float rstd = rsqrtf(wave_sum(q) * (1.0f / 256.0f) + 1e-5f);
        const f32x4 lg = *(const f32x4*)(c.in[9] + l * 256 + 4 * lane), lb = *(const f32x4*)(c.in[10] + l * 256 + 4 * lane);
        const float ws0 = c.in[11][(size_t)l * 65536 + h * 16384], bs0 = c.in[12][(size_t)l * 512 + h * 128]; f32x4 vn; float o[4];
#pragma unroll
        for (int e = 0; e < 4; ++e) { vn[e] = (v[e] - mean) * rstd * lg[e] + lb[e]; o[e] = gelu_t(u[e]) * (ws0 * vn[e] + bs0); }
        *(f32x4*)(c.out + O_CHV + ((size_t)l * NSAMP + i) * 256 + 4 * lane) = vn;
        u32x2 p; p.x = pk2(o[0], o[1]); p.y = pk2(o[2], o[3]); *(u32x2*)(zr + 768 + 4 * lane) = p; }
}


constexpr int CH_W = 0, CH_R = 4096, CH_ARB = 8192, CH_BT = 10240, CH_Y = 14336, CH_P1 = 18432, CH_P2 = 22528, CH_DG = 30720;
__device__ __forceinline__ bf16x8 lds_ld16(const LAS bf16_t* p) { const u32x2 a = *(const LAS u32x2*)p, b = *(const LAS u32x2*)(p + 4); u32x4 r; r.x = a.x; r.y = a.y; r.z = b.x; r.w = b.y; return __builtin_bit_cast(bf16x8, r); }
__device__ __forceinline__ u32x2 pk4(f32x4 v) { u32x2 p; p.x = pk2(v[0], v[1]); p.y = pk2(v[2], v[3]); return p; }
__device__ __forceinline__ bf16x8 pk8(f32x4 a, f32x4 b) { const u32x2 x = pk4(a), y = pk4(b); u32x4 r; r.x = x.x; r.y = x.y; r.z = y.x; r.w = y.y; return __builtin_bit_cast(bf16x8, r); }
#define LDSW() asm volatile("s_waitcnt lgkmcnt(0)" ::: "memory")
typedef short s16x4 __attribute__((ext_vector_type(4)));
__device__ __forceinline__ bf16x8 tr_frag(const LAS bf16_t* buf, int rb0, int rb1, int c, int lane) {
    const int q = (lane & 15) >> 2, p = lane & 3;
    const s16x4 lo = __builtin_amdgcn_ds_read_tr16_b64_v4i16((LAS s16x4*)(buf + (rb0 + q) * 68 + 16 * c + 4 * p));
    const s16x4 hi = __builtin_amdgcn_ds_read_tr16_b64_v4i16((LAS s16x4*)(buf + (rb1 + q) * 68 + 16 * c + 4 * p));
    return __builtin_shufflevector(lo, hi, 0, 1, 2, 3, 4, 5, 6, 7);
}
__device__ void d1_chunk(const Ctx& c, int blk, int h) {
    const int lane = c.lane, fr = lane & 15, fq = lane >> 4;
    const int b = blk >> 6, ck = blk & 63, row0 = blk * 32;
    unsigned char* chp = c.CH() + (size_t)((b * 4 + h) * 64 + ck) * CHS;
    LAS unsigned char* lw = c.lds + c.w * 17408;
    LAS bf16_t* AT = (LAS bf16_t*)lw; LAS bf16_t* BT_ = AT + 32 * 68; LAS bf16_t* KT_ = BT_ + 32 * 68; LAS bf16_t* RT_ = KT_ + 32 * 68;
    const bf16_t* tok = c.TOK() + (size_t)row0 * 1536 + h * 64 + lane;
    float z0_ = 0.f; asm volatile("" : "+v"(z0_)); const f32x4 zero = {z0_, z0_, z0_, z0_};
    float GT;
    LDSW();
    { float G = 0.f;
#pragma unroll 1
      for (int t0 = 0; t0 < 32; t0 += 16) { unsigned raw[16][5];
#pragma unroll
          for (int u = 0; u < 16; ++u) { const bf16_t* q = tok + (size_t)(t0 + u) * 1536; raw[u][0] = q[0]; raw[u][1] = q[256]; raw[u][2] = q[768]; raw[u][3] = q[1024]; raw[u][4] = q[1280]; }
#pragma unroll
          for (int u = 0; u < 16; ++u) { const int t = t0 + u; const float ld = __uint_as_float(raw[u][4] << 16); const float Gm = G; G += ld;
              const float r = __uint_as_float(raw[u][0] << 16), km = __uint_as_float(raw[u][1] << 16), a = -__uint_as_float(raw[u][2] << 16), bv = __uint_as_float(raw[u][3] << 16); const float eG = __expf(G), ie = __expf(-G), eGm = __expf(Gm);
              AT[t * 68 + lane] = f2bf(a * eGm); BT_[t * 68 + lane] = f2bf(bv * ie); KT_[t * 68 + lane] = f2bf(km * ie); RT_[t * 68 + lane] = f2bf(r * eG); }
          asm volatile("" ::: "memory"); }
      GT = G; }
    LDSW();
    f32x4 acc[2][2][2][2];
#pragma unroll
    for (int i = 0; i < 16; ++i) acc[i >> 3][(i >> 2) & 1][(i >> 1) & 1][i & 1] = zero;
#pragma unroll
    for (int ks = 0; ks < 2; ++ks) { bf16x8 af[2][2], bf[2][2];
#pragma unroll
        for (int m = 0; m < 2; ++m) { const int o = (m * 16 + fr) * 68 + ks * 32 + fq * 8; af[0][m] = lds_ld16(BT_ + o); af[1][m] = lds_ld16(KT_ + o); bf[0][m] = lds_ld16(AT + o); bf[1][m] = lds_ld16(RT_ + o); }
#pragma unroll
        for (int i = 0; i < 16; ++i) { const int as = i >> 3, bs = (i >> 2) & 1, mt = (i >> 1) & 1, nt = i & 1; acc[as][bs][mt][nt] = mfma16(af[as][mt], bf[bs][nt], acc[as][bs][mt][nt]); } }
#pragma unroll
    for (int nt = 0; nt < 2; ++nt)
#pragma unroll
        for (int ks = 0; ks < 2; ++ks) { const int t = 16 * nt + fr; const u32x2 lo = *(const LAS u32x2*)(RT_ + t * 68 + 32 * ks + 4 * fq), hi = *(const LAS u32x2*)(RT_ + t * 68 + 32 * ks + 16 + 4 * fq);
            u32x4 v; v.x = lo.x; v.y = lo.y; v.z = hi.x; v.w = hi.y; *(u32x4*)((bf16_t*)(chp + CH_R) + t * 64 + (((ks * 4 + fq) ^ (fr & 7)) * 8)) = v; }
    LDSW();
    bf16x8 aT[4], kT[4], bTp[4];
#pragma unroll
    for (int mt = 0; mt < 4; ++mt) { aT[mt] = tr_frag(AT, 8 * fq, 8 * fq + 4, mt, lane); kT[mt] = tr_frag(KT_, 8 * fq, 8 * fq + 4, mt, lane); bTp[mt] = tr_frag(BT_, 4 * fq, 16 + 4 * fq, mt, lane); }
    LDSW();
    LAS float* L = (LAS float*)lw; LAS bf16_t* AAK = (LAS bf16_t*)(lw + 4608); LAS bf16_t* ARK = (LAS bf16_t*)(lw + 7168); LAS bf16_t* TINV = (LAS bf16_t*)(lw + 9728);
    LAS float* DGL = (LAS float*)(lw + 12288); LAS bf16_t* VR = RT_;
    DGL[lane] = __expf(GT);
    {
#pragma unroll 1
      for (int t0 = 0; t0 < 32; t0 += 16) { unsigned rv[16];
#pragma unroll
          for (int u = 0; u < 16; ++u) rv[u] = tok[(size_t)(t0 + u) * 1536 + 512];
#pragma unroll
          for (int u = 0; u < 16; ++u) VR[(t0 + u) * 68 + lane] = (bf16_t)rv[u];
          asm volatile("" ::: "memory"); } }
#pragma unroll
    for (int nt = 0; nt < 2; ++nt) { const int t = 16 * nt + fr;
#pragma unroll
        for (int mt = 0; mt < 2; ++mt) { const int s0 = 16 * mt + 4 * fq; f32x4 v = acc[0][0][mt][nt], k = acc[1][0][mt][nt], q = acc[1][1][mt][nt];
#pragma unroll
            for (int e = 0; e < 4; ++e) { if (!(s0 + e < t)) { v[e] = z0_; k[e] = z0_; } if (!(s0 + e <= t)) q[e] = z0_; }
            *(LAS f32x4*)(L + t * 36 + s0) = v; *(LAS u32x2*)(AAK + t * 40 + s0) = pk4(k); *(LAS u32x2*)(ARK + t * 40 + s0) = pk4(q); }
        f32x4 v0 = acc[0][1][0][nt], v1 = acc[0][1][1][nt];
#pragma unroll
        for (int e = 0; e < 4; ++e) { if (!(4 * fq + e <= t)) v0[e] = z0_; if (!(16 + 4 * fq + e <= t)) v1[e] = z0_; }
        const u32x2 a = pk4(v0), bb = pk4(v1); u32x4 w; w.x = a.x; w.y = a.y; w.z = bb.x; w.w = bb.y; *(u32x4*)((bf16_t*)(chp + CH_ARB) + t * 32 + ((fq ^ ((fr >> 2) & 3)) * 8)) = w; }
    LDSW();
    bf16x8 vT[4];
#pragma unroll
    for (int nt = 0; nt < 4; ++nt) vT[nt] = tr_frag(VR, 8 * fq, 8 * fq + 4, nt, lane);
#pragma unroll
    for (int mt = 0; mt < 4; ++mt) { const f32x4 dg4 = *(const LAS f32x4*)(DGL + 16 * mt + 4 * fq);
#pragma unroll
        for (int nt = 0; nt < 4; ++nt) { const f32x4 p = mfma16(kT[mt], vT[nt], zero) * dg4; *(u32x2*)(chp + CH_P2 + ((nt * 4 + mt) * 64 + lane) * 8) = pk4(p); }
        const int chn = 16 * mt + fr; const float dgs = DGL[chn]; float z[8]; unpack8(__builtin_bit_cast(u32x4, bTp[mt]), z);
#pragma unroll
        for (int e = 0; e < 8; ++e) z[e] *= dgs;
        *(bf16x8*)((bf16_t*)(chp + CH_BT) + chn * 32 + ((fq ^ ((fr >> 2) & 3)) * 8)) = pack8(z); }
#pragma unroll
    for (int nt = 0; nt < 4; ++nt)
#pragma unroll
        for (int mt = 0; mt < 2; ++mt) { const f32x4 p = mfma16(*(const LAS bf16x8*)(ARK + (mt * 16 + fr) * 40 + fq * 8), vT[nt], zero); *(u32x2*)(chp + CH_P1 + ((nt * 2 + mt) * 64 + lane) * 8) = pk4(p); }
    LDSW();
    { float x[32]; const int j = lane & 31;
#pragma unroll
      for (int t = 0; t < 32; ++t) x[t] = 0.f;
#pragma unroll
      for (int t = 0; t < 32; ++t) { int jj = j; asm volatile("" : "+v"(jj)); float a = (t == jj) ? 1.f : 0.f;
#pragma unroll
          for (int s4 = 0; s4 < (t + 3) / 4; ++s4) { const f32x4 Lr = *(const LAS f32x4*)(L + t * 36 + 4 * s4); a += Lr[0] * x[4 * s4] + Lr[1] * x[4 * s4 + 1] + Lr[2] * x[4 * s4 + 2] + Lr[3] * x[4 * s4 + 3]; }
          asm volatile("" : "+v"(a) :: "memory"); x[t] = a; }
#pragma unroll
      for (int t = 0; t < 32; ++t) TINV[t * 40 + j] = f2bf(x[t]); }
    { f32x4 w[4][2];
#pragma unroll
      for (int mt = 0; mt < 4; ++mt)
#pragma unroll
          for (int nt = 0; nt < 2; ++nt) w[mt][nt] = mfma16(aT[mt], *(const LAS bf16x8*)(TINV + (nt * 16 + fr) * 40 + fq * 8), zero);
#pragma unroll
      for (int nt = 0; nt < 2; ++nt)
#pragma unroll
          for (int ks = 0; ks < 2; ++ks) { const u32x2 a = pk4(w[2 * ks][nt]), bb = pk4(w[2 * ks + 1][nt]); u32x4 v; v.x = a.x; v.y = a.y; v.z = bb.x; v.w = bb.y;
              *(u32x4*)((bf16_t*)(chp + CH_W) + (16 * nt + fr) * 64 + (((ks * 4 + fq) ^ (fr & 7)) * 8)) = v; } }
    { bf16x8 tp[2];
#pragma unroll
      for (int mt = 0; mt < 2; ++mt) { const u32x2 lo = *(const LAS u32x2*)(TINV + (mt * 16 + fr) * 40 + 4 * fq), hi = *(const LAS u32x2*)(TINV + (mt * 16 + fr) * 40 + 16 + 4 * fq); u32x4 v; v.x = lo.x; v.y = lo.y; v.z = hi.x; v.w = hi.y; tp[mt] = __builtin_bit_cast(bf16x8, v); }
#pragma unroll
      for (int nt = 0; nt < 4; ++nt) { f32x4 x[2];
#pragma unroll
          for (int mt = 0; mt < 2; ++mt) x[mt] = mfma16(*(const LAS bf16x8*)(AAK + (mt * 16 + fr) * 40 + fq * 8), vT[nt], zero);
          const bf16x8 xb = pk8(x[0], x[1]);
#pragma unroll
          for (int mt = 0; mt < 2; ++mt) { const f32x4 y = mfma16(tp[mt], xb, zero); *(u32x2*)(chp + CH_Y + ((nt * 2 + mt) * 64 + lane) * 8) = pk4(y);
 } } }
    ((bf16_t*)(chp + CH_DG))[lane] = f2bf(__expf(GT));
    LDSW();
}

__device__ void rwkv_d1(const Ctx& c) {
    asm volatile("s_waitcnt vmcnt(0)" ::: "memory");
    for (int task = c.gw; task < (NPROMPT / 32) * 4; task += c.nw) d1_chunk(c, task >> 2, task & 3);
}

struct D2F { bf16x8 w[2][2], rr[2][2], arb[2], bt[4]; u32x2 y[2], p1[2], p2[4], dg[4]; };
constexpr int D2_SLOT = 19456, D2_NSLOT = 7;
__device__ __forceinline__ void d2_dma(LAS unsigned char* slot, const unsigned char* chp, int slab, int lane) {
    const unsigned char* g = chp + lane * 16;
#pragma unroll
    for (int i = 0; i < 14; ++i) __builtin_amdgcn_global_load_lds((const unsigned*)(g + i * 1024), (LAS unsigned*)(slot + i * 1024), 16, 0, 0);
    __builtin_amdgcn_global_load_lds((const unsigned*)(g + CH_Y + slab * 1024), (LAS unsigned*)(slot + 14336), 16, 0, 0);
    __builtin_amdgcn_global_load_lds((const unsigned*)(g + CH_P1 + slab * 1024), (LAS unsigned*)(slot + 15360), 16, 0, 0);
    __builtin_amdgcn_global_load_lds((const unsigned*)(g + CH_P2 + slab * 2048), (LAS unsigned*)(slot + 16384), 16, 0, 0);
    __builtin_amdgcn_global_load_lds((const unsigned*)(g + CH_P2 + slab * 2048 + 1024), (LAS unsigned*)(slot + 17408), 16, 0, 0);
    __builtin_amdgcn_global_load_lds((const unsigned*)(g + CH_DG), (LAS unsigned*)(slot + 18432), 16, 0, 0);
}
__device__ __forceinline__ void d2_load(D2F& f, const LAS unsigned char* slot, int fr, int fq, int lane) {
    const int x8 = fr & 7, x4 = (fr >> 2) & 3;
#pragma unroll
    for (int mt = 0; mt < 2; ++mt) {
#pragma unroll
        for (int ks = 0; ks < 2; ++ks) { const int o = (16 * mt + fr) * 128 + (((ks * 4 + fq) ^ x8) * 16); f.w[mt][ks] = *(const LAS bf16x8*)(slot + CH_W + o); f.rr[mt][ks] = *(const LAS bf16x8*)(slot + CH_R + o); }
        f.arb[mt] = *(const LAS bf16x8*)(slot + CH_ARB + (16 * mt + fr) * 64 + ((fq ^ x4) * 16));
        f.y[mt] = *(const LAS u32x2*)(slot + 14336 + mt * 512 + lane * 8); f.p1[mt] = *(const LAS u32x2*)(slot + 15360 + mt * 512 + lane * 8); }
#pragma unroll
    for (int mt = 0; mt < 4; ++mt) { f.bt[mt] = *(const LAS bf16x8*)(slot + CH_BT + (16 * mt + fr) * 64 + ((fq ^ x4) * 16));
        f.p2[mt] = *(const LAS u32x2*)(slot + 16384 + mt * 512 + lane * 8); f.dg[mt] = *(const LAS u32x2*)(slot + 18432 + mt * 32 + fq * 8); }
}
__device__ __forceinline__ f32x4 up4(u32x2 u) { return (f32x4){bflo(u.x), bfhi(u.x), bflo(u.y), bfhi(u.y)}; }
__device__ __forceinline__ void d2_step(const D2F& f, f32x4 (&H)[4], float* op, int fq) {
    const bf16x8 hb0 = pk8(H[0], H[1]), hb1 = pk8(H[2], H[3]);
    f32x4 U[2], O[2];
#pragma unroll
    for (int mt = 0; mt < 2; ++mt) { U[mt] = up4(f.y[mt]); U[mt] = mfma16(f.w[mt][0], hb0, U[mt]); U[mt] = mfma16(f.w[mt][1], hb1, U[mt]);
        O[mt] = up4(f.p1[mt]); O[mt] = mfma16(f.rr[mt][0], hb0, O[mt]); O[mt] = mfma16(f.rr[mt][1], hb1, O[mt]); }
    const bf16x8 ub = pk8(U[0], U[1]);
#pragma unroll
    for (int mt = 0; mt < 2; ++mt) { O[mt] = mfma16(f.arb[mt], ub, O[mt]);
#pragma unroll
        for (int r = 0; r < 4; ++r) op[(size_t)(16 * mt + 4 * fq + r) * 256] = O[mt][r]; }
#pragma unroll
    for (int mt = 0; mt < 4; ++mt) { u32x2 p2 = f.p2[mt], dg = f.dg[mt]; asm volatile("" : "+v"(p2.x), "+v"(p2.y), "+v"(dg.x), "+v"(dg.y)); const f32x4 hn = up4(p2) + up4(dg) * H[mt]; H[mt] = mfma16(f.bt[mt], ub, hn); }
}
__device__ void rwkv_d2(const Ctx& c, int l) {
    const int lane = c.lane, fr = lane & 15, fq = lane >> 4, G = gridDim.x;
    if (c.w != 0) return;
    __builtin_amdgcn_s_setprio(2);
    for (int task = blockIdx.x; task < NB * 4 * 4; task += G) {
        const int slab = task & 3, h = (task >> 2) & 3, b = task >> 4;
        const unsigned char* chb = c.CH() + (size_t)((b * 4 + h) * 64) * CHS;
        f32x4 H[4];
#pragma unroll
        for (int mt = 0; mt < 4; ++mt) H[mt] = zero4();
        float* op = c.OO() + (size_t)(b * SEQ) * 256 + h * 64 + slab * 16 + fr;
        asm volatile("s_waitcnt vmcnt(0) lgkmcnt(0)" ::: "memory");
        d2_dma(c.lds, chb, slab, lane); d2_dma(c.lds + D2_SLOT, chb + CHS, slab, lane);
        for (int ck = 0; ck < 64; ++ck) {
            if (ck + 2 < 64) d2_dma(c.lds + ((ck + 2) % D2_NSLOT) * D2_SLOT, chb + (size_t)(ck + 2) * CHS, slab, lane);
            if (ck == 0) asm volatile("s_waitcnt vmcnt(38)" ::: "memory");
            else if (ck == 1) asm volatile("s_waitcnt vmcnt(46)" ::: "memory");
            else if (ck < 62) asm volatile("s_waitcnt vmcnt(54)" ::: "memory");
            else asm volatile("s_waitcnt vmcnt(0)" ::: "memory");
            D2F f; d2_load(f, c.lds + (ck % D2_NSLOT) * D2_SLOT, fr, fq, lane);
            d2_step(f, H, op + (size_t)(ck * 32) * 256, fq);
        }
        float* so = c.out + O_WKVP + (((size_t)(l * NB + b) * 4 + h) * 64 + slab * 16 + fr) * 64;
#pragma unroll
        for (int mt = 0; mt < 4; ++mt) *(f32x4*)(so + 16 * mt + 4 * fq) = H[mt];
    }
    __builtin_amdgcn_s_setprio(0);
}

__device__ void rwkv_scan(const Ctx& c, int l, int first, int stride) {
    const int lane = c.lane;
    for (int task = first; task < NSAMP * 16; task += stride) {
        const int i = task >> 4, h = (task >> 2) & 3, q4 = task & 3, row = NPROMPT + i;
        const bf16_t* tk = c.TOK() + (size_t)row * 1536 + h * 64;
        const float r = bf2f(tk[lane]), km = bf2f(tk[256 + lane]), kk = bf2f(tk[768 + lane]), bv = bf2f(tk[1024 + lane]), d = __expf(bf2f(tk[1280 + lane]));
        const size_t sb = (((size_t)(l * NSAMP + i) * 4 + h) * 64) * 64;
        float S0[16]; unsigned vraw[16];
#pragma unroll
        for (int j = 0; j < 16; ++j) { const int vr = q4 * 16 + j; S0[j] = c.in[2][sb + (size_t)vr * 64 + lane]; vraw[j] = tk[512 + vr]; }
#pragma unroll
        for (int j = 0; j < 16; ++j) { const int vr = q4 * 16 + j; float S = S0[j]; const float vv = __uint_as_float(vraw[j] << 16);
            const float sa = -wave_sum(S * kk); S = S * d + sa * bv + vv * km; const float o = wave_sum(S * r);
            __builtin_nontemporal_store(S, c.out + O_WKVS + sb + (size_t)vr * 64 + lane); if (lane == 0) c.OO()[(size_t)row * 256 + h * 64 + vr] = o; }
    }
}

__device__ void rwkv_final(const Ctx& c, int l) {
    const int lane = c.lane, h = lane >> 4;
    const f32x4 lg = *(const f32x4*)(c.in[34] + l * 256 + 4 * lane), lb = *(const f32x4*)(c.in[35] + l * 256 + 4 * lane);
    for (int row0 = c.gw; row0 < NR; row0 += 9 * c.nw) {
        f32x4 o[9]; u32x2 vv[9], gq[9]; float bon[9];
#pragma unroll
        for (int u = 0; u < 9; ++u) { const int row = (row0 + u * c.nw < NR) ? row0 + u * c.nw : row0; o[u] = *(const f32x4*)(c.OO() + (size_t)row * 256 + 4 * lane);
            vv[u] = *(const u32x2*)(c.TOK() + (size_t)row * 1536 + 512 + 4 * lane); gq[u] = *(const u32x2*)(c.GG() + (size_t)row * 256 + 4 * lane); bon[u] = c.BON()[(size_t)row * 4 + h]; }
#pragma unroll
        for (int u = 0; u < 9; ++u) { const int row = row0 + u * c.nw; if (row < NR) {
            const float m = row16_sum((o[u][0] + o[u][1]) + (o[u][2] + o[u][3])) * (1.0f / 64.0f);
            const f32x4 d = o[u] - m; const float var = row16_sum((d[0] * d[0] + d[1] * d[1]) + (d[2] * d[2] + d[3] * d[3])) * (1.0f / 64.0f);
            const float rstd = rsqrtf(var + 64e-5f);
            float v[4], g[4]; unpack4(vv[u], v); unpack4(gq[u], g);
            float y[4];
#pragma unroll
            for (int e = 0; e < 4; ++e) y[e] = (d[e] * rstd * lg[e] + lb[e] + bon[u] * v[e]) * g[e];
            u32x2 p; p.x = pk2(y[0], y[1]); p.y = pk2(y[2], y[3]); *(u32x2*)(c.Z() + (size_t)row * ZLD + 256 + 4 * lane) = p; } }
    }
}

#define XB_XCNT(j)  (256  + 64 * (j))
#define XB_XSUB(j)  (1280 + 64 * (j))
#define XB_XGEN(j)  (2304 + 64 * (j))
#define XB_TOP      3328
#define XB_TOPGEN   3392
__device__ __forceinline__ unsigned xb_ld(unsigned* p) { return __hip_atomic_load(p, __ATOMIC_RELAXED, __HIP_MEMORY_SCOPE_AGENT); }
__device__ __forceinline__ unsigned xb_add(unsigned* p, unsigned v) { return __hip_atomic_fetch_add(p, v, __ATOMIC_RELAXED, __HIP_MEMORY_SCOPE_AGENT); }
#define XB_SPIN(cond) do { unsigned _sp = 0; while (cond) { __builtin_amdgcn_s_sleep(1); if (++_sp > (1u << 24)) break; } } while (0)
__device__ __forceinline__ void gbar(unsigned* bar, unsigned x, unsigned nloc, unsigned nx, unsigned gen) {
    asm volatile("s_waitcnt vmcnt(0) lgkmcnt(0)" ::: "memory");
    __syncthreads();
    if (threadIdx.x == 0) {
        const unsigned old = xb_add(&bar[XB_XSUB(x)], 1u);
        if (old + 1u == (gen + 1u) * nloc) {
            __builtin_amdgcn_fence(__ATOMIC_RELEASE, "agent");
            asm volatile("s_waitcnt vmcnt(0)" ::: "memory");
            const unsigned og = xb_add(&bar[XB_TOP], 1u);
            const unsigned tg = gen;
            if (og + 1u == (tg + 1u) * nx) xb_add(&bar[XB_TOPGEN], 1u);
            else XB_SPIN(xb_ld(&bar[XB_TOPGEN]) == tg);
            __builtin_amdgcn_fence(__ATOMIC_ACQUIRE, "agent");
            xb_add(&bar[XB_XGEN(x)], 1u);
            asm volatile("s_waitcnt vmcnt(0)" ::: "memory");
        } else {
            XB_SPIN(xb_ld(&bar[XB_XGEN(x)]) == gen);
            __builtin_amdgcn_fence(__ATOMIC_ACQUIRE, "agent");
            asm volatile("s_waitcnt vmcnt(0)" ::: "memory");
        }
    }
    __syncthreads();
}

__global__ void __launch_bounds__(512) hybrid_fwd(Params P) {
    extern __shared__ __attribute__((aligned(16))) unsigned char lds_raw[];
    cg::grid_group grid = cg::this_grid();
    Ctx c;
    c.in = P.in; c.out = P.out; c.ws = P.ws;
    c.lds = (LAS unsigned char*)lds_raw; c.tid = threadIdx.x; c.lane = threadIdx.x & 63; c.w = __builtin_amdgcn_readfirstlane(threadIdx.x >> 6);
    c.gw = blockIdx.x * 8 + c.w; c.nw = gridDim.x * 8;
    const int G = gridDim.x;
    const int wave_id = __builtin_amdgcn_readfirstlane(threadIdx.x >> 6);
#define REFRESH() do { int w_ = wave_id; asm volatile("" : "+s"(w_)); int ln_; asm volatile("v_mbcnt_lo_u32_b32 %0, -1, 0\n\tv_mbcnt_hi_u32_b32 %0, -1, %0" : "=v"(ln_)); int t_ = w_ * 64 + ln_; { unsigned char* w2_ = P.ws; asm volatile("" : "+s"(w2_)); c.ws = w2_; } c.tid = t_; c.lane = t_ & 63; c.w = w_; c.gw = blockIdx.x * 8 + c.w; } while (0)

    unsigned* bar = (unsigned*)(P.ws + W_BAR);
    const unsigned xcc = (unsigned)__builtin_amdgcn_s_getreg((3 << 11) | 20) & 0xFu;
    if (threadIdx.x == 0) xb_add(&bar[XB_XCNT(xcc)], 1u);
    phase0(c);
    grid.sync();
    unsigned nloc = 0, nx = 0;
#pragma unroll
    for (unsigned j = 0; j < 16; ++j) { const unsigned cnt = xb_ld(&bar[XB_XCNT(j)]); nx += cnt > 0u ? 1u : 0u; nloc = (j == xcc) ? cnt : nloc; }
    nloc = __builtin_amdgcn_readfirstlane(nloc); nx = __builtin_amdgcn_readfirstlane(nx);
    if (nloc == 0u) nloc = 1u; if (nx == 0u) nx = 1u;
    unsigned bar_gen = 0;
#define GBAR() do { gbar(bar, xcc, nloc, nx, bar_gen); ++bar_gen; } while (0)
    for (int l = 0; l < NL; ++l) {
        const int buf = l & 1;
        unsigned char* wb = c.WB() + (size_t)buf * WB_SIZE;
        const bf16_t* WinT = (const bf16_t*)(wb + WB_WIN); const bf16_t* WoutT = (const bf16_t*)(wb + WB_WOUT); const bf16_t* WguT = (const bf16_t*)(wb + WB_WGU); const bf16_t* WdnT = (const bf16_t*)(wb + WB_WDN);
        REFRESH();
        { pg8::Gemm g{c.XB(), WinT, NPROMPT, ZLD, 1024, 1024}; pg8::StaticOrder S; S.init(NPROMPT, ZLD, G, blockIdx.x); EpiZ E{c.Z(), c.SSQ() + (size_t)(2 * l) * NR};
          pg8::gemm_phase<EpiZ>(c.lds, g, S, E, c.tid);
          REFRESH(); ThinZ T{c.Z(), c.SSQ() + (size_t)(2 * l) * NR};
          const bool split = (G == 256);
          if (!split) thin_gemm(c.XB() + (size_t)NPROMPT * DM, DM, WinT, 1024, INC / 32, T, c.w, c.lane);
          else if (blockIdx.x >= 128) thin_gemm(c.XB() + (size_t)NPROMPT * DM, DM, WinT, 1024, INC / 32, T, c.w, c.lane, (int)blockIdx.x - 128, 128);
          if (l + 1 < NL) { REFRESH(); if (!split) convert_weights(c, l + 1, buf ^ 1, 0); else if (blockIdx.x >= 128) convert_weights(c, l + 1, buf ^ 1, 0, (int)blockIdx.x - 128, 128); } }
        GBAR();
        REFRESH();
        conv_phase(c, l);
        REFRESH();
        for (int tile = blockIdx.x; tile < 256; tile += G) ssm_tile<false>(c, l, tile);
        REFRESH();
        rwkv_tok(c, l, buf);
        REFRESH();
        __syncthreads();
        rwkv_d1(c);
        if (G != 256) { REFRESH(); shift_out(c, l, (int)blockIdx.x * 512 + c.tid, G * 512); }
        GBAR();
        REFRESH();
        for (int tile = blockIdx.x; tile < 256; tile += G) { ssm_tile<true>(c, l, tile); __syncthreads(); ssm_glu(c, l, buf, tile); __syncthreads(); }
        { const int sb = (G >= 160) ? 128 : 0;
          for (int q = (int)blockIdx.x - sb; q >= 0 && q < 4; q += G) { const int tile = 256 + (q >> 1), hf = q & 1; ssm_tile<true>(c, l, tile, hf, hf + 1); __syncthreads(); ssm_glu(c, l, buf, tile, 2 * hf, 2 * hf + 2); __syncthreads(); } }
        if (G == 256) {
            if (blockIdx.x >= 128) { REFRESH(); gmlp_tile<true>(c, l, buf, (int)blockIdx.x - 128); }
            else { REFRESH();
                if (c.w == 0) rwkv_d2(c, l);
                else { if (c.w == 1) gmlp_sample(c, l, (int)blockIdx.x, 128); rwkv_scan(c, l, (int)blockIdx.x * 7 + c.w - 1, 128 * 7); shift_out(c, l, (int)blockIdx.x * 448 + c.tid - 64, 128 * 448); } }
        } else {
            REFRESH();
            for (int tile = blockIdx.x; tile < 256; tile += G) gmlp_tile<false>(c, l, buf, tile);
            REFRESH();
            gmlp_sample(c, l, c.gw, c.nw);
            REFRESH();
            rwkv_scan(c, l, c.gw, c.nw);
            REFRESH();
            rwkv_d2(c, l);
        }
        GBAR();
        REFRESH();
        rwkv_final(c, l);
        GBAR();
        REFRESH();
        { pg8::Gemm g{c.Z() + MIXOFF, WoutT, NPROMPT, 1024, 1024, ZLD}; pg8::StaticOrder S; S.init(NPROMPT, 1024, G, blockIdx.x); EpiRes E{c.XB(), c.SSQ() + (size_t)(2 * l + 1) * NR};
          pg8::gemm_phase<EpiRes>(c.lds, g, S, E, c.tid);
          REFRESH(); ThinRes T{c.XB(), c.SSQ() + (size_t)(2 * l + 1) * NR}; thin_gemm_sk<4>(c.lds, c.Z() + MIXOFF + (size_t)NPROMPT * ZLD, ZLD, WoutT, 1024, 32, T, c.w, c.lane); }
        GBAR();
        REFRESH();
        { pg8::Gemm g{c.XB(), WguT, NPROMPT, 5632, 1024, 1024}; pg8::StaticOrder S; S.init(NPROMPT, 5632, G, blockIdx.x); EpiAct E{c.ACT(), c.SSQ() + (size_t)(2 * l + 1) * NR};
          pg8::gemm_phase<EpiAct>(c.lds, g, S, E, c.tid);
          REFRESH(); ThinAct T{c.ACT(), c.SSQ() + (size_t)(2 * l + 1) * NR}; if (G != 256) thin_gemm(c.XB() + (size_t)NPROMPT * DM, DM, WguT, 1024, DFF / 16, T, c.w, c.lane); else if (blockIdx.x >= 128) thin_gemm(c.XB() + (size_t)NPROMPT * DM, DM, WguT, 1024, DFF / 16, T, c.w, c.lane, (int)blockIdx.x - 128, 128);
          if (l + 1 < NL) { REFRESH(); if (G != 256) convert_weights(c, l + 1, buf ^ 1, 1); else if (blockIdx.x >= 128) convert_weights(c, l + 1, buf ^ 1, 1, (int)blockIdx.x - 128, 128); } }
        GBAR();
        REFRESH();
        { pg8::Gemm g{c.ACT(), WdnT, NPROMPT, 1024, DFF, DFF}; pg8::StaticOrder S; S.init(NPROMPT, 1024, G, blockIdx.x); EpiRes E{c.XB(), c.SSQ() + (size_t)(2 * l + 2) * NR};
          pg8::gemm_phase<EpiRes>(c.lds, g, S, E, c.tid);
          REFRESH(); ThinRes T{c.XB(), c.SSQ() + (size_t)(2 * l + 2) * NR}; thin_gemm_sk<11>(c.lds, c.ACT() + (size_t)NPROMPT * DFF, DFF, WdnT, DFF, 32, T, c.w, c.lane); }
        GBAR();
    }
    REFRESH();
    { f32x4 gn[4];
#pragma unroll
      for (int j = 0; j < 4; ++j) gn[j] = *(const f32x4*)(c.in[40] + j * 256 + c.lane * 4);
      for (int row0 = c.gw; row0 < NR; row0 += 5 * c.nw) { u32x2 xv[5][4]; unsigned long long sq[5];
#pragma unroll
          for (int u = 0; u < 5; ++u) { const int row = (row0 + u * c.nw < NR) ? row0 + u * c.nw : row0; sq[u] = c.SSQ()[(size_t)8 * NR + row];
#pragma unroll
              for (int j = 0; j < 4; ++j) xv[u][j] = *(const u32x2*)(c.XB() + (size_t)row * DM + j * 256 + c.lane * 4); }
#pragma unroll
          for (int u = 0; u < 5; ++u) { const int row = row0 + u * c.nw; if (row < NR) { const float rs = rsqrtf((float)sq[u] * (1.0f / (SSQ_SCALE * 1024.0f)) + 1e-6f);
#pragma unroll
              for (int j = 0; j < 4; ++j) { float v[4]; unpack4(xv[u][j], v); __builtin_nontemporal_store((f32x4){v[0] * rs * gn[j][0], v[1] * rs * gn[j][1], v[2] * rs * gn[j][2], v[3] * rs * gn[j][3]}, (f32x4*)(c.out + (size_t)row * DM + j * 256 + c.lane * 4)); } } } } }
}

extern "C" void kernel_launch(void* const* d_in, const int* in_sizes, int n_in, void* d_out, int out_size, void* d_ws, size_t ws_size, hipStream_t stream) {
    static int grid_blocks = 0;
    if (!grid_blocks) {
        int dev = 0, cus = 0, per_cu = 0;
        hipGetDevice(&dev);
        hipDeviceGetAttribute(&cus, hipDeviceAttributeMultiprocessorCount, dev);
        hipFuncSetAttribute((const void*)hybrid_fwd, hipFuncAttributeMaxDynamicSharedMemorySize, LDS_BYTES);
        hipOccupancyMaxActiveBlocksPerMultiprocessor(&per_cu, (const void*)hybrid_fwd, 512, LDS_BYTES);
        if (per_cu < 1) per_cu = 1;
        grid_blocks = cus * per_cu;
        if (n_in != 41 || (size_t)out_size != O_END || ws_size < W_END) fprintf(stderr, "kernel_launch: unexpected sizes n_in %d out %d ws %zu\n", n_in, out_size, ws_size);
    }
    hipMemsetAsync((char*)d_ws + W_BAR, 0, 16384, stream);
    Params p{};
    for (int i = 0; i < 41; ++i) p.in[i] = (const float*)d_in[i];
    p.out = (float*)d_out; p.ws = (unsigned char*)d_ws;
    void* args[] = {&p};
    hipError_t e = hipLaunchCooperativeKernel((const void*)hybrid_fwd, dim3(grid_blocks), dim3(512), args, LDS_BYTES, stream);
    if (e != hipSuccess) fprintf(stderr, "cooperative launch failed: %s (grid %d)\n", hipGetErrorString(e), grid_blocks);
}
```
